# Optimizing an MI355X kernel written in HIP

```python
import jax, jax.numpy as jnp
from jax import lax
import numpy as np

D_MODEL = 1024
BATCH = 16
SEQ = 2048
DEPTH = 2

CHUNK = 64
POOL_WIDTH = 1024
POOL_WINDOWS = (2, 4, 8, 16)
POOL_GROUPS = len(POOL_WINDOWS)
POOL_GROUP_WIDTH = POOL_WIDTH // POOL_GROUPS
HGRN_WIDTH = 1024
HGRN_EXPAND = 128
HGRN_HEADS = HGRN_WIDTH // HGRN_EXPAND
HGRN_HEAD_V = HGRN_WIDTH // HGRN_HEADS
MIX_WIDTH = POOL_WIDTH + HGRN_WIDTH
IN_WIDTH = 2 * POOL_WIDTH + 4 * HGRN_WIDTH
EPS = 1e-6

kernel_name = "hybrid_pool_hgrn2_adaln_block"


def rms_norm(x, w):
    xf = x.astype(jnp.float32)
    xf = xf * lax.rsqrt(jnp.mean(xf * xf, axis=-1, keepdims=True) + EPS)
    return xf * w.astype(jnp.float32)


def multiscale_pool(u, pool_w, pool_scale):
    B, S, _ = u.shape
    cs = jnp.cumsum(u, axis=1)
    count = jnp.arange(1, S + 1, dtype=jnp.float32)[None, :, None]
    outs = []
    for g, w in enumerate(POOL_WINDOWS):
        lo, hi = g * POOL_GROUP_WIDTH, (g + 1) * POOL_GROUP_WIDTH
        cs_g = cs[..., lo:hi]
        prev = jnp.pad(cs_g, ((0, 0), (w, 0), (0, 0)))[:, :S]
        mean = (cs_g - prev) / jnp.minimum(count, float(w))
        outs.append(mean - u[..., lo:hi])
    d = jnp.stack(outs, axis=2)
    y = jnp.einsum('bsgc,gcd->bsgd', d, pool_w.astype(jnp.float32))
    return y.reshape(B, S, POOL_WIDTH) * pool_scale.astype(jnp.float32)


def _to_chunks(t):
    B, S, H, D = t.shape
    return t.reshape(B, S // CHUNK, CHUNK, H, D).transpose(1, 0, 3, 2, 4)


def hgrn2_chunkwise(q, log_f, k, v):
    B, S, H, dk = q.shape
    dv = v.shape[-1]
    causal = jnp.tril(jnp.ones((CHUNK, CHUNK), dtype=bool))[:, :, None]

    def step(state, xs):
        qc, lfc, kc, vc = xs
        b = jnp.cumsum(lfc, axis=2)
        o_inter = jnp.einsum('bhtk,bhkv->bhtv', qc * jnp.exp(b), state)
        diff = b[:, :, :, None, :] - b[:, :, None, :, :]
        decay = jnp.exp(jnp.where(causal, diff, -jnp.inf))
        attn = jnp.einsum('bhtk,bhsk,bhtsk->bhts', qc, kc, decay)
        o_intra = jnp.einsum('bhts,bhsv->bhtv', attn, vc)
        b_last = b[:, :, -1, :]
        k_dec = kc * jnp.exp(b_last[:, :, None, :] - b)
        new_state = jnp.exp(b_last)[..., None] * state + jnp.einsum('bhsk,bhsv->bhkv', k_dec, vc)
        return new_state, o_inter + o_intra

    state0 = jnp.zeros((B, H, dk, dv), jnp.float32)
    _, o = lax.scan(step, state0, (_to_chunks(q), _to_chunks(log_f), _to_chunks(k), _to_chunks(v)))
    return o.transpose(1, 0, 3, 2, 4).reshape(B, S, H, dv)


def setup_inputs(seed: int = 0) -> dict:
    key = jax.random.key(seed)
    ks = jax.random.split(key, 12)
    f32 = jnp.float32
    x = jax.random.normal(ks[0], (BATCH, SEQ, D_MODEL), f32)
    c = jax.random.normal(ks[1], (BATCH, D_MODEL), f32)
    norm_pre_w = 1.0 + 0.05 * jax.random.normal(ks[2], (DEPTH, D_MODEL), f32)
    ada_w = 0.5 * D_MODEL ** -0.5 * jax.random.normal(ks[3], (DEPTH, D_MODEL, 3 * D_MODEL), f32)
    ada_b = 0.01 * jax.random.normal(ks[4], (DEPTH, 3 * D_MODEL), f32)
    w_in = D_MODEL ** -0.5 * jax.random.normal(ks[5], (DEPTH, D_MODEL, IN_WIDTH), f32)
    pool_w = POOL_GROUP_WIDTH ** -0.5 * jax.random.normal(
        ks[6], (DEPTH, POOL_GROUPS, POOL_GROUP_WIDTH, POOL_GROUP_WIDTH), f32)
    pool_scale = 1.0 + 0.05 * jax.random.normal(ks[7], (DEPTH, POOL_WIDTH), f32)
    hgrn_lower_bounds = 0.5 * jax.random.normal(ks[8], (DEPTH, HGRN_WIDTH), f32)
    hgrn_norm_w = 1.0 + 0.05 * jax.random.normal(ks[9], (DEPTH, HGRN_HEAD_V), f32)
    w_out = MIX_WIDTH ** -0.5 * jax.random.normal(ks[10], (DEPTH, MIX_WIDTH, D_MODEL), f32)
    norm_post_w = 1.0 + 0.05 * jax.random.normal(ks[11], (DEPTH, D_MODEL), f32)
    return {"x": x, "c": c, "norm_pre_w": norm_pre_w, "ada_w": ada_w, "ada_b": ada_b,
            "w_in": w_in, "pool_w": pool_w, "pool_scale": pool_scale,
            "hgrn_lower_bounds": hgrn_lower_bounds, "hgrn_norm_w": hgrn_norm_w,
            "w_out": w_out, "norm_post_w": norm_post_w}


def reference(x, c, norm_pre_w, ada_w, ada_b, w_in, pool_w, pool_scale,
              hgrn_lower_bounds, hgrn_norm_w, w_out, norm_post_w):
    B, S, D = x.shape
    f32 = jnp.float32
    lb_sm = jax.nn.softmax(hgrn_lower_bounds.astype(f32), axis=0)
    lower_bounds = jnp.cumsum(lb_sm, axis=0) - lb_sm[0]
    silu_c = jax.nn.silu(c.astype(f32))
    h_res = x.astype(f32)
    for l in range(DEPTH):
        mod = silu_c @ ada_w[l].astype(f32) + ada_b[l].astype(f32)
        shift, scale, gate = jnp.split(mod[:, None, :], 3, axis=-1)
        h = rms_norm(h_res, norm_pre_w[l]) * (1.0 + scale) + shift
        z = h @ w_in[l].astype(f32)
        u_pool, g_pool, q, f_pre, i_in, g_h = jnp.split(
            z, np.cumsum([POOL_WIDTH, POOL_WIDTH, HGRN_WIDTH, HGRN_WIDTH, HGRN_WIDTH]), axis=-1)
        pool_out = multiscale_pool(u_pool, pool_w[l], pool_scale[l]) * jax.nn.silu(g_pool)
        lb = lower_bounds[l]
        f = lb + (1.0 - lb) * jax.nn.sigmoid(f_pre)
        log_f = jnp.log(f)
        k = 1.0 - f
        heads = lambda t, d: t.reshape(B, S, HGRN_HEADS, d)
        o = hgrn2_chunkwise(heads(q, HGRN_EXPAND), heads(log_f, HGRN_EXPAND),
                            heads(k, HGRN_EXPAND), heads(i_in, HGRN_HEAD_V))
        o = rms_norm(o, hgrn_norm_w[l]) * jax.nn.silu(heads(g_h, HGRN_HEAD_V))
        hgrn_out = o.reshape(B, S, HGRN_WIDTH)
        y = jnp.concatenate([pool_out, hgrn_out], axis=-1) @ w_out[l].astype(f32)
        h_res = h_res + gate * rms_norm(y, norm_post_w[l])
    return h_res.astype(x.dtype)
```

```cpp
#include <hip/hip_runtime.h>
#include <cstdio>
#include <cstdint>

#ifndef MK_N_LAUNCHES
#define MK_N_LAUNCHES 12
#endif

constexpr int NWAVES = 8;
constexpr int N_LAUNCHES = MK_N_LAUNCHES;
constexpr int BATCH = 16, SEQ = 2048, D = 1024, DEPTH = 2, NZ = 6144, MIXW = 2048, NHEAD = 8, HD = 128;
constexpr int M = BATCH * SEQ;
constexpr float EPS = 1e-6f;
constexpr int N_PHASES = 2 + 5 * DEPTH;

constexpr size_t MiB = 1u << 20;
constexpr size_t WS_CTL = 0, CTL_ZERO_BYTES = 1 * MiB;
constexpr size_t WS_MOD = 1 * MiB;
constexpr size_t WS_LB = 1 * MiB + 512 * 1024;
constexpr size_t WS_WIN = 2 * MiB;
constexpr size_t WS_WOUT = 26 * MiB;
constexpr size_t WS_WPOOL = 34 * MiB;
constexpr size_t WS_XN = 36 * MiB;
constexpr size_t WS_U = 100 * MiB, WS_Q = 164 * MiB, WS_LF = 228 * MiB, WS_V = 292 * MiB;
constexpr size_t WS_MIX = 356 * MiB;
constexpr size_t WS_Y = WS_U;
constexpr size_t WS_END = 484 * MiB;
constexpr int CW_TMO = 0, CW_CODE = 1;
constexpr int CW_BAR = 4096;


struct Args { const float* in[12]; float* out; unsigned char* ws; int ph_lo, ph_hi, li, pad; };
typedef const __attribute__((address_space(4))) Args* KArgs;
__device__ __forceinline__ KArgs kargs() { KArgs p = (KArgs)__builtin_amdgcn_kernarg_segment_ptr(); asm volatile("" : "+s"(p)); return p; }
enum { IN_X = 0, IN_C, IN_NPRE, IN_ADAW, IN_ADAB, IN_WIN, IN_POOLW, IN_PSCALE, IN_HLB, IN_HNW, IN_WOUT, IN_NPOST };

namespace pg8 {
#define PG8_LAS __attribute__((address_space(3)))
typedef unsigned short bf16_t;
typedef short bf16x8 __attribute__((ext_vector_type(8)));
typedef float f32x4 __attribute__((ext_vector_type(4)));
typedef unsigned u32x4 __attribute__((ext_vector_type(4)));
constexpr int BM = 256, BK = 64, HALF = 128, HTB = HALF * BK * 2  , STAGE_BYTES = 8 * HTB, NXCD = 8, WGM = 8;

__host__ __device__ __forceinline__ int lds_byte(int r, int c) { const int st = (r >> 4) * 2 + (c >> 5), rr = r & 15, cc = c & 31, ob = rr * 64 + cc * 2; return st * 1024 + (ob ^ (((ob >> 9) & 1) << 5)); }
__host__ __device__ __forceinline__ void stage_rc(int b, int& R, int& C) { const int st = b / 1024, sb = b % 1024, swz = sb ^ (((sb >> 9) & 1) << 5); R = (st >> 1) * 16 + swz / 64; C = (st & 1) * 32 + (swz % 64) / 2; }
__host__ __device__ __forceinline__ int perm32(int rho) { const int n = rho >> 4, i = rho & 15; return 8 * (i >> 2) + 4 * n + (i & 3); }

struct Unit { int pm, pn; };
struct Gemm { const bf16_t* A; const bf16_t* Bt; int M, N, K, lda, acol; };

struct StaticOrder {
    int nM, nN, nwg, G, c;
    __host__ __device__ void init(int M, int N, int G_, int c_) { nM = M / BM; nN = N / BM; nwg = nM * nN; G = G_; c = c_; }
    __host__ __device__ bool next(int i, Unit& u) const {
        const long L = (long)i * G + c; if (L >= nwg) return false;
        int wgid = (int)L; { const int q = nwg / NXCD, r = nwg % NXCD, xcd = wgid % NXCD, off = wgid / NXCD; wgid = (xcd < r ? xcd * (q + 1) : r * (q + 1) + (xcd - r) * q) + off; }
        const int nig = WGM * nN, gid = wgid / nig, fm = gid * WGM, gsz = (nM - fm) < WGM ? (nM - fm) : WGM;
        u.pm = fm + ((wgid % nig) % gsz); u.pn = (wgid % nig) / gsz; return true;
    }
    __device__ __forceinline__ void a_ready(const Unit&) const {}
    __device__ __forceinline__ void done(const Unit&) const {}
};

__device__ __forceinline__ unsigned cvt_pk_bf16(float lo, float hi) { unsigned r; asm volatile("v_cvt_pk_bf16_f32 %0, %1, %2" : "=v"(r) : "v"(lo), "v"(hi)); return r; }
__device__ __forceinline__ unsigned cvt_pk_f16(float lo, float hi) { typedef _Float16 h2 __attribute__((ext_vector_type(2))); h2 v; v.x = (_Float16)lo; v.y = (_Float16)hi; return __builtin_bit_cast(unsigned, v); }
__device__ __forceinline__ float bf_lo(unsigned w) { return __uint_as_float(w << 16); }
__device__ __forceinline__ float bf_hi(unsigned w) { return __uint_as_float(w & 0xffff0000u); }
__device__ __forceinline__ float sigmoid_f(float x) { return __builtin_amdgcn_rcpf(1.0f + __expf(-x)); }

struct EpiBf16Plain {
    static constexpr bool PERM = true, AFTER_DRAIN = false;
    size_t ws_off; int ldc;
    __device__ __forceinline__ void operator()(const f32x4 (&acc)[2][2][4][2], const Unit& u, int wr, int wc, int fr, int fq) const {
        const int row0 = u.pm * BM + wr * 64 + fr, col0 = u.pn * BM + wc * 32 + 8 * fq;
        bf16_t* O = (bf16_t*)(kargs()->ws + ws_off);
#pragma unroll
        for (int ai = 0; ai < 2; ++ai)
#pragma unroll
            for (int m = 0; m < 4; ++m) { bf16_t* rowp = O + (size_t)(row0 + ai * HALF + m * 16) * ldc + col0;
#pragma unroll
                for (int bj = 0; bj < 2; ++bj) { const f32x4 v0 = acc[ai][bj][m][0], v1 = acc[ai][bj][m][1];
                    u32x4 w; w.x = cvt_pk_bf16(v0[0], v0[1]); w.y = cvt_pk_bf16(v0[2], v0[3]); w.z = cvt_pk_bf16(v1[0], v1[1]); w.w = cvt_pk_bf16(v1[2], v1[3]);
                    *(u32x4*)(rowp + bj * HALF) = w; } }
    }
};

struct EpiZ {
    static constexpr bool PERM = true, AFTER_DRAIN = false;
    int l;
    template <int ACT> __device__ __forceinline__ void tile(const f32x4 (&acc)[2][2][4][2], bf16_t* base, int ldc, int row0, int col0, const float* lb) const {
        f32x4 lbv[2][2];
        if (ACT == 2) {
#pragma unroll
            for (int bj = 0; bj < 2; ++bj)
#pragma unroll
                for (int n = 0; n < 2; ++n) lbv[bj][n] = *(const f32x4*)(lb + col0 + bj * HALF + 4 * n);
        }
#pragma unroll
        for (int ai = 0; ai < 2; ++ai)
#pragma unroll
            for (int m = 0; m < 4; ++m) { bf16_t* rowp = base + (size_t)(row0 + ai * HALF + m * 16) * ldc + col0;
#pragma unroll
                for (int bj = 0; bj < 2; ++bj) { f32x4 v[2] = {acc[ai][bj][m][0], acc[ai][bj][m][1]};
                    u32x4 w;
                    if (ACT == 1) {
#pragma unroll
                        for (int n = 0; n < 2; ++n)
#pragma unroll
                            for (int e = 0; e < 4; ++e) v[n][e] = v[n][e] * sigmoid_f(v[n][e]);
                    }
                    if (ACT == 2) {
#pragma unroll
                        for (int n = 0; n < 2; ++n)
#pragma unroll
                            for (int e = 0; e < 4; ++e) { const float x = fminf(fmaxf(v[n][e], -30.f), 30.f), l = lbv[bj][n][e]; v[n][e] = __logf(l + (1.0f - l) * sigmoid_f(x)); }
                        w.x = cvt_pk_f16(v[0][0], v[0][1]); w.y = cvt_pk_f16(v[0][2], v[0][3]); w.z = cvt_pk_f16(v[1][0], v[1][1]); w.w = cvt_pk_f16(v[1][2], v[1][3]);
                    } else {
                        w.x = cvt_pk_bf16(v[0][0], v[0][1]); w.y = cvt_pk_bf16(v[0][2], v[0][3]); w.z = cvt_pk_bf16(v[1][0], v[1][1]); w.w = cvt_pk_bf16(v[1][2], v[1][3]);
                    }
                    *(u32x4*)(rowp + bj * HALF) = w; }
                if (ACT != 0) __builtin_amdgcn_sched_barrier(0); }
    }
    __device__ __forceinline__ void operator()(const f32x4 (&acc)[2][2][4][2], const Unit& u, int wr, int wc, int fr, int fq) const {
        const int seg = u.pn >> 2, row0 = u.pm * BM + wr * 64 + fr, col0 = (u.pn & 3) * BM + wc * 32 + 8 * fq;
        unsigned char* ws = kargs()->ws; const float* lb = (const float*)(ws + WS_LB) + l * 1024;
        const size_t off = seg == 0 ? WS_U : seg == 2 ? WS_Q : seg == 3 ? WS_LF : seg == 4 ? WS_V : seg == 1 ? WS_MIX : WS_MIX + 2048;
        const int ldc = (seg == 1 || seg == 5) ? 2048 : 1024;
        bf16_t* base = (bf16_t*)(ws + off);
        if (seg == 3) tile<2>(acc, base, ldc, row0, col0, lb);
        else if (seg == 1 || seg == 5) tile<1>(acc, base, ldc, row0, col0, lb);
        else tile<0>(acc, base, ldc, row0, col0, lb);
    }
};

struct EpiPool {
    static constexpr bool PERM = true, AFTER_DRAIN = false;
    int l;
    __device__ __forceinline__ void operator()(const f32x4 (&acc)[2][2][4][2], const Unit& u, int wr, int wc, int fr, int fq) const {
        const int row0 = u.pm * BM + wr * 64 + fr, col0 = u.pn * BM + wc * 32 + 8 * fq;
        const KArgs ka = kargs(); bf16_t* MIX = (bf16_t*)(ka->ws + WS_MIX); const float* pscale = ka->in[IN_PSCALE] + l * 1024;
        f32x4 sv[2][2];
#pragma unroll
        for (int bj = 0; bj < 2; ++bj)
#pragma unroll
            for (int n = 0; n < 2; ++n) sv[bj][n] = *(const f32x4*)(pscale + col0 + bj * HALF + 4 * n);
#pragma unroll
        for (int ai = 0; ai < 2; ++ai)
#pragma unroll
            for (int m = 0; m < 4; ++m) { bf16_t* rowp = MIX + (size_t)(row0 + ai * HALF + m * 16) * 2048 + col0;
#pragma unroll
                for (int bj = 0; bj < 2; ++bj) { const u32x4 gw = *(const u32x4*)(rowp + bj * HALF);
                    const f32x4 v0 = acc[ai][bj][m][0] * sv[bj][0], v1 = acc[ai][bj][m][1] * sv[bj][1];
                    u32x4 w; w.x = cvt_pk_bf16(v0[0] * bf_lo(gw.x), v0[1] * bf_hi(gw.x)); w.y = cvt_pk_bf16(v0[2] * bf_lo(gw.y), v0[3] * bf_hi(gw.y));
                    w.z = cvt_pk_bf16(v1[0] * bf_lo(gw.z), v1[1] * bf_hi(gw.z)); w.w = cvt_pk_bf16(v1[2] * bf_lo(gw.w), v1[3] * bf_hi(gw.w));
                    *(u32x4*)(rowp + bj * HALF) = w; }
                if (m & 1) asm volatile("" ::: "memory"); }
    }
};

template <class Epi, class Sched, bool ALIGN_EPI = false, bool SP2 = false>
__device__ __forceinline__ void gemm_phase(PG8_LAS unsigned char* lds, const Gemm g, const Sched& S, const Epi& E) {
    int tid_ = threadIdx.x; asm volatile("" : "+v"(tid_));
    const int tid = tid_, wid = __builtin_amdgcn_readfirstlane(tid >> 6), lane = tid & 63, wr = wid >> 2, wc = wid & 3, fr = lane & 15, fq = lane >> 4;
    const int K = g.K, nt = K / BK;
    unsigned voffA[2], voffB[2];
#pragma unroll
    for (int i = 0; i < 2; ++i) { int R, C; stage_rc(tid * 16 + i * 8192, R, C); const int Rb = Epi::PERM ? ((R & ~31) + perm32(R & 31)) : R;
        voffA[i] = (unsigned)(R * g.lda + C) * 2u; voffB[i] = (unsigned)(Rb * K + C) * 2u; }
    const size_t kstep = (size_t)(BK * 2);
    const size_t hstepA = (size_t)HALF * g.lda * 2, hstepB = (size_t)HALF * K * 2;
    const size_t tstepA = 2 * hstepA, tstepB = 2 * hstepB;
    const size_t acolB = (size_t)g.acol * 2;
    const unsigned ldsw = (unsigned)wid * 1024u;
    const int aoff = lds_byte(wr * 64 + fr, fq * 8), boff = lds_byte(wc * 32 + fr, fq * 8);
#define PG8_SA(b, h) (((b) * 2 + (h)) * HTB)
#define PG8_SB(b, h) ((4 + (b) * 2 + (h)) * HTB)
#define PG8_STAGE(bufoff, gbase, voff) do { _Pragma("unroll") for (int _i = 0; _i < 2; ++_i) \
        __builtin_amdgcn_global_load_lds((const unsigned*)((const char*)(gbase) + (voff)[_i]), (PG8_LAS unsigned*)(lds + (bufoff) + ldsw + _i * 8192), 16, 0, 0); } while (0)
#define PG8_LDA(dst, b, h) do { _Pragma("unroll") for (int m = 0; m < 4; ++m) _Pragma("unroll") for (int k = 0; k < 2; ++k) dst[m][k] = *(const PG8_LAS bf16x8*)(lds + PG8_SA(b, h) + aoff + m * 2048 + k * 1024); } while (0)
#define PG8_LDB(dst, b, h) do { _Pragma("unroll") for (int n = 0; n < 2; ++n) _Pragma("unroll") for (int k = 0; k < 2; ++k) dst[n][k] = *(const PG8_LAS bf16x8*)(lds + PG8_SB(b, h) + boff + n * 2048 + k * 1024); } while (0)
#define PG8_MMA(ai, bj, At, Bt) do { __builtin_amdgcn_s_setprio(1); _Pragma("unroll") for (int m = 0; m < 4; ++m) _Pragma("unroll") for (int n = 0; n < 2; ++n) _Pragma("unroll") for (int k = 0; k < 2; ++k) \
        acc[ai][bj][m][n] = __builtin_amdgcn_mfma_f32_16x16x32_bf16(Bt[n][k], At[m][k], acc[ai][bj][m][n], 0, 0, 0); __builtin_amdgcn_s_setprio(0); } while (0)
#define PG8_WAIT_V(n) asm volatile("s_waitcnt vmcnt(" #n ")" ::: "memory")
#define PG8_WAIT_L(n) asm volatile("s_waitcnt lgkmcnt(" #n ")" ::: "memory")
#define PG8_BAR __builtin_amdgcn_s_barrier()
#define PG8_SCHED __builtin_amdgcn_sched_barrier(0)
    Unit cur, nxt; int ui = 0;
    if (!S.next(0, cur)) return;
    f32x4 acc[2][2][4][2];
#pragma unroll
    for (int a = 0; a < 2; ++a)
#pragma unroll
        for (int b = 0; b < 2; ++b)
#pragma unroll
            for (int m = 0; m < 4; ++m)
#pragma unroll
                for (int n = 0; n < 2; ++n) acc[a][b][m][n] = (f32x4){0.f, 0.f, 0.f, 0.f};
    bf16x8 At[4][2], B0[2][2], B1[2][2];
    const char* cA = (const char*)g.A + (size_t)cur.pm * tstepA + (size_t)cur.pn * acolB; const char* cB = (const char*)g.Bt + (size_t)cur.pn * tstepB;
    S.a_ready(cur);
    if constexpr (SP2) {
        PG8_STAGE(PG8_SB(0, 0), cB, voffB); PG8_STAGE(PG8_SB(0, 1), cB + hstepB, voffB); PG8_STAGE(PG8_SA(0, 0), cA, voffA); PG8_STAGE(PG8_SA(0, 1), cA + hstepA, voffA);
        if (wr == 1) PG8_BAR;
        PG8_WAIT_V(2); PG8_BAR;
        PG8_STAGE(PG8_SB(1, 0), cB + kstep, voffB); PG8_STAGE(PG8_SA(1, 0), cA + kstep, voffA); PG8_STAGE(PG8_SB(1, 1), cB + hstepB + kstep, voffB);
        PG8_WAIT_V(6); PG8_BAR;
    } else {
        PG8_STAGE(PG8_SB(0, 0), cB, voffB); PG8_STAGE(PG8_SA(0, 0), cA, voffA); PG8_STAGE(PG8_SB(0, 1), cB + hstepB, voffB); PG8_STAGE(PG8_SA(0, 1), cA + hstepA, voffA);
        if (wr == 1) PG8_BAR;
        PG8_WAIT_V(4); PG8_BAR;
        PG8_STAGE(PG8_SB(1, 0), cB + kstep, voffB); PG8_STAGE(PG8_SA(1, 0), cA + kstep, voffA); PG8_STAGE(PG8_SB(1, 1), cB + hstepB + kstep, voffB);
        PG8_WAIT_V(6); PG8_BAR;
    }
    for (;;) {
        const bool has_next = S.next(ui + 1, nxt);
        const char* nA = has_next ? (const char*)g.A + (size_t)nxt.pm * tstepA + (size_t)nxt.pn * acolB : cA; const char* nB = has_next ? (const char*)g.Bt + (size_t)nxt.pn * tstepB : cB;
        for (int t = 0; t < nt; t += 2) {
            const bool last = (t == nt - 2);
            const char* a1 = cA + (size_t)(t + 1) * kstep;
            const char* a2 = last ? nA : cA + (size_t)(t + 2) * kstep; const char* b2 = last ? nB : cB + (size_t)(t + 2) * kstep;
            const char* a3 = a2 + kstep; const char* b3 = b2 + kstep;
            if (last && has_next) S.a_ready(nxt);
            if constexpr (SP2) {
            PG8_LDB(B0, 0, 0); PG8_LDB(B1, 0, 1); PG8_SCHED; PG8_LDA(At, 0, 0); PG8_STAGE(PG8_SA(1, 1), a1 + hstepA, voffA);
            PG8_WAIT_V(8); PG8_WAIT_L(0); PG8_BAR; PG8_MMA(0, 0, At, B0); PG8_MMA(0, 1, At, B1); PG8_BAR; PG8_SCHED;
            PG8_LDA(At, 0, 1); PG8_STAGE(PG8_SB(0, 0), b2, voffB); PG8_STAGE(PG8_SB(0, 1), b2 + hstepB, voffB); PG8_STAGE(PG8_SA(0, 0), a2, voffA);
            PG8_WAIT_V(8); PG8_WAIT_L(0); PG8_BAR; PG8_MMA(1, 0, At, B0); PG8_MMA(1, 1, At, B1); PG8_BAR; PG8_SCHED;
            PG8_LDB(B0, 1, 0); PG8_LDB(B1, 1, 1); PG8_SCHED; PG8_LDA(At, 1, 0); PG8_STAGE(PG8_SA(0, 1), a2 + hstepA, voffA);
            PG8_WAIT_V(8); PG8_WAIT_L(0); PG8_BAR; PG8_MMA(0, 0, At, B0); PG8_MMA(0, 1, At, B1); PG8_BAR; PG8_SCHED;
            PG8_LDA(At, 1, 1); PG8_STAGE(PG8_SB(1, 0), b3, voffB); PG8_STAGE(PG8_SB(1, 1), b3 + hstepB, voffB); PG8_STAGE(PG8_SA(1, 0), a3, voffA);
            PG8_WAIT_V(8); PG8_WAIT_L(0); PG8_BAR; PG8_MMA(1, 0, At, B0); PG8_MMA(1, 1, At, B1); PG8_BAR; PG8_SCHED;
            } else {
            PG8_LDB(B0, 0, 0); PG8_SCHED; PG8_LDA(At, 0, 0); PG8_STAGE(PG8_SA(1, 1), a1 + hstepA, voffA);
            PG8_WAIT_L(8); PG8_BAR; PG8_WAIT_L(0); PG8_MMA(0, 0, At, B0); PG8_BAR; PG8_SCHED;
            PG8_LDB(B1, 0, 1); PG8_STAGE(PG8_SB(0, 0), b2, voffB);
            PG8_BAR; PG8_WAIT_L(0); PG8_MMA(0, 1, At, B1); PG8_BAR;
            PG8_LDA(At, 0, 1); PG8_STAGE(PG8_SA(0, 0), a2, voffA);
            PG8_BAR; PG8_WAIT_L(0); PG8_MMA(1, 0, At, B0); PG8_BAR; PG8_SCHED;
            PG8_STAGE(PG8_SB(0, 1), b2 + hstepB, voffB);
            PG8_WAIT_V(6); PG8_BAR; PG8_MMA(1, 1, At, B1); PG8_BAR;
            PG8_LDB(B0, 1, 0); PG8_SCHED; PG8_LDA(At, 1, 0); PG8_STAGE(PG8_SA(0, 1), a2 + hstepA, voffA);
            PG8_WAIT_L(8); PG8_BAR; PG8_WAIT_L(0); PG8_MMA(0, 0, At, B0); PG8_BAR; PG8_SCHED;
            PG8_LDB(B1, 1, 1); PG8_STAGE(PG8_SB(1, 0), b3, voffB);
            PG8_BAR; PG8_WAIT_L(0); PG8_MMA(0, 1, At, B1); PG8_BAR;
            PG8_LDA(At, 1, 1); PG8_STAGE(PG8_SA(1, 0), a3, voffA);
            PG8_BAR; PG8_WAIT_L(0); PG8_MMA(1, 0, At, B0); PG8_BAR; PG8_SCHED;
            PG8_STAGE(PG8_SB(1, 1), b3 + hstepB, voffB);
            PG8_WAIT_V(6); PG8_BAR; PG8_MMA(1, 1, At, B1); PG8_BAR;
            }
        }
        if constexpr (ALIGN_EPI) { if (wr == 0) PG8_BAR; }
        if constexpr (!Epi::AFTER_DRAIN) { E(acc, cur, wr, wc, fr, fq); S.done(cur); }
        if (!has_next) break;
#pragma unroll
        for (int a = 0; a < 2; ++a)
#pragma unroll
            for (int b = 0; b < 2; ++b)
#pragma unroll
                for (int m = 0; m < 4; ++m)
#pragma unroll
                    for (int n = 0; n < 2; ++n) acc[a][b][m][n] = (f32x4){0.f, 0.f, 0.f, 0.f};
        cur = nxt; cA = nA; cB = nB; ++ui;
        if constexpr (ALIGN_EPI) { if (wr == 1) PG8_BAR; }
    }
    PG8_WAIT_V(0);
    if constexpr (!ALIGN_EPI) { if (wr == 0) PG8_BAR; }
    PG8_BAR;
    if constexpr (Epi::AFTER_DRAIN) { E.fused(acc, cur, wr, wc, fr, fq, lds, wid, lane); S.done(cur); }
#undef PG8_SA
#undef PG8_SB
#undef PG8_STAGE
#undef PG8_LDA
#undef PG8_LDB
#undef PG8_MMA
#undef PG8_WAIT_V
#undef PG8_WAIT_L
#undef PG8_BAR
#undef PG8_SCHED
}
}

#define PG8_SP2 true
#define PG8_ALIGN true

constexpr int RING_OFF = 0, RING_BYTES = 131072;
constexpr int LDSCTL_OFF = RING_BYTES, MISC_OFF = LDSCTL_OFF + 320;
constexpr int LDS_BYTES = 147456;

#define GAS __attribute__((address_space(1)))
#define LAS __attribute__((address_space(3)))
typedef unsigned short bf16;
typedef unsigned v4u __attribute__((ext_vector_type(4)));
typedef unsigned v2u __attribute__((ext_vector_type(2)));
typedef float f32x4 __attribute__((ext_vector_type(4)));
typedef short bf16x8 __attribute__((ext_vector_type(8)));
typedef GAS unsigned gu32;
typedef GAS unsigned long long gu64;
#define RLX_AGENT __ATOMIC_RELAXED, __HIP_MEMORY_SCOPE_AGENT
#define LDS_WAIT() asm volatile("s_waitcnt lgkmcnt(0)" ::: "memory")
#define VM_WAIT() asm volatile("s_waitcnt vmcnt(0)" ::: "memory")
__device__ __forceinline__ unsigned f2bf(float f) { unsigned u = __builtin_bit_cast(unsigned, f); return (u + 0x7fffu + ((u >> 16) & 1u)) >> 16; }
__device__ __forceinline__ unsigned pk2(float lo, float hi) { return f2bf(lo) | (f2bf(hi) << 16); }
__device__ __forceinline__ float bflo(unsigned w) { return __uint_as_float(w << 16); }
__device__ __forceinline__ float bfhi(unsigned w) { return __uint_as_float(w & 0xffff0000u); }
__device__ __forceinline__ float h2f_lo(unsigned w) { typedef _Float16 h2 __attribute__((ext_vector_type(2))); return (float)__builtin_bit_cast(h2, w).x; }
__device__ __forceinline__ float h2f_hi(unsigned w) { typedef _Float16 h2 __attribute__((ext_vector_type(2))); return (float)__builtin_bit_cast(h2, w).y; }

#define XB_TMO      128
#define XB_XCNT(j)  (256  + 64 * (j))
#define XB_XSUB(j)  (1280 + 64 * (j))
#define XB_XGEN(j)  (2304 + 64 * (j))
#define XB_TOP      3328
#define XB_TOPGEN   3392
#define XCD_BAR_WORDS 3456
#define XB_SPIN_CAP (1u << 18)

__device__ __forceinline__ unsigned xb_ld(unsigned* p)              { return __hip_atomic_load(p, __ATOMIC_RELAXED, __HIP_MEMORY_SCOPE_AGENT); }
__device__ __forceinline__ unsigned xb_add(unsigned* p, unsigned v) { return __hip_atomic_fetch_add(p, v, __ATOMIC_RELAXED, __HIP_MEMORY_SCOPE_AGENT); }
__device__ __forceinline__ unsigned xb_xcc_id() { return (unsigned)__builtin_amdgcn_s_getreg((3 << 11) | 20) & 0xFu; }
#define XB_SPIN(cond, bar) do { unsigned _sp = 0; while (cond) { __builtin_amdgcn_s_sleep(1); \
    if ((++_sp & 255u) == 0u) { if (xb_ld(&(bar)[XB_TMO])) break; if (_sp > XB_SPIN_CAP) { atomicAdd(&(bar)[XB_TMO], 1u); break; } } } } while (0)

struct XcdBarrier { unsigned* bar; unsigned x; volatile LAS unsigned* st; };

__device__ __forceinline__ XcdBarrier xcd_barrier_post(unsigned* bar, volatile LAS unsigned* st) {
    XcdBarrier b; b.bar = bar; b.x = xb_xcc_id(); b.st = st;
    if (threadIdx.x == 0) (void)xb_add(&bar[XB_XCNT(b.x)], 1u);
    return b;
}
__device__ __forceinline__ void xcd_barrier_complete(unsigned* bar, unsigned x, unsigned& nloc, unsigned& nx) {
    const unsigned G = gridDim.x * gridDim.y * gridDim.z;
    unsigned sum, cnt, mine, sp = 0u;
    for (;;) {
        sum = 0u; cnt = 0u; mine = 0u;
#pragma unroll
        for (unsigned j = 0; j < 16; ++j) { const unsigned c = xb_ld(&bar[XB_XCNT(j)]); sum += c; cnt += (c > 0u) ? 1u : 0u; mine = (j == x) ? c : mine; }
        if (sum == G) break;
        __builtin_amdgcn_s_sleep(1);
        if ((++sp & 255u) == 0u) { if (xb_ld(&bar[XB_TMO])) break; if (sp > XB_SPIN_CAP) { atomicAdd(&bar[XB_TMO], 1u); break; } }
    }
    nloc = mine > 0u ? mine : 1u; nx = cnt > 0u ? cnt : 1u;
}
__device__ __forceinline__ void xcd_barrier(const XcdBarrier& b) {
    asm volatile("s_waitcnt vmcnt(0)" ::: "memory");
    __syncthreads();
    if (threadIdx.x == 0) {
        unsigned* bar = b.bar;
        __builtin_amdgcn_s_waitcnt(0);
        unsigned nloc = b.st[0], nx = b.st[1];
        if (nloc == 0u) { xcd_barrier_complete(bar, b.x, nloc, nx); b.st[0] = nloc; b.st[1] = nx; }
        const unsigned old = xb_add(&bar[XB_XSUB(b.x)], 1u);
        const unsigned gen = old / nloc;
        if (old + 1u == (gen + 1u) * nloc) {
            __builtin_amdgcn_fence(__ATOMIC_RELEASE, "agent");
            asm volatile("s_waitcnt vmcnt(0)" ::: "memory");
            const unsigned og = xb_add(&bar[XB_TOP], 1u);
            const unsigned tg = og / nx;
            if (og + 1u == (tg + 1u) * nx) xb_add(&bar[XB_TOPGEN], 1u);
            else XB_SPIN(xb_ld(&bar[XB_TOPGEN]) == tg, bar);
            __builtin_amdgcn_fence(__ATOMIC_ACQUIRE, "agent");
            xb_add(&bar[XB_XGEN(b.x)], 1u);
            asm volatile("s_waitcnt vmcnt(0)" ::: "memory");
        } else {
            XB_SPIN(xb_ld(&bar[XB_XGEN(b.x)]) == gen, bar);
            __builtin_amdgcn_fence(__ATOMIC_ACQUIRE, "agent");
            asm volatile("s_waitcnt vmcnt(0)" ::: "memory");
        }
    }
    __syncthreads();
}

struct Frame {
    LAS unsigned char* lds;
    volatile LAS unsigned* MISC;
    gu32* ctl;
    int tid, lane, wave;
    int G;
};
#define REFRESH_IDS(F) do { int t_ = threadIdx.x; asm volatile("" : "+v"(t_)); (F).tid = t_; (F).lane = t_ & 63; (F).wave = __builtin_amdgcn_readfirstlane(t_ >> 6); } while (0)

__device__ __forceinline__ float wave_sum(float v) {
#pragma unroll
    for (int o = 1; o < 64; o <<= 1) v += __shfl_xor(v, o);
    return v;
}
__device__ __forceinline__ void p0_transpose_item(const float* W, int K, int N, bf16* WT, LAS float* scr, int item, int lane) {
    const int nblk = N / 32, kb = item / nblk, nb = item % nblk, k0 = 64 * kb, n0 = 32 * nb;
#pragma unroll 8
    for (int i = 0; i < 32; ++i) { const int kk = 2 * i + (lane >> 5); scr[kk * 33 + (lane & 31)] = W[(size_t)(k0 + kk) * N + n0 + (lane & 31)]; }
    LDS_WAIT(); asm volatile("" ::: "memory");
    const int c = lane & 7;
#pragma unroll
    for (int j = 0; j < 4; ++j) { const int n = (lane >> 3) + 8 * j; const LAS float* s = scr + (8 * c) * 33 + n;
        v4u o; o.x = pk2(s[0 * 33], s[1 * 33]); o.y = pk2(s[2 * 33], s[3 * 33]); o.z = pk2(s[4 * 33], s[5 * 33]); o.w = pk2(s[6 * 33], s[7 * 33]);
        *(GAS v4u*)(WT + (size_t)(n0 + n) * K + k0 + 8 * c) = o; }
    LDS_WAIT(); asm volatile("" ::: "memory");
}

__device__ __forceinline__ void p0_prologue(Frame& F) {
    REFRESH_IDS(F);
    const KArgs ka = kargs(); const float* P_win = ka->in[IN_WIN]; const float* P_wout = ka->in[IN_WOUT]; const float* P_poolw = ka->in[IN_POOLW]; bf16* P_WIN = (bf16*)(ka->ws + WS_WIN); bf16* P_WOUT = (bf16*)(ka->ws + WS_WOUT); bf16* P_WPOOL = (bf16*)(ka->ws + WS_WPOOL); const float* P_hlb = ka->in[IN_HLB]; float* P_lb = (float*)(ka->ws + WS_LB); const float* P_adaw = ka->in[IN_ADAW]; const float* P_adab = ka->in[IN_ADAB]; const float* P_c = ka->in[IN_C]; float* P_mod = (float*)(ka->ws + WS_MOD);
    LAS float* scr = (LAS float*)(F.lds + RING_OFF + F.wave * 16384);
    const int gw = blockIdx.x * NWAVES + F.wave, NGW = F.G * NWAVES;
    constexpr int I_IN = (D / 64) * (NZ / 32), I_OUT = (MIXW / 64) * (D / 32), I_PW = (256 / 64) * (256 / 32);
    constexpr int NITEMS = DEPTH * (I_IN + I_OUT + 4 * I_PW);
    for (int it = gw; it < NITEMS; it += NGW) {
        int r = it;
        if (r < DEPTH * I_IN) { const int l = r / I_IN; p0_transpose_item(P_win + (size_t)l * D * NZ, D, NZ, P_WIN + (size_t)l * NZ * D, scr, r % I_IN, F.lane); continue; } r -= DEPTH * I_IN;
        if (r < DEPTH * I_OUT) { const int l = r / I_OUT; p0_transpose_item(P_wout + (size_t)l * MIXW * D, MIXW, D, P_WOUT + (size_t)l * D * MIXW, scr, r % I_OUT, F.lane); continue; } r -= DEPTH * I_OUT;
        { const int lg = r / I_PW; p0_transpose_item(P_poolw + (size_t)lg * 65536, 256, 256, P_WPOOL + (size_t)lg * 65536, scr, r % I_PW, F.lane); }
    }
    if (blockIdx.x == 0) for (int j = F.tid; j < 1024; j += NWAVES * 64) { const float a0 = P_hlb[j], a1 = P_hlb[1024 + j]; P_lb[j] = 0.f; P_lb[1024 + j] = 1.0f / (1.0f + __expf(a0 - a1)); }
    constexpr int AITEMS = DEPTH * (3 * D / 8);
    for (int it = NGW - 1 - gw; it < AITEMS; it += NGW) {
        const int l = it / (3 * D / 8), n0 = (it % (3 * D / 8)) * 8;
        float acc[16][8];
#pragma unroll
        for (int b = 0; b < 16; ++b)
#pragma unroll
            for (int j = 0; j < 8; ++j) acc[b][j] = 0.f;
        for (int i = 0; i < 16; ++i) {
            const int k = F.lane + 64 * i;
            const float* wp = P_adaw + ((size_t)l * D + k) * (3 * D) + n0;
            const f32x4 w0 = *(const f32x4*)wp, w1 = *(const f32x4*)(wp + 4);
#pragma unroll
            for (int b = 0; b < 16; ++b) { const float cv = P_c[b * D + k], s = cv * __builtin_amdgcn_rcpf(1.0f + __expf(-cv));
#pragma unroll
                for (int j = 0; j < 4; ++j) { acc[b][j] += s * w0[j]; acc[b][4 + j] += s * w1[j]; } }
        }
#pragma unroll
        for (int b = 0; b < 16; ++b)
#pragma unroll
            for (int j = 0; j < 8; ++j) { const float t = wave_sum(acc[b][j]); if (F.lane == ((b * 8 + j) & 63)) P_mod[((size_t)l * BATCH + b) * (3 * D) + n0 + j] = t + P_adab[l * 3 * D + n0 + j]; }
    }
}

__device__ __forceinline__ void rowpass(Frame& F, int l) {
    REFRESH_IDS(F);
    const KArgs ka = kargs(); const float* P_x = ka->in[IN_X]; float* P_out = ka->out; bf16* P_Y = (bf16*)(ka->ws + WS_Y); float* P_mod = (float*)(ka->ws + WS_MOD); const float* P_npost = ka->in[IN_NPOST]; const float* P_npre = ka->in[IN_NPRE]; bf16* P_XN = (bf16*)(ka->ws + WS_XN);
    const int gw = blockIdx.x * NWAVES + F.wave, NGW = F.G * NWAVES;
    const int ln = l + 1;
    for (int m = gw; m < M; m += NGW) {
        const int b = m / SEQ;
        f32x4 v[4];
        const float* xin = (l <= 0 ? P_x : (const float*)P_out) + (size_t)m * D;
#pragma unroll
        for (int j = 0; j < 4; ++j) v[j] = *((const GAS f32x4*)xin + F.lane + 64 * j);
        if (l >= 0) {
            const GAS v2u* yr = (const GAS v2u*)(P_Y + (size_t)m * D) + F.lane;
            f32x4 y[4]; float ss = 0.f;
#pragma unroll
            for (int j = 0; j < 4; ++j) { const v2u w = yr[64 * j]; y[j] = (f32x4){bflo(w.x), bfhi(w.x), bflo(w.y), bfhi(w.y)}; ss += (y[j].x * y[j].x + y[j].y * y[j].y) + (y[j].z * y[j].z + y[j].w * y[j].w); }
            const float r = __builtin_amdgcn_rsqf(wave_sum(ss) * (1.f / D) + EPS);
            const float* gate = P_mod + ((size_t)l * BATCH + b) * (3 * D) + 2 * D;
            const float* wp = P_npost + l * D;
#pragma unroll
            for (int j = 0; j < 4; ++j) { const f32x4 g = *((const f32x4*)gate + F.lane + 64 * j), w = *((const f32x4*)wp + F.lane + 64 * j); v[j] = v[j] + g * (y[j] * r * w);
                *((GAS f32x4*)(P_out + (size_t)m * D) + F.lane + 64 * j) = v[j]; }
        }
        if (ln < DEPTH) {
            float ss = 0.f;
#pragma unroll
            for (int j = 0; j < 4; ++j) ss += (v[j].x * v[j].x + v[j].y * v[j].y) + (v[j].z * v[j].z + v[j].w * v[j].w);
            const float r = __builtin_amdgcn_rsqf(wave_sum(ss) * (1.f / D) + EPS);
            const float* shift = P_mod + ((size_t)ln * BATCH + b) * (3 * D); const float* scale = shift + D; const float* wp = P_npre + ln * D;
            GAS v2u* o = (GAS v2u*)(P_XN + (size_t)m * D) + F.lane;
#pragma unroll
            for (int j = 0; j < 4; ++j) { const f32x4 sh = *((const f32x4*)shift + F.lane + 64 * j), sc = *((const f32x4*)scale + F.lane + 64 * j), w = *((const f32x4*)wp + F.lane + 64 * j);
                const f32x4 h = v[j] * r * w * (sc + 1.0f) + sh; v2u pw; pw.x = pk2(h.x, h.y); pw.y = pk2(h.z, h.w); o[64 * j] = pw; }
        }
    }
}

__device__ __forceinline__ void dpass(Frame& F) {
    REFRESH_IDS(F);
    const KArgs ka = kargs(); bf16* P_U = (bf16*)(ka->ws + WS_U); bf16* DP = (bf16*)(ka->ws + WS_XN);
    constexpr int RUN = 32;
    const int g = F.tid >> 7, w = 2 << g;
    for (int run = blockIdx.x; run < M / RUN; run += F.G) {
        const int t0 = run * RUN, tp0 = t0 & (SEQ - 1);
        const GAS unsigned* up = (const GAS unsigned*)(P_U + (size_t)t0 * D) + F.tid;
        GAS unsigned* dp = (GAS unsigned*)(DP + (size_t)t0 * D) + F.tid;
        float s0 = 0.f, s1 = 0.f;
        for (int i = 1; i < w; ++i) if (tp0 - i >= 0) { const unsigned xw = up[-(long)i * (D / 2)]; s0 += bflo(xw); s1 += bfhi(xw); }
        for (int r = 0; r < RUN; ++r) {
            const unsigned xw = up[(long)r * (D / 2)]; const float x0 = bflo(xw), x1 = bfhi(xw); s0 += x0; s1 += x1;
            const int tp = tp0 + r;
            const float inv = 1.0f / (float)(tp + 1 < w ? tp + 1 : w);
            dp[(long)r * (D / 2)] = pk2(s0 * inv - x0, s1 * inv - x1);
            if (tp + 1 >= w) { const unsigned yw = up[(long)(r + 1 - w) * (D / 2)]; s0 -= bflo(yw); s1 -= bfhi(yw); }
        }
    }
}

__device__ __forceinline__ void hgrn_naive(Frame& F, int l) {
    REFRESH_IDS(F);
    const KArgs ka = kargs(); const float* P_hnw = ka->in[IN_HNW]; bf16* P_Q = (bf16*)(ka->ws + WS_Q); bf16* P_LF = (bf16*)(ka->ws + WS_LF); bf16* P_V = (bf16*)(ka->ws + WS_V); bf16* P_MIX = (bf16*)(ka->ws + WS_MIX);
    LAS float* qs = (LAS float*)(F.lds + RING_OFF);
    LAS float* fs = qs + 2048; LAS float* ks = fs + 2048; LAS float* vs = ks + 2048;
    LAS float* part = vs + 2048;
    const int v = F.tid & 127, kg = F.tid >> 7;
    const float* nw = P_hnw + l * HD;
    for (int unit = blockIdx.x; unit < BATCH * NHEAD; unit += F.G) {
        const int b = unit / NHEAD, h = unit % NHEAD;
        float S[32];
#pragma unroll
        for (int i = 0; i < 32; ++i) S[i] = 0.f;
        const size_t rb = (size_t)b * SEQ;
        for (int t0 = 0; t0 < SEQ; t0 += 16) {
            { const int tt = F.tid >> 5, ch = (F.tid & 31) * 4; const size_t off = (rb + t0 + tt) * D + h * HD + ch;
              const v2u qw = *(const GAS v2u*)(P_Q + off), lw = *(const GAS v2u*)(P_LF + off), vw = *(const GAS v2u*)(P_V + off);
              const float lf[4] = {h2f_lo(lw.x), h2f_hi(lw.x), h2f_lo(lw.y), h2f_hi(lw.y)};
              const float qq[4] = {bflo(qw.x), bfhi(qw.x), bflo(qw.y), bfhi(qw.y)}, vv[4] = {bflo(vw.x), bfhi(vw.x), bflo(vw.y), bfhi(vw.y)};
#pragma unroll
              for (int e = 0; e < 4; ++e) { const float f = __expf(lf[e]); fs[tt * 128 + ch + e] = f; ks[tt * 128 + ch + e] = 1.0f - f; qs[tt * 128 + ch + e] = qq[e]; vs[tt * 128 + ch + e] = vv[e]; } }
            __syncthreads();
            for (int tt = 0; tt < 16; ++tt) {
                const float vv = vs[tt * 128 + v]; float po = 0.f;
#pragma unroll
                for (int i = 0; i < 32; ++i) { const float f = fs[tt * 128 + kg * 32 + i], k = ks[tt * 128 + kg * 32 + i], q = qs[tt * 128 + kg * 32 + i]; S[i] = f * S[i] + k * vv; po += q * S[i]; }
                part[(tt * 4 + kg) * 128 + v] = po;
            }
            __syncthreads();
#pragma unroll
            for (int e = 0; e < 2; ++e) { const int tt = F.wave * 2 + e;
                float o0 = 0.f, o1 = 0.f;
#pragma unroll
                for (int k4 = 0; k4 < 4; ++k4) { o0 += part[(tt * 4 + k4) * 128 + F.lane]; o1 += part[(tt * 4 + k4) * 128 + 64 + F.lane]; }
                const float r = __builtin_amdgcn_rsqf(wave_sum(o0 * o0 + o1 * o1) * (1.f / HD) + EPS);
                GAS bf16* gp = (GAS bf16*)(P_MIX + (rb + t0 + tt) * MIXW + D + h * HD);
                const float g0 = __uint_as_float((unsigned)gp[F.lane] << 16), g1 = __uint_as_float((unsigned)gp[64 + F.lane] << 16);
                gp[F.lane] = (bf16)f2bf(o0 * r * nw[F.lane] * g0); gp[64 + F.lane] = (bf16)f2bf(o1 * r * nw[64 + F.lane] * g1); }
        }
        __syncthreads();
    }
}

__global__ void __launch_bounds__(NWAVES * 64, 2) skel_fwd(Args args) {
    extern __shared__ __attribute__((aligned(16))) unsigned char lds[];
    Frame F;
    F.lds = (LAS unsigned char*)lds;
    F.MISC = (volatile LAS unsigned*)(F.lds + MISC_OFF);
    F.tid = threadIdx.x; F.lane = F.tid & 63; F.wave = __builtin_amdgcn_readfirstlane(F.tid >> 6);
    F.G = gridDim.x;
    F.ctl = (gu32*)(args.ws + WS_CTL);
    for (int u = F.tid; u < (LDS_BYTES - LDSCTL_OFF) / 4; u += NWAVES * 64) ((LAS unsigned*)(F.lds + LDSCTL_OFF))[u] = 0u;
    __syncthreads();
    XcdBarrier bar; bar.bar = (unsigned*)(F.ctl + CW_BAR); bar.x = 0; bar.st = nullptr;
    if (N_LAUNCHES == 1) bar = xcd_barrier_post((unsigned*)(F.ctl + CW_BAR), F.MISC + 8);
#define GRID_BAR() do { if (N_LAUNCHES == 1) xcd_barrier(bar); } while (0)
    const int lo = args.ph_lo, hi = args.ph_hi;
#ifndef DBG_KINDS
#define DBG_KINDS 0x7f
#endif
#define KIND(j) ((DBG_KINDS >> (j)) & 1)
#define IN(k) (lo <= (k) && (k) < hi)
#define BOTH(k) (IN(k) && IN((k) + 1))

    if (KIND(0) && IN(0)) { p0_prologue(F); if (BOTH(0)) GRID_BAR(); }
    if (KIND(1) && IN(1)) { rowpass(F, -1); if (BOTH(1)) GRID_BAR(); }
#pragma unroll
    for (int l = 0; l < DEPTH; ++l) {
        const int p = 2 + 5 * l;
        if (KIND(2) && IN(p)) {
            const KArgs ka = kargs(); bf16* P_XN = (bf16*)(ka->ws + WS_XN); bf16* P_WIN = (bf16*)(ka->ws + WS_WIN);
            pg8::Gemm g{P_XN, P_WIN + (size_t)l * NZ * D, M, NZ, D, D, 0}; pg8::StaticOrder S; S.init(M, NZ, F.G, (int)blockIdx.x);
            pg8::EpiZ E{l};
            pg8::gemm_phase<pg8::EpiZ, pg8::StaticOrder, PG8_ALIGN, PG8_SP2>(F.lds + RING_OFF, g, S, E);
            if (BOTH(p)) GRID_BAR();
        }
        if (KIND(3) && IN(p + 1)) {
            dpass(F);
            hgrn_naive(F, l);
            if (BOTH(p + 1)) GRID_BAR();
        }
        if (KIND(4) && IN(p + 2)) {
            const KArgs ka = kargs(); bf16* P_XN = (bf16*)(ka->ws + WS_XN); bf16* P_WPOOL = (bf16*)(ka->ws + WS_WPOOL);
            pg8::Gemm g{P_XN, P_WPOOL + (size_t)l * 4 * 65536, M, D, 256, D, 256}; pg8::StaticOrder S; S.init(M, D, F.G, (int)blockIdx.x);
            pg8::EpiPool E{l};
            pg8::gemm_phase<pg8::EpiPool, pg8::StaticOrder, PG8_ALIGN, PG8_SP2>(F.lds + RING_OFF, g, S, E);
            if (BOTH(p + 2)) GRID_BAR();
        }
        if (KIND(5) && IN(p + 3)) {
            const KArgs ka = kargs(); bf16* P_MIX = (bf16*)(ka->ws + WS_MIX); bf16* P_WOUT = (bf16*)(ka->ws + WS_WOUT);
            pg8::Gemm g{P_MIX, P_WOUT + (size_t)l * D * MIXW, M, D, MIXW, MIXW, 0}; pg8::StaticOrder S; S.init(M, D, F.G, (int)blockIdx.x);
            pg8::EpiBf16Plain E{WS_Y, D};
            pg8::gemm_phase<pg8::EpiBf16Plain, pg8::StaticOrder, PG8_ALIGN, PG8_SP2>(F.lds + RING_OFF, g, S, E);
            if (BOTH(p + 3)) GRID_BAR();
        }
        if (KIND(6) && IN(p + 4)) {
            rowpass(F, l);
            if (BOTH(p + 4)) GRID_BAR();
        }
    }
#undef IN
#undef BOTH
}

extern "C" void kernel_launch(void* const* d_in, const int* in_sizes, int n_in, void* d_out, int out_size, void* d_ws, size_t ws_size, hipStream_t stream) {
    static int grid = 0;
    if (grid == 0) {
        if (n_in != 12 || in_sizes[0] != M * D || out_size != M * D || ws_size < WS_END) { fprintf(stderr, "kernel_launch: unexpected shapes: n_in %d in0 %d out %d ws %zu\n", n_in, n_in > 0 ? in_sizes[0] : -1, out_size, ws_size); grid = -1; return; }
        int dev = 0, cus = 0, per_cu = 0;
        if (hipGetDevice(&dev) != hipSuccess || hipDeviceGetAttribute(&cus, hipDeviceAttributeMultiprocessorCount, dev) != hipSuccess) { grid = -1; return; }
        if (hipFuncSetAttribute((const void*)skel_fwd, hipFuncAttributeMaxDynamicSharedMemorySize, LDS_BYTES) != hipSuccess) { fprintf(stderr, "kernel_launch: hipFuncSetAttribute failed\n"); grid = -1; return; }
        if (hipOccupancyMaxActiveBlocksPerMultiprocessor(&per_cu, (const void*)skel_fwd, NWAVES * 64, LDS_BYTES) != hipSuccess || per_cu < 1) { fprintf(stderr, "kernel_launch: occupancy query says %d blocks per CU\n", per_cu); per_cu = 1; }
        (void)hipGetLastError();
        grid = cus;
    }
    if (grid < 0) return;
    if (hipMemsetAsync((char*)d_ws + WS_CTL, 0, CTL_ZERO_BYTES, stream) != hipSuccess) { fprintf(stderr, "kernel_launch: memset failed\n"); return; }
    Args a{};
    for (int i = 0; i < 12; ++i) a.in[i] = (const float*)d_in[i];
    a.out = (float*)d_out; a.ws = (unsigned char*)d_ws;
    for (int li = 0; li < N_LAUNCHES; ++li) {
        a.ph_lo = (N_LAUNCHES == 1) ? 0 : li; a.ph_hi = (N_LAUNCHES == 1) ? N_PHASES : li + 1; a.li = li;
        hipLaunchKernelGGL(skel_fwd, dim3(grid), dim3(NWAVES * 64), LDS_BYTES, stream, a);
        const hipError_t le = hipPeekAtLastError();
        if (le != hipSuccess) { fprintf(stderr, "kernel_launch: launch %d failed: %s\n", li, hipGetErrorName(le)); break; }
    }
}
```

```cpp
#include <hip/hip_runtime.h>
#include <cstdio>
#include <cstdint>

#ifndef MK_N_LAUNCHES
#define MK_N_LAUNCHES 1
#endif

constexpr int NWAVES = 8;
constexpr int N_LAUNCHES = MK_N_LAUNCHES;
constexpr int BATCH = 16, SEQ = 2048, D = 1024, DEPTH = 2, NZ = 6144, MIXW = 2048, NHEAD = 8, HD = 128;
constexpr int M = BATCH * SEQ;
constexpr float EPS = 1e-6f;
constexpr int N_PHASES = 2 + 5 * DEPTH;

constexpr size_t MiB = 1u << 20;
constexpr size_t WS_CTL = 0, CTL_ZERO_BYTES = 1 * MiB;
constexpr size_t WS_MOD = 1 * MiB;
constexpr size_t WS_LB = 1 * MiB + 512 * 1024;
constexpr size_t WS_WIN = 2 * MiB;
constexpr size_t WS_WOUT = 26 * MiB;
constexpr size_t WS_WPOOL = 34 * MiB;
constexpr size_t WS_XN = 36 * MiB;
constexpr size_t WS_U = 100 * MiB, WS_Q = 164 * MiB, WS_LF = 228 * MiB, WS_V = 292 * MiB;
constexpr size_t WS_MIX = 356 * MiB;
constexpr size_t WS_Y = WS_U;
constexpr size_t WS_END = 484 * MiB;
constexpr int CW_TMO = 0, CW_CODE = 1;
constexpr int CW_BAR = 4096;


struct Args { const float* in[12]; float* out; unsigned char* ws; int ph_lo, ph_hi, li, pad; };
typedef const __attribute__((address_space(4))) Args* KArgs;
__device__ __forceinline__ KArgs kargs() { KArgs p = (KArgs)__builtin_amdgcn_kernarg_segment_ptr(); asm volatile("" : "+s"(p)); return p; }
enum { IN_X = 0, IN_C, IN_NPRE, IN_ADAW, IN_ADAB, IN_WIN, IN_POOLW, IN_PSCALE, IN_HLB, IN_HNW, IN_WOUT, IN_NPOST };

namespace pg8 {
#define PG8_LAS __attribute__((address_space(3)))
typedef unsigned short bf16_t;
typedef short bf16x8 __attribute__((ext_vector_type(8)));
typedef float f32x4 __attribute__((ext_vector_type(4)));
typedef unsigned u32x4 __attribute__((ext_vector_type(4)));
constexpr int BM = 256, BK = 64, HALF = 128, HTB = HALF * BK * 2  , STAGE_BYTES = 8 * HTB, NXCD = 8, WGM = 8;

__host__ __device__ __forceinline__ int lds_byte(int r, int c) { const int st = (r >> 4) * 2 + (c >> 5), rr = r & 15, cc = c & 31, ob = rr * 64 + cc * 2; return st * 1024 + (ob ^ (((ob >> 9) & 1) << 5)); }
__host__ __device__ __forceinline__ void stage_rc(int b, int& R, int& C) { const int st = b / 1024, sb = b % 1024, swz = sb ^ (((sb >> 9) & 1) << 5); R = (st >> 1) * 16 + swz / 64; C = (st & 1) * 32 + (swz % 64) / 2; }
__host__ __device__ __forceinline__ int perm32(int rho) { const int n = rho >> 4, i = rho & 15; return 8 * (i >> 2) + 4 * n + (i & 3); }

struct Unit { int pm, pn; };
struct Gemm { const bf16_t* A; const bf16_t* Bt; int M, N, K, lda, acol; };

struct StaticOrder {
    int nM, nN, nwg, G, c;
    __host__ __device__ void init(int M, int N, int G_, int c_) { nM = M / BM; nN = N / BM; nwg = nM * nN; G = G_; c = c_; }
    __host__ __device__ bool next(int i, Unit& u) const {
        const long L = (long)i * G + c; if (L >= nwg) return false;
        int wgid = (int)L; { const int q = nwg / NXCD, r = nwg % NXCD, xcd = wgid % NXCD, off = wgid / NXCD; wgid = (xcd < r ? xcd * (q + 1) : r * (q + 1) + (xcd - r) * q) + off; }
        const int nig = WGM * nN, gid = wgid / nig, fm = gid * WGM, gsz = (nM - fm) < WGM ? (nM - fm) : WGM;
        u.pm = fm + ((wgid % nig) % gsz); u.pn = (wgid % nig) / gsz; return true;
    }
    __device__ __forceinline__ void a_ready(const Unit&) const {}
    __device__ __forceinline__ void done(const Unit&) const {}
};

__device__ __forceinline__ unsigned cvt_pk_bf16(float lo, float hi) { unsigned r; asm volatile("v_cvt_pk_bf16_f32 %0, %1, %2" : "=v"(r) : "v"(lo), "v"(hi)); return r; }
__device__ __forceinline__ unsigned cvt_pk_f16(float lo, float hi) { typedef _Float16 h2 __attribute__((ext_vector_type(2))); h2 v; v.x = (_Float16)lo; v.y = (_Float16)hi; return __builtin_bit_cast(unsigned, v); }
__device__ __forceinline__ float bf_lo(unsigned w) { return __uint_as_float(w << 16); }
__device__ __forceinline__ float bf_hi(unsigned w) { return __uint_as_float(w & 0xffff0000u); }
__device__ __forceinline__ float sigmoid_f(float x) { return __builtin_amdgcn_rcpf(1.0f + __expf(-x)); }

struct EpiBf16Plain {
    static constexpr bool PERM = true, AFTER_DRAIN = false;
    size_t ws_off; int ldc;
    __device__ __forceinline__ void operator()(const f32x4 (&acc)[2][2][4][2], const Unit& u, int wr, int wc, int fr, int fq) const {
        const int row0 = u.pm * BM + wr * 64 + fr, col0 = u.pn * BM + wc * 32 + 8 * fq;
        bf16_t* O = (bf16_t*)(kargs()->ws + ws_off);
#pragma unroll
        for (int ai = 0; ai < 2; ++ai)
#pragma unroll
            for (int m = 0; m < 4; ++m) { bf16_t* rowp = O + (size_t)(row0 + ai * HALF + m * 16) * ldc + col0;
#pragma unroll
                for (int bj = 0; bj < 2; ++bj) { const f32x4 v0 = acc[ai][bj][m][0], v1 = acc[ai][bj][m][1];
                    u32x4 w; w.x = cvt_pk_bf16(v0[0], v0[1]); w.y = cvt_pk_bf16(v0[2], v0[3]); w.z = cvt_pk_bf16(v1[0], v1[1]); w.w = cvt_pk_bf16(v1[2], v1[3]);
                    *(u32x4*)(rowp + bj * HALF) = w; } }
    }
};

struct EpiZ {
    static constexpr bool PERM = true, AFTER_DRAIN = false;
    int l;
    template <int ACT> __device__ __forceinline__ void tile(const f32x4 (&acc)[2][2][4][2], bf16_t* base, int ldc, int row0, int col0, const float* lb) const {
        f32x4 lbv[2][2];
        if (ACT == 2) {
#pragma unroll
            for (int bj = 0; bj < 2; ++bj)
#pragma unroll
                for (int n = 0; n < 2; ++n) lbv[bj][n] = *(const f32x4*)(lb + col0 + bj * HALF + 4 * n);
        }
#pragma unroll
        for (int ai = 0; ai < 2; ++ai)
#pragma unroll
            for (int m = 0; m < 4; ++m) { bf16_t* rowp = base + (size_t)(row0 + ai * HALF + m * 16) * ldc + col0;
#pragma unroll
                for (int bj = 0; bj < 2; ++bj) { f32x4 v[2] = {acc[ai][bj][m][0], acc[ai][bj][m][1]};
                    u32x4 w;
                    if (ACT == 1) {
#pragma unroll
                        for (int n = 0; n < 2; ++n)
#pragma unroll
                            for (int e = 0; e < 4; ++e) v[n][e] = v[n][e] * sigmoid_f(v[n][e]);
                    }
                    if (ACT == 2) {
#pragma unroll
                        for (int n = 0; n < 2; ++n)
#pragma unroll
                            for (int e = 0; e < 4; ++e) { const float x = fminf(fmaxf(v[n][e], -30.f), 30.f), l = lbv[bj][n][e]; v[n][e] = __logf(l + (1.0f - l) * sigmoid_f(x)); }
                        w.x = cvt_pk_f16(v[0][0], v[0][1]); w.y = cvt_pk_f16(v[0][2], v[0][3]); w.z = cvt_pk_f16(v[1][0], v[1][1]); w.w = cvt_pk_f16(v[1][2], v[1][3]);
                    } else {
                        w.x = cvt_pk_bf16(v[0][0], v[0][1]); w.y = cvt_pk_bf16(v[0][2], v[0][3]); w.z = cvt_pk_bf16(v[1][0], v[1][1]); w.w = cvt_pk_bf16(v[1][2], v[1][3]);
                    }
                    *(u32x4*)(rowp + bj * HALF) = w; }
                if (ACT != 0) __builtin_amdgcn_sched_barrier(0); }
    }
    __device__ __forceinline__ void operator()(const f32x4 (&acc)[2][2][4][2], const Unit& u, int wr, int wc, int fr, int fq) const {
        const int seg = u.pn >> 2, row0 = u.pm * BM + wr * 64 + fr, col0 = (u.pn & 3) * BM + wc * 32 + 8 * fq;
        unsigned char* ws = kargs()->ws; const float* lb = (const float*)(ws + WS_LB) + l * 1024;
        const size_t off = seg == 0 ? WS_U : seg == 2 ? WS_Q : seg == 3 ? WS_LF : seg == 4 ? WS_V : seg == 1 ? WS_MIX : WS_MIX + 2048;
        const int ldc = (seg == 1 || seg == 5) ? 2048 : 1024;
        bf16_t* base = (bf16_t*)(ws + off);
        if (seg == 3) tile<2>(acc, base, ldc, row0, col0, lb);
        else if (seg == 1 || seg == 5) tile<1>(acc, base, ldc, row0, col0, lb);
        else tile<0>(acc, base, ldc, row0, col0, lb);
    }
};

struct EpiPool {
    static constexpr bool PERM = true, AFTER_DRAIN = false;
    int l;
    __device__ __forceinline__ void operator()(const f32x4 (&acc)[2][2][4][2], const Unit& u, int wr, int wc, int fr, int fq) const {
        const int row0 = u.pm * BM + wr * 64 + fr, col0 = u.pn * BM + wc * 32 + 8 * fq;
        const KArgs ka = kargs(); bf16_t* MIX = (bf16_t*)(ka->ws + WS_MIX); const float* pscale = ka->in[IN_PSCALE] + l * 1024;
        f32x4 sv[2][2];
#pragma unroll
        for (int bj = 0; bj < 2; ++bj)
#pragma unroll
            for (int n = 0; n < 2; ++n) sv[bj][n] = *(const f32x4*)(pscale + col0 + bj * HALF + 4 * n);
#pragma unroll
        for (int ai = 0; ai < 2; ++ai)
#pragma unroll
            for (int m = 0; m < 4; ++m) { bf16_t* rowp = MIX + (size_t)(row0 + ai * HALF + m * 16) * 2048 + col0;
#pragma unroll
                for (int bj = 0; bj < 2; ++bj) { const u32x4 gw = *(const u32x4*)(rowp + bj * HALF);
                    const f32x4 v0 = acc[ai][bj][m][0] * sv[bj][0], v1 = acc[ai][bj][m][1] * sv[bj][1];
                    u32x4 w; w.x = cvt_pk_bf16(v0[0] * bf_lo(gw.x), v0[1] * bf_hi(gw.x)); w.y = cvt_pk_bf16(v0[2] * bf_lo(gw.y), v0[3] * bf_hi(gw.y));
                    w.z = cvt_pk_bf16(v1[0] * bf_lo(gw.z), v1[1] * bf_hi(gw.z)); w.w = cvt_pk_bf16(v1[2] * bf_lo(gw.w), v1[3] * bf_hi(gw.w));
                    *(u32x4*)(rowp + bj * HALF) = w; }
                if (m & 1) asm volatile("" ::: "memory"); }
    }
};

template <class Epi, class Sched, bool ALIGN_EPI = false, bool SP2 = false>
__device__ __forceinline__ void gemm_phase(PG8_LAS unsigned char* lds, const Gemm g, const Sched& S, const Epi& E, const int tid_in) {
    int tid_ = tid_in; asm volatile("" : "+v"(tid_));
    const int tid = tid_, wid = __builtin_amdgcn_readfirstlane(tid >> 6), lane = tid & 63, wr = wid >> 2, wc = wid & 3, fr = lane & 15, fq = lane >> 4;
    const int K = g.K, nt = K / BK;
    unsigned voffA[2], voffB[2];
#pragma unroll
    for (int i = 0; i < 2; ++i) { int R, C; stage_rc(tid * 16 + i * 8192, R, C); const int Rb = Epi::PERM ? ((R & ~31) + perm32(R & 31)) : R;
        voffA[i] = (unsigned)(R * g.lda + C) * 2u; voffB[i] = (unsigned)(Rb * K + C) * 2u; }
    const size_t kstep = (size_t)(BK * 2);
    const size_t hstepA = (size_t)HALF * g.lda * 2, hstepB = (size_t)HALF * K * 2;
    const size_t tstepA = 2 * hstepA, tstepB = 2 * hstepB;
    const size_t acolB = (size_t)g.acol * 2;
    const unsigned ldsw = (unsigned)wid * 1024u;
    const int aoff = lds_byte(wr * 64 + fr, fq * 8), boff = lds_byte(wc * 32 + fr, fq * 8);
#define PG8_SA(b, h) (((b) * 2 + (h)) * HTB)
#define PG8_SB(b, h) ((4 + (b) * 2 + (h)) * HTB)
#define PG8_STAGE(bufoff, gbase, voff) do { _Pragma("unroll") for (int _i = 0; _i < 2; ++_i) \
        __builtin_amdgcn_global_load_lds((const unsigned*)((const char*)(gbase) + (voff)[_i]), (PG8_LAS unsigned*)(lds + (bufoff) + ldsw + _i * 8192), 16, 0, 0); } while (0)
#define PG8_LDA(dst, b, h) do { _Pragma("unroll") for (int m = 0; m < 4; ++m) _Pragma("unroll") for (int k = 0; k < 2; ++k) dst[m][k] = *(const PG8_LAS bf16x8*)(lds + PG8_SA(b, h) + aoff + m * 2048 + k * 1024); } while (0)
#define PG8_LDB(dst, b, h) do { _Pragma("unroll") for (int n = 0; n < 2; ++n) _Pragma("unroll") for (int k = 0; k < 2; ++k) dst[n][k] = *(const PG8_LAS bf16x8*)(lds + PG8_SB(b, h) + boff + n * 2048 + k * 1024); } while (0)
#define PG8_MMA(ai, bj, At, Bt) do { __builtin_amdgcn_s_setprio(1); _Pragma("unroll") for (int m = 0; m < 4; ++m) _Pragma("unroll") for (int n = 0; n < 2; ++n) _Pragma("unroll") for (int k = 0; k < 2; ++k) \
        acc[ai][bj][m][n] = __builtin_amdgcn_mfma_f32_16x16x32_bf16(Bt[n][k], At[m][k], acc[ai][bj][m][n], 0, 0, 0); __builtin_amdgcn_s_setprio(0); } while (0)
#define PG8_WAIT_V(n) asm volatile("s_waitcnt vmcnt(" #n ")" ::: "memory")
#define PG8_WAIT_L(n) asm volatile("s_waitcnt lgkmcnt(" #n ")" ::: "memory")
#define PG8_BAR __builtin_amdgcn_s_barrier()
#define PG8_SCHED __builtin_amdgcn_sched_barrier(0)
    Unit cur, nxt; int ui = 0;
    if (!S.next(0, cur)) return;
    f32x4 acc[2][2][4][2];
#pragma unroll
    for (int a = 0; a < 2; ++a)
#pragma unroll
        for (int b = 0; b < 2; ++b)
#pragma unroll
            for (int m = 0; m < 4; ++m)
#pragma unroll
                for (int n = 0; n < 2; ++n) acc[a][b][m][n] = (f32x4){0.f, 0.f, 0.f, 0.f};
    bf16x8 At[4][2], B0[2][2], B1[2][2];
    const char* cA = (const char*)g.A + (size_t)cur.pm * tstepA + (size_t)cur.pn * acolB; const char* cB = (const char*)g.Bt + (size_t)cur.pn * tstepB;
    S.a_ready(cur);
    if constexpr (SP2) {
        PG8_STAGE(PG8_SB(0, 0), cB, voffB); PG8_STAGE(PG8_SB(0, 1), cB + hstepB, voffB); PG8_STAGE(PG8_SA(0, 0), cA, voffA); PG8_STAGE(PG8_SA(0, 1), cA + hstepA, voffA);
        if (wr == 1) PG8_BAR;
        PG8_WAIT_V(2); PG8_BAR;
        PG8_STAGE(PG8_SB(1, 0), cB + kstep, voffB); PG8_STAGE(PG8_SA(1, 0), cA + kstep, voffA); PG8_STAGE(PG8_SB(1, 1), cB + hstepB + kstep, voffB);
        PG8_WAIT_V(6); PG8_BAR;
    } else {
        PG8_STAGE(PG8_SB(0, 0), cB, voffB); PG8_STAGE(PG8_SA(0, 0), cA, voffA); PG8_STAGE(PG8_SB(0, 1), cB + hstepB, voffB); PG8_STAGE(PG8_SA(0, 1), cA + hstepA, voffA);
        if (wr == 1) PG8_BAR;
        PG8_WAIT_V(4); PG8_BAR;
        PG8_STAGE(PG8_SB(1, 0), cB + kstep, voffB); PG8_STAGE(PG8_SA(1, 0), cA + kstep, voffA); PG8_STAGE(PG8_SB(1, 1), cB + hstepB + kstep, voffB);
        PG8_WAIT_V(6); PG8_BAR;
    }
    for (;;) {
        const bool has_next = S.next(ui + 1, nxt);
        const char* nA = has_next ? (const char*)g.A + (size_t)nxt.pm * tstepA + (size_t)nxt.pn * acolB : cA; const char* nB = has_next ? (const char*)g.Bt + (size_t)nxt.pn * tstepB : cB;
        for (int t = 0; t < nt; t += 2) {
            const bool last = (t == nt - 2);
            const char* a1 = cA + (size_t)(t + 1) * kstep;
            const char* a2 = last ? nA : cA + (size_t)(t + 2) * kstep; const char* b2 = last ? nB : cB + (size_t)(t + 2) * kstep;
            const char* a3 = a2 + kstep; const char* b3 = b2 + kstep;
            if (last && has_next) S.a_ready(nxt);
            if constexpr (SP2) {
            PG8_LDB(B0, 0, 0); PG8_LDB(B1, 0, 1); PG8_SCHED; PG8_LDA(At, 0, 0); PG8_STAGE(PG8_SA(1, 1), a1 + hstepA, voffA);
            PG8_WAIT_V(8); PG8_WAIT_L(0); PG8_BAR; PG8_MMA(0, 0, At, B0); PG8_MMA(0, 1, At, B1); PG8_BAR; PG8_SCHED;
            PG8_LDA(At, 0, 1); PG8_STAGE(PG8_SB(0, 0), b2, voffB); PG8_STAGE(PG8_SB(0, 1), b2 + hstepB, voffB); PG8_STAGE(PG8_SA(0, 0), a2, voffA);
            PG8_WAIT_V(8); PG8_WAIT_L(0); PG8_BAR; PG8_MMA(1, 0, At, B0); PG8_MMA(1, 1, At, B1); PG8_BAR; PG8_SCHED;
            PG8_LDB(B0, 1, 0); PG8_LDB(B1, 1, 1); PG8_SCHED; PG8_LDA(At, 1, 0); PG8_STAGE(PG8_SA(0, 1), a2 + hstepA, voffA);
            PG8_WAIT_V(8); PG8_WAIT_L(0); PG8_BAR; PG8_MMA(0, 0, At, B0); PG8_MMA(0, 1, At, B1); PG8_BAR; PG8_SCHED;
            PG8_LDA(At, 1, 1); PG8_STAGE(PG8_SB(1, 0), b3, voffB); PG8_STAGE(PG8_SB(1, 1), b3 + hstepB, voffB); PG8_STAGE(PG8_SA(1, 0), a3, voffA);
            PG8_WAIT_V(8); PG8_WAIT_L(0); PG8_BAR; PG8_MMA(1, 0, At, B0); PG8_MMA(1, 1, At, B1); PG8_BAR; PG8_SCHED;
            } else {
            PG8_LDB(B0, 0, 0); PG8_SCHED; PG8_LDA(At, 0, 0); PG8_STAGE(PG8_SA(1, 1), a1 + hstepA, voffA);
            PG8_WAIT_L(8); PG8_BAR; PG8_WAIT_L(0); PG8_MMA(0, 0, At, B0); PG8_BAR; PG8_SCHED;
            PG8_LDB(B1, 0, 1); PG8_STAGE(PG8_SB(0, 0), b2, voffB);
            PG8_BAR; PG8_WAIT_L(0); PG8_MMA(0, 1, At, B1); PG8_BAR;
            PG8_LDA(At, 0, 1); PG8_STAGE(PG8_SA(0, 0), a2, voffA);
            PG8_BAR; PG8_WAIT_L(0); PG8_MMA(1, 0, At, B0); PG8_BAR; PG8_SCHED;
            PG8_STAGE(PG8_SB(0, 1), b2 + hstepB, voffB);
            PG8_WAIT_V(6); PG8_BAR; PG8_MMA(1, 1, At, B1); PG8_BAR;
            PG8_LDB(B0, 1, 0); PG8_SCHED; PG8_LDA(At, 1, 0); PG8_STAGE(PG8_SA(0, 1), a2 + hstepA, voffA);
            PG8_WAIT_L(8); PG8_BAR; PG8_WAIT_L(0); PG8_MMA(0, 0, At, B0); PG8_BAR; PG8_SCHED;
            PG8_LDB(B1, 1, 1); PG8_STAGE(PG8_SB(1, 0), b3, voffB);
            PG8_BAR; PG8_WAIT_L(0); PG8_MMA(0, 1, At, B1); PG8_BAR;
            PG8_LDA(At, 1, 1); PG8_STAGE(PG8_SA(1, 0), a3, voffA);
            PG8_BAR; PG8_WAIT_L(0); PG8_MMA(1, 0, At, B0); PG8_BAR; PG8_SCHED;
            PG8_STAGE(PG8_SB(1, 1), b3 + hstepB, voffB);
            PG8_WAIT_V(6); PG8_BAR; PG8_MMA(1, 1, At, B1); PG8_BAR;
            }
        }
        if constexpr (ALIGN_EPI) { if (wr == 0) PG8_BAR; }
        if constexpr (!Epi::AFTER_DRAIN) { E(acc, cur, wr, wc, fr, fq); S.done(cur); }
        if (!has_next) break;
#pragma unroll
        for (int a = 0; a < 2; ++a)
#pragma unroll
            for (int b = 0; b < 2; ++b)
#pragma unroll
                for (int m = 0; m < 4; ++m)
#pragma unroll
                    for (int n = 0; n < 2; ++n) acc[a][b][m][n] = (f32x4){0.f, 0.f, 0.f, 0.f};
        cur = nxt; cA = nA; cB = nB; ++ui;
        if constexpr (ALIGN_EPI) { if (wr == 1) PG8_BAR; }
    }
    PG8_WAIT_V(0);
    if constexpr (!ALIGN_EPI) { if (wr == 0) PG8_BAR; }
    PG8_BAR;
    if constexpr (Epi::AFTER_DRAIN) { E.fused(acc, cur, wr, wc, fr, fq, lds, wid, lane); S.done(cur); }
#undef PG8_SA
#undef PG8_SB
#undef PG8_STAGE
#undef PG8_LDA
#undef PG8_LDB
#undef PG8_MMA
#undef PG8_WAIT_V
#undef PG8_WAIT_L
#undef PG8_BAR
#undef PG8_SCHED
}
}

#define PG8_SP2 true
#define PG8_ALIGN true

constexpr int RING_OFF = 0, RING_BYTES = 131072;
constexpr int LDSCTL_OFF = RING_BYTES, MISC_OFF = LDSCTL_OFF + 320;
constexpr int LDS_BYTES = 147456;

#define GAS __attribute__((address_space(1)))
#define LAS __attribute__((address_space(3)))
typedef unsigned short bf16;
typedef unsigned v4u __attribute__((ext_vector_type(4)));
typedef unsigned v2u __attribute__((ext_vector_type(2)));
typedef float f32x4 __attribute__((ext_vector_type(4)));
typedef short bf16x8 __attribute__((ext_vector_type(8)));
typedef GAS unsigned gu32;
typedef GAS unsigned long long gu64;
#define RLX_AGENT __ATOMIC_RELAXED, __HIP_MEMORY_SCOPE_AGENT
#define LDS_WAIT() asm volatile("s_waitcnt lgkmcnt(0)" ::: "memory")
#define VM_WAIT() asm volatile("s_waitcnt vmcnt(0)" ::: "memory")
__device__ __forceinline__ unsigned f2bf(float f) { unsigned u = __builtin_bit_cast(unsigned, f); return (u + 0x7fffu + ((u >> 16) & 1u)) >> 16; }
__device__ __forceinline__ unsigned pk2(float lo, float hi) { return f2bf(lo) | (f2bf(hi) << 16); }
__device__ __forceinline__ float bflo(unsigned w) { return __uint_as_float(w << 16); }
__device__ __forceinline__ float bfhi(unsigned w) { return __uint_as_float(w & 0xffff0000u); }
__device__ __forceinline__ float h2f_lo(unsigned w) { typedef _Float16 h2 __attribute__((ext_vector_type(2))); return (float)__builtin_bit_cast(h2, w).x; }
__device__ __forceinline__ float h2f_hi(unsigned w) { typedef _Float16 h2 __attribute__((ext_vector_type(2))); return (float)__builtin_bit_cast(h2, w).y; }

#define XB_TMO      128
#define XB_XCNT(j)  (256  + 64 * (j))
#define XB_XSUB(j)  (1280 + 64 * (j))
#define XB_XGEN(j)  (2304 + 64 * (j))
#define XB_TOP      3328
#define XB_TOPGEN   3392
#define XCD_BAR_WORDS 3456
#define XB_SPIN_CAP (1u << 18)

__device__ __forceinline__ unsigned xb_ld(unsigned* p)              { return __hip_atomic_load(p, __ATOMIC_RELAXED, __HIP_MEMORY_SCOPE_AGENT); }
__device__ __forceinline__ unsigned xb_add(unsigned* p, unsigned v) { return __hip_atomic_fetch_add(p, v, __ATOMIC_RELAXED, __HIP_MEMORY_SCOPE_AGENT); }
__device__ __forceinline__ unsigned xb_xcc_id() { return (unsigned)__builtin_amdgcn_s_getreg((3 << 11) | 20) & 0xFu; }
#define XB_SPIN(cond, bar) do { unsigned _sp = 0; while (cond) { __builtin_amdgcn_s_sleep(1); \
    if ((++_sp & 255u) == 0u) { if (xb_ld(&(bar)[XB_TMO])) break; if (_sp > XB_SPIN_CAP) { atomicAdd(&(bar)[XB_TMO], 1u); break; } } } } while (0)

__device__ __forceinline__ int lane_now() { return (int)__builtin_amdgcn_mbcnt_hi(~0u, __builtin_amdgcn_mbcnt_lo(~0u, 0u)); }
struct XcdBarrier { unsigned* bar; unsigned x; volatile LAS unsigned* st; int wave0; };

__device__ __forceinline__ XcdBarrier xcd_barrier_post(unsigned* bar, volatile LAS unsigned* st) {
    XcdBarrier b; b.bar = bar; b.x = xb_xcc_id(); b.st = st; b.wave0 = __builtin_amdgcn_readfirstlane(threadIdx.x >> 6);
    if (threadIdx.x == 0) (void)xb_add(&bar[XB_XCNT(b.x)], 1u);
    return b;
}
__device__ __forceinline__ void xcd_barrier_complete(unsigned* bar, unsigned x, unsigned& nloc, unsigned& nx) {
    const unsigned G = gridDim.x * gridDim.y * gridDim.z;
    unsigned sum, cnt, mine, sp = 0u;
    for (;;) {
        sum = 0u; cnt = 0u; mine = 0u;
#pragma unroll
        for (unsigned j = 0; j < 16; ++j) { const unsigned c = xb_ld(&bar[XB_XCNT(j)]); sum += c; cnt += (c > 0u) ? 1u : 0u; mine = (j == x) ? c : mine; }
        if (sum == G) break;
        __builtin_amdgcn_s_sleep(1);
        if ((++sp & 255u) == 0u) { if (xb_ld(&bar[XB_TMO])) break; if (sp > XB_SPIN_CAP) { atomicAdd(&bar[XB_TMO], 1u); break; } }
    }
    nloc = mine > 0u ? mine : 1u; nx = cnt > 0u ? cnt : 1u;
}
__device__ __forceinline__ void xcd_barrier_census(const XcdBarrier& b) {
    if (b.wave0 == 0 && lane_now() == 0) { unsigned nloc, nx; xcd_barrier_complete(b.bar, b.x, nloc, nx); b.st[0] = nloc; b.st[1] = nx; }
}
__device__ __forceinline__ void xcd_barrier(const XcdBarrier& b) {
    asm volatile("s_waitcnt vmcnt(0)" ::: "memory");
    __syncthreads();
    if (b.wave0 == 0 && lane_now() == 0) {
        unsigned* bar = b.bar;
        __builtin_amdgcn_s_waitcnt(0);
        const unsigned nloc = b.st[0], nx = b.st[1];
        const unsigned old = xb_add(&bar[XB_XSUB(b.x)], 1u);
        const unsigned gen = old / nloc;
        if (old + 1u == (gen + 1u) * nloc) {
            __builtin_amdgcn_fence(__ATOMIC_RELEASE, "agent");
            asm volatile("s_waitcnt vmcnt(0)" ::: "memory");
            const unsigned og = xb_add(&bar[XB_TOP], 1u);
            const unsigned tg = og / nx;
            if (og + 1u == (tg + 1u) * nx) xb_add(&bar[XB_TOPGEN], 1u);
            else XB_SPIN(xb_ld(&bar[XB_TOPGEN]) == tg, bar);
            __builtin_amdgcn_fence(__ATOMIC_ACQUIRE, "agent");
            xb_add(&bar[XB_XGEN(b.x)], 1u);
            asm volatile("s_waitcnt vmcnt(0)" ::: "memory");
        } else {
            XB_SPIN(xb_ld(&bar[XB_XGEN(b.x)]) == gen, bar);
            __builtin_amdgcn_fence(__ATOMIC_ACQUIRE, "agent");
            asm volatile("s_waitcnt vmcnt(0)" ::: "memory");
        }
    }
    __syncthreads();
}

struct Frame {
    LAS unsigned char* lds;
    volatile LAS unsigned* MISC;
    gu32* ctl;
    int tid, lane, wave, wave0;
    int G, bid;
};
#define REFRESH_IDS(F) do { int w_ = (F).wave0; asm volatile("" : "+s"(w_)); int l_ = lane_now(); asm volatile("" : "+v"(l_)); (F).wave = w_; (F).lane = l_; (F).tid = w_ * 64 + l_; \
    int b_ = blockIdx.x, g_ = gridDim.x; asm volatile("" : "+s"(b_), "+s"(g_)); (F).bid = b_; (F).G = g_; } while (0)

__device__ __forceinline__ float shfl_x(float v, int o, int lane) { return __int_as_float(__builtin_amdgcn_ds_bpermute((lane ^ o) << 2, __float_as_int(v))); }
__device__ __forceinline__ float wave_sum(float v, int lane) {
#pragma unroll
    for (int o = 1; o < 64; o <<= 1) v += shfl_x(v, o, lane);
    return v;
}
__device__ __forceinline__ void p0_transpose_item(const float* W, int K, int N, bf16* WT, LAS float* scr, int item, int lane) {
    const int nblk = N / 32, kb = item / nblk, nb = item % nblk, k0 = 64 * kb, n0 = 32 * nb;
#pragma unroll 8
    for (int i = 0; i < 32; ++i) { const int kk = 2 * i + (lane >> 5); scr[kk * 33 + (lane & 31)] = W[(size_t)(k0 + kk) * N + n0 + (lane & 31)]; }
    LDS_WAIT(); asm volatile("" ::: "memory");
    const int c = lane & 7;
#pragma unroll
    for (int j = 0; j < 4; ++j) { const int n = (lane >> 3) + 8 * j; const LAS float* s = scr + (8 * c) * 33 + n;
        v4u o; o.x = pk2(s[0 * 33], s[1 * 33]); o.y = pk2(s[2 * 33], s[3 * 33]); o.z = pk2(s[4 * 33], s[5 * 33]); o.w = pk2(s[6 * 33], s[7 * 33]);
        *(GAS v4u*)(WT + (size_t)(n0 + n) * K + k0 + 8 * c) = o; }
    LDS_WAIT(); asm volatile("" ::: "memory");
}

__device__ __forceinline__ void p0_prologue(Frame& F) {
    REFRESH_IDS(F);
    const KArgs ka = kargs(); const float* P_win = ka->in[IN_WIN]; const float* P_wout = ka->in[IN_WOUT]; const float* P_poolw = ka->in[IN_POOLW]; bf16* P_WIN = (bf16*)(ka->ws + WS_WIN); bf16* P_WOUT = (bf16*)(ka->ws + WS_WOUT); bf16* P_WPOOL = (bf16*)(ka->ws + WS_WPOOL); const float* P_hlb = ka->in[IN_HLB]; float* P_lb = (float*)(ka->ws + WS_LB); const float* P_adaw = ka->in[IN_ADAW]; const float* P_adab = ka->in[IN_ADAB]; const float* P_c = ka->in[IN_C]; float* P_mod = (float*)(ka->ws + WS_MOD);
    LAS float* scr = (LAS float*)(F.lds + RING_OFF + F.wave * 16384);
    const int gw = F.bid * NWAVES + F.wave, NGW = F.G * NWAVES;
    constexpr int I_IN = (D / 64) * (NZ / 32), I_OUT = (MIXW / 64) * (D / 32), I_PW = (256 / 64) * (256 / 32);
    constexpr int NITEMS = DEPTH * (I_IN + I_OUT + 4 * I_PW);
    for (int it = gw; it < NITEMS; it += NGW) {
        int r = it;
        if (r < DEPTH * I_IN) { const int l = r / I_IN; p0_transpose_item(P_win + (size_t)l * D * NZ, D, NZ, P_WIN + (size_t)l * NZ * D, scr, r % I_IN, F.lane); continue; } r -= DEPTH * I_IN;
        if (r < DEPTH * I_OUT) { const int l = r / I_OUT; p0_transpose_item(P_wout + (size_t)l * MIXW * D, MIXW, D, P_WOUT + (size_t)l * D * MIXW, scr, r % I_OUT, F.lane); continue; } r -= DEPTH * I_OUT;
        { const int lg = r / I_PW; p0_transpose_item(P_poolw + (size_t)lg * 65536, 256, 256, P_WPOOL + (size_t)lg * 65536, scr, r % I_PW, F.lane); }
    }
    if (F.bid == 0) for (int j = F.tid; j < 1024; j += NWAVES * 64) { const float a0 = P_hlb[j], a1 = P_hlb[1024 + j]; P_lb[j] = 0.f; P_lb[1024 + j] = 1.0f / (1.0f + __expf(a0 - a1)); }
    constexpr int AITEMS = DEPTH * (3 * D / 8);
    for (int it = NGW - 1 - gw; it < AITEMS; it += NGW) {
        const int l = it / (3 * D / 8), n0 = (it % (3 * D / 8)) * 8;
        float acc[16][8];
#pragma unroll
        for (int b = 0; b < 16; ++b)
#pragma unroll
            for (int j = 0; j < 8; ++j) acc[b][j] = 0.f;
        for (int i = 0; i < 16; ++i) {
            const int k = F.lane + 64 * i;
            const float* wp = P_adaw + ((size_t)l * D + k) * (3 * D) + n0;
            const f32x4 w0 = *(const f32x4*)wp, w1 = *(const f32x4*)(wp + 4);
#pragma unroll
            for (int b = 0; b < 16; ++b) { const float cv = P_c[b * D + k], s = cv * __builtin_amdgcn_rcpf(1.0f + __expf(-cv));
#pragma unroll
                for (int j = 0; j < 4; ++j) { acc[b][j] += s * w0[j]; acc[b][4 + j] += s * w1[j]; } }
        }
        float* av = &acc[0][0];
#define TR_STEP(N, OFF) _Pragma("unroll") for (int i = 0; i < (N) / 2; ++i) { const bool up = (F.lane & (OFF)) != 0; const float keep = up ? av[i + (N) / 2] : av[i], send = up ? av[i] : av[i + (N) / 2]; av[i] = keep + shfl_x(send, (OFF), F.lane); }
        TR_STEP(128, 32) TR_STEP(64, 16) TR_STEP(32, 8) TR_STEP(16, 4) TR_STEP(8, 2) TR_STEP(4, 1)
#undef TR_STEP
        { const int b = F.lane >> 2, j = (F.lane & 3) * 2; const float* bp = P_adab + l * 3 * D + n0 + j;
          float* mp = P_mod + ((size_t)l * BATCH + b) * (3 * D) + n0 + j; mp[0] = av[0] + bp[0]; mp[1] = av[1] + bp[1]; }
    }
}

__device__ __forceinline__ void rowpass(Frame& F, int l) {
    REFRESH_IDS(F);
    const KArgs ka = kargs(); const float* P_x = ka->in[IN_X]; float* P_out = ka->out; bf16* P_Y = (bf16*)(ka->ws + WS_Y); float* P_mod = (float*)(ka->ws + WS_MOD); const float* P_npost = ka->in[IN_NPOST]; const float* P_npre = ka->in[IN_NPRE]; bf16* P_XN = (bf16*)(ka->ws + WS_XN);
    const int gw = F.bid * NWAVES + F.wave, NGW = F.G * NWAVES;
    const int ln = l + 1;
    for (int m = gw; m < M; m += NGW) {
        const int b = m / SEQ;
        f32x4 v[4];
        const float* xin = (l <= 0 ? P_x : (const float*)P_out) + (size_t)m * D;
#pragma unroll
        for (int j = 0; j < 4; ++j) v[j] = *((const GAS f32x4*)xin + F.lane + 64 * j);
        if (l >= 0) {
            const GAS v2u* yr = (const GAS v2u*)(P_Y + (size_t)m * D) + F.lane;
            f32x4 y[4]; float ss = 0.f;
#pragma unroll
            for (int j = 0; j < 4; ++j) { const v2u w = yr[64 * j]; y[j] = (f32x4){bflo(w.x), bfhi(w.x), bflo(w.y), bfhi(w.y)}; ss += (y[j].x * y[j].x + y[j].y * y[j].y) + (y[j].z * y[j].z + y[j].w * y[j].w); }
            const float r = __builtin_amdgcn_rsqf(wave_sum(ss, F.lane) * (1.f / D) + EPS);
            const float* gate = P_mod + ((size_t)l * BATCH + b) * (3 * D) + 2 * D;
            const float* wp = P_npost + l * D;
#pragma unroll
            for (int j = 0; j < 4; ++j) { const f32x4 g = *((const f32x4*)gate + F.lane + 64 * j), w = *((const f32x4*)wp + F.lane + 64 * j); v[j] = v[j] + g * (y[j] * r * w);
                *((GAS f32x4*)(P_out + (size_t)m * D) + F.lane + 64 * j) = v[j]; }
        }
        if (ln < DEPTH) {
            float ss = 0.f;
#pragma unroll
            for (int j = 0; j < 4; ++j) ss += (v[j].x * v[j].x + v[j].y * v[j].y) + (v[j].z * v[j].z + v[j].w * v[j].w);
            const float r = __builtin_amdgcn_rsqf(wave_sum(ss, F.lane) * (1.f / D) + EPS);
            const float* shift = P_mod + ((size_t)ln * BATCH + b) * (3 * D); const float* scale = shift + D; const float* wp = P_npre + ln * D;
            GAS v2u* o = (GAS v2u*)(P_XN + (size_t)m * D) + F.lane;
#pragma unroll
            for (int j = 0; j < 4; ++j) { const f32x4 sh = *((const f32x4*)shift + F.lane + 64 * j), sc = *((const f32x4*)scale + F.lane + 64 * j), w = *((const f32x4*)wp + F.lane + 64 * j);
                const f32x4 h = v[j] * r * w * (sc + 1.0f) + sh; v2u pw; pw.x = pk2(h.x, h.y); pw.y = pk2(h.z, h.w); o[64 * j] = pw; }
        }
    }
}

__device__ __forceinline__ void dpass(Frame& F) {
    REFRESH_IDS(F);
    const KArgs ka = kargs(); bf16* P_U = (bf16*)(ka->ws + WS_U); bf16* DP = (bf16*)(ka->ws + WS_XN);
    constexpr int RUN = 32;
    const int g = F.tid >> 7, w = 2 << g;
    for (int run = F.bid; run < M / RUN; run += F.G) {
        const int t0 = run * RUN, tp0 = t0 & (SEQ - 1);
        const GAS unsigned* up = (const GAS unsigned*)(P_U + (size_t)t0 * D) + F.tid;
        GAS unsigned* dp = (GAS unsigned*)(DP + (size_t)t0 * D) + F.tid;
        float s0 = 0.f, s1 = 0.f;
        for (int i = 1; i < w; ++i) if (tp0 - i >= 0) { const unsigned xw = up[-(long)i * (D / 2)]; s0 += bflo(xw); s1 += bfhi(xw); }
        for (int r = 0; r < RUN; ++r) {
            const unsigned xw = up[(long)r * (D / 2)]; const float x0 = bflo(xw), x1 = bfhi(xw); s0 += x0; s1 += x1;
            const int tp = tp0 + r;
            const float inv = 1.0f / (float)(tp + 1 < w ? tp + 1 : w);
            dp[(long)r * (D / 2)] = pk2(s0 * inv - x0, s1 * inv - x1);
            if (tp + 1 >= w) { const unsigned yw = up[(long)(r + 1 - w) * (D / 2)]; s0 -= bflo(yw); s1 -= bfhi(yw); }
        }
    }
}

__device__ __forceinline__ void hgrn_naive(Frame& F, int l) {
    REFRESH_IDS(F);
    const KArgs ka = kargs(); const float* P_hnw = ka->in[IN_HNW]; bf16* P_Q = (bf16*)(ka->ws + WS_Q); bf16* P_LF = (bf16*)(ka->ws + WS_LF); bf16* P_V = (bf16*)(ka->ws + WS_V); bf16* P_MIX = (bf16*)(ka->ws + WS_MIX);
    LAS float* qs = (LAS float*)(F.lds + RING_OFF);
    LAS float* fs = qs + 2048; LAS float* ks = fs + 2048; LAS float* vs = ks + 2048;
    LAS float* part = vs + 2048;
    const int v = F.tid & 127, kg = F.tid >> 7;
    const float* nw = P_hnw + l * HD;
    for (int unit = F.bid; unit < BATCH * NHEAD; unit += F.G) {
        const int b = unit / NHEAD, h = unit % NHEAD;
        float S[32];
#pragma unroll
        for (int i = 0; i < 32; ++i) S[i] = 0.f;
        const size_t rb = (size_t)b * SEQ;
        for (int t0 = 0; t0 < SEQ; t0 += 16) {
            { const int tt = F.tid >> 5, ch = (F.tid & 31) * 4; const size_t off = (rb + t0 + tt) * D + h * HD + ch;
              const v2u qw = *(const GAS v2u*)(P_Q + off), lw = *(const GAS v2u*)(P_LF + off), vw = *(const GAS v2u*)(P_V + off);
              const float lf[4] = {h2f_lo(lw.x), h2f_hi(lw.x), h2f_lo(lw.y), h2f_hi(lw.y)};
              const float qq[4] = {bflo(qw.x), bfhi(qw.x), bflo(qw.y), bfhi(qw.y)}, vv[4] = {bflo(vw.x), bfhi(vw.x), bflo(vw.y), bfhi(vw.y)};
#pragma unroll
              for (int e = 0; e < 4; ++e) { const float f = __expf(lf[e]); fs[tt * 128 + ch + e] = f; ks[tt * 128 + ch + e] = 1.0f - f; qs[tt * 128 + ch + e] = qq[e]; vs[tt * 128 + ch + e] = vv[e]; } }
            __syncthreads();
            for (int tt = 0; tt < 16; ++tt) {
                const float vv = vs[tt * 128 + v]; float po = 0.f;
#pragma unroll
                for (int i = 0; i < 32; ++i) { const float f = fs[tt * 128 + kg * 32 + i], k = ks[tt * 128 + kg * 32 + i], q = qs[tt * 128 + kg * 32 + i]; S[i] = f * S[i] + k * vv; po += q * S[i]; }
                part[(tt * 4 + kg) * 128 + v] = po;
            }
            __syncthreads();
#pragma unroll
            for (int e = 0; e < 2; ++e) { const int tt = F.wave * 2 + e;
                float o0 = 0.f, o1 = 0.f;
#pragma unroll
                for (int k4 = 0; k4 < 4; ++k4) { o0 += part[(tt * 4 + k4) * 128 + F.lane]; o1 += part[(tt * 4 + k4) * 128 + 64 + F.lane]; }
                const float r = __builtin_amdgcn_rsqf(wave_sum(o0 * o0 + o1 * o1, F.lane) * (1.f / HD) + EPS);
                GAS bf16* gp = (GAS bf16*)(P_MIX + (rb + t0 + tt) * MIXW + D + h * HD);
                const float g0 = __uint_as_float((unsigned)gp[F.lane] << 16), g1 = __uint_as_float((unsigned)gp[64 + F.lane] << 16);
                gp[F.lane] = (bf16)f2bf(o0 * r * nw[F.lane] * g0); gp[64 + F.lane] = (bf16)f2bf(o1 * r * nw[64 + F.lane] * g1); }
        }
        __syncthreads();
    }
}

#ifndef DBG_KINDS
#define DBG_KINDS 0x7f
#endif
#define KIND(j) ((DBG_KINDS >> (j)) & 1)
#define IN(k) (lo <= (k) && (k) < hi)
#define BOTH(k) (IN(k) && IN((k) + 1))
#define GRID_BAR() do { if (N_LAUNCHES == 1) xcd_barrier(bar); } while (0)
template <int l> __device__ __forceinline__ void layer_phases(Frame& F, const XcdBarrier& bar, const int lo, const int hi) {
        const int p = 2 + 5 * l;
    if (KIND(2) && IN(p)) {
        const KArgs ka = kargs(); bf16* P_XN = (bf16*)(ka->ws + WS_XN); bf16* P_WIN = (bf16*)(ka->ws + WS_WIN);
        pg8::Gemm g{P_XN, P_WIN + (size_t)l * NZ * D, M, NZ, D, D, 0}; pg8::StaticOrder S; REFRESH_IDS(F); S.init(M, NZ, F.G, F.bid);
        pg8::EpiZ E{l};
        pg8::gemm_phase<pg8::EpiZ, pg8::StaticOrder, PG8_ALIGN, PG8_SP2>(F.lds + RING_OFF, g, S, E, F.tid);
        if (BOTH(p)) GRID_BAR();
    }
    if (KIND(3) && IN(p + 1)) {
        dpass(F);
        hgrn_naive(F, l);
        if (BOTH(p + 1)) GRID_BAR();
    }
    if (KIND(4) && IN(p + 2)) {
        const KArgs ka = kargs(); bf16* P_XN = (bf16*)(ka->ws + WS_XN); bf16* P_WPOOL = (bf16*)(ka->ws + WS_WPOOL);
        pg8::Gemm g{P_XN, P_WPOOL + (size_t)l * 4 * 65536, M, D, 256, D, 256}; pg8::StaticOrder S; REFRESH_IDS(F); S.init(M, D, F.G, F.bid);
        pg8::EpiPool E{l};
        pg8::gemm_phase<pg8::EpiPool, pg8::StaticOrder, PG8_ALIGN, PG8_SP2>(F.lds + RING_OFF, g, S, E, F.tid);
        if (BOTH(p + 2)) GRID_BAR();
    }
    if (KIND(5) && IN(p + 3)) {
        const KArgs ka = kargs(); bf16* P_MIX = (bf16*)(ka->ws + WS_MIX); bf16* P_WOUT = (bf16*)(ka->ws + WS_WOUT);
        pg8::Gemm g{P_MIX, P_WOUT + (size_t)l * D * MIXW, M, D, MIXW, MIXW, 0}; pg8::StaticOrder S; REFRESH_IDS(F); S.init(M, D, F.G, F.bid);
        pg8::EpiBf16Plain E{WS_Y, D};
        pg8::gemm_phase<pg8::EpiBf16Plain, pg8::StaticOrder, PG8_ALIGN, PG8_SP2>(F.lds + RING_OFF, g, S, E, F.tid);
        if (BOTH(p + 3)) GRID_BAR();
    }
    if (KIND(6) && IN(p + 4)) {
        rowpass(F, l);
        if (BOTH(p + 4)) GRID_BAR();
    }
}

__global__ void __launch_bounds__(NWAVES * 64, 2) skel_fwd(Args args) {
    extern __shared__ __attribute__((aligned(16))) unsigned char lds[];
    Frame F;
    F.lds = (LAS unsigned char*)lds;
    F.MISC = (volatile LAS unsigned*)(F.lds + MISC_OFF);
    F.tid = threadIdx.x; F.lane = F.tid & 63; F.wave = __builtin_amdgcn_readfirstlane(F.tid >> 6); F.wave0 = F.wave;
    F.G = gridDim.x; F.bid = blockIdx.x;
    F.ctl = (gu32*)(args.ws + WS_CTL);
    for (int u = F.tid; u < (LDS_BYTES - LDSCTL_OFF) / 4; u += NWAVES * 64) ((LAS unsigned*)(F.lds + LDSCTL_OFF))[u] = 0u;
    __syncthreads();
    XcdBarrier bar; bar.bar = (unsigned*)(F.ctl + CW_BAR); bar.x = 0; bar.st = nullptr; bar.wave0 = F.wave0;
    if (N_LAUNCHES == 1) bar = xcd_barrier_post((unsigned*)(F.ctl + CW_BAR), F.MISC + 8);
    const int lo = (N_LAUNCHES == 1) ? 0 : args.ph_lo, hi = (N_LAUNCHES == 1) ? N_PHASES : args.ph_hi;

    if (KIND(0) && IN(0)) { p0_prologue(F); if (N_LAUNCHES == 1) xcd_barrier_census(bar); if (BOTH(0)) GRID_BAR(); }
    if (KIND(1) && IN(1)) { rowpass(F, -1); if (BOTH(1)) GRID_BAR(); }
    layer_phases<0>(F, bar, lo, hi);
    layer_phases<1>(F, bar, lo, hi);
    static_assert(DEPTH == 2, "two explicit layer_phases calls");
#undef IN
#undef BOTH
}

extern "C" void kernel_launch(void* const* d_in, const int* in_sizes, int n_in, void* d_out, int out_size, void* d_ws, size_t ws_size, hipStream_t stream) {
    static int grid = 0;
    if (grid == 0) {
        if (n_in != 12 || in_sizes[0] != M * D || out_size != M * D || ws_size < WS_END) { fprintf(stderr, "kernel_launch: unexpected shapes: n_in %d in0 %d out %d ws %zu\n", n_in, n_in > 0 ? in_sizes[0] : -1, out_size, ws_size); grid = -1; return; }
        int dev = 0, cus = 0, per_cu = 0;
        if (hipGetDevice(&dev) != hipSuccess || hipDeviceGetAttribute(&cus, hipDeviceAttributeMultiprocessorCount, dev) != hipSuccess) { grid = -1; return; }
        if (hipFuncSetAttribute((const void*)skel_fwd, hipFuncAttributeMaxDynamicSharedMemorySize, LDS_BYTES) != hipSuccess) { fprintf(stderr, "kernel_launch: hipFuncSetAttribute failed\n"); grid = -1; return; }
        if (hipOccupancyMaxActiveBlocksPerMultiprocessor(&per_cu, (const void*)skel_fwd, NWAVES * 64, LDS_BYTES) != hipSuccess || per_cu < 1) { fprintf(stderr, "kernel_launch: occupancy query says %d blocks per CU\n", per_cu); per_cu = 1; }
        (void)hipGetLastError();
        grid = cus;
    }
    if (grid < 0) return;
    if (hipMemsetAsync((char*)d_ws + WS_CTL, 0, CTL_ZERO_BYTES, stream) != hipSuccess) { fprintf(stderr, "kernel_launch: memset failed\n"); return; }
    Args a{};
    for (int i = 0; i < 12; ++i) a.in[i] = (const float*)d_in[i];
    a.out = (float*)d_out; a.ws = (unsigned char*)d_ws;
    for (int li = 0; li < N_LAUNCHES; ++li) {
        a.ph_lo = (N_LAUNCHES == 1) ? 0 : li; a.ph_hi = (N_LAUNCHES == 1) ? N_PHASES : li + 1; a.li = li;
        hipLaunchKernelGGL(skel_fwd, dim3(grid), dim3(NWAVES * 64), LDS_BYTES, stream, a);
        const hipError_t le = hipPeekAtLastError();
        if (le != hipSuccess) { fprintf(stderr, "kernel_launch: launch %d failed: %s\n", li, hipGetErrorName(le)); break; }
    }
}
```

```cpp
#include <hip/hip_runtime.h>
#include <cstdio>
#include <cstdint>

#ifndef MK_N_LAUNCHES
#define MK_N_LAUNCHES 1
#endif

constexpr int NWAVES = 8;
constexpr int N_LAUNCHES = MK_N_LAUNCHES;
constexpr int BATCH = 16, SEQ = 2048, D = 1024, DEPTH = 2, NZ = 6144, MIXW = 2048, NHEAD = 8, HD = 128;
constexpr int M = BATCH * SEQ;
constexpr float EPS = 1e-6f;
constexpr int N_PHASES = 2 + 5 * DEPTH;

constexpr size_t MiB = 1u << 20;
constexpr size_t WS_CTL = 0, CTL_ZERO_BYTES = 1 * MiB;
constexpr size_t WS_MOD = 1 * MiB;
constexpr size_t WS_LB = 1 * MiB + 512 * 1024;
constexpr size_t WS_WIN = 2 * MiB;
constexpr size_t WS_WOUT = 26 * MiB;
constexpr size_t WS_WPOOL = 34 * MiB;
constexpr size_t WS_XN = 36 * MiB;
constexpr size_t WS_U = 100 * MiB, WS_Q = 164 * MiB, WS_LF = 228 * MiB, WS_V = 292 * MiB;
constexpr size_t WS_MIX = 356 * MiB;
constexpr size_t WS_Y = WS_U;
constexpr size_t WS_END = 484 * MiB;
constexpr int CW_TMO = 0, CW_CODE = 1;
constexpr int CW_BAR = 4096;


struct Args { const float* in[12]; float* out; unsigned char* ws; int ph_lo, ph_hi, li, pad; };
typedef const __attribute__((address_space(4))) Args* KArgs;
__device__ __forceinline__ KArgs kargs() { KArgs p = (KArgs)__builtin_amdgcn_kernarg_segment_ptr(); asm volatile("" : "+s"(p)); return p; }
enum { IN_X = 0, IN_C, IN_NPRE, IN_ADAW, IN_ADAB, IN_WIN, IN_POOLW, IN_PSCALE, IN_HLB, IN_HNW, IN_WOUT, IN_NPOST };

namespace pg8 {
#define PG8_LAS __attribute__((address_space(3)))
typedef unsigned short bf16_t;
typedef short bf16x8 __attribute__((ext_vector_type(8)));
typedef float f32x4 __attribute__((ext_vector_type(4)));
typedef unsigned u32x4 __attribute__((ext_vector_type(4)));
constexpr int BM = 256, BK = 64, HALF = 128, HTB = HALF * BK * 2  , STAGE_BYTES = 8 * HTB, NXCD = 8, WGM = 8;

__host__ __device__ __forceinline__ int lds_byte(int r, int c) { const int st = (r >> 4) * 2 + (c >> 5), rr = r & 15, cc = c & 31, ob = rr * 64 + cc * 2; return st * 1024 + (ob ^ (((ob >> 9) & 1) << 5)); }
__host__ __device__ __forceinline__ void stage_rc(int b, int& R, int& C) { const int st = b / 1024, sb = b % 1024, swz = sb ^ (((sb >> 9) & 1) << 5); R = (st >> 1) * 16 + swz / 64; C = (st & 1) * 32 + (swz % 64) / 2; }
__host__ __device__ __forceinline__ int perm32(int rho) { const int n = rho >> 4, i = rho & 15; return 8 * (i >> 2) + 4 * n + (i & 3); }

struct Unit { int pm, pn; };
struct Gemm { const bf16_t* A; const bf16_t* Bt; int M, N, K, lda, acol; };

struct StaticOrder {
    int nM, nN, nwg, G, c;
    __host__ __device__ void init(int M, int N, int G_, int c_) { nM = M / BM; nN = N / BM; nwg = nM * nN; G = G_; c = c_; }
    __host__ __device__ bool next(int i, Unit& u) const {
        const long L = (long)i * G + c; if (L >= nwg) return false;
        int wgid = (int)L; { const int q = nwg / NXCD, r = nwg % NXCD, xcd = wgid % NXCD, off = wgid / NXCD; wgid = (xcd < r ? xcd * (q + 1) : r * (q + 1) + (xcd - r) * q) + off; }
        const int nig = WGM * nN, gid = wgid / nig, fm = gid * WGM, gsz = (nM - fm) < WGM ? (nM - fm) : WGM;
        u.pm = fm + ((wgid % nig) % gsz); u.pn = (wgid % nig) / gsz; return true;
    }
    __device__ __forceinline__ void a_ready(const Unit&) const {}
    __device__ __forceinline__ void done(const Unit&) const {}
};

__device__ __forceinline__ unsigned cvt_pk_bf16(float lo, float hi) { unsigned r; asm volatile("v_cvt_pk_bf16_f32 %0, %1, %2" : "=v"(r) : "v"(lo), "v"(hi)); return r; }
__device__ __forceinline__ unsigned cvt_pk_f16(float lo, float hi) { typedef _Float16 h2 __attribute__((ext_vector_type(2))); h2 v; v.x = (_Float16)lo; v.y = (_Float16)hi; return __builtin_bit_cast(unsigned, v); }
__device__ __forceinline__ float bf_lo(unsigned w) { return __uint_as_float(w << 16); }
__device__ __forceinline__ float bf_hi(unsigned w) { return __uint_as_float(w & 0xffff0000u); }
__device__ __forceinline__ float sigmoid_f(float x) { return __builtin_amdgcn_rcpf(1.0f + __expf(-x)); }

struct EpiBf16Plain {
    static constexpr bool PERM = true, AFTER_DRAIN = false;
    size_t ws_off; int ldc;
    __device__ __forceinline__ void operator()(const f32x4 (&acc)[2][2][4][2], const Unit& u, int wr, int wc, int fr, int fq) const {
        const int row0 = u.pm * BM + wr * 64 + fr, col0 = u.pn * BM + wc * 32 + 8 * fq;
        bf16_t* O = (bf16_t*)(kargs()->ws + ws_off);
#pragma unroll
        for (int ai = 0; ai < 2; ++ai)
#pragma unroll
            for (int m = 0; m < 4; ++m) { bf16_t* rowp = O + (size_t)(row0 + ai * HALF + m * 16) * ldc + col0;
#pragma unroll
                for (int bj = 0; bj < 2; ++bj) { const f32x4 v0 = acc[ai][bj][m][0], v1 = acc[ai][bj][m][1];
                    u32x4 w; w.x = cvt_pk_bf16(v0[0], v0[1]); w.y = cvt_pk_bf16(v0[2], v0[3]); w.z = cvt_pk_bf16(v1[0], v1[1]); w.w = cvt_pk_bf16(v1[2], v1[3]);
                    *(u32x4*)(rowp + bj * HALF) = w; } }
    }
};

struct EpiZ {
    static constexpr bool PERM = true, AFTER_DRAIN = false;
    int l;
    template <int ACT> __device__ __forceinline__ void tile(const f32x4 (&acc)[2][2][4][2], bf16_t* base, int ldc, int row0, int col0, const float* lb) const {
        f32x4 lbv[2][2];
        if (ACT == 2) {
#pragma unroll
            for (int bj = 0; bj < 2; ++bj)
#pragma unroll
                for (int n = 0; n < 2; ++n) lbv[bj][n] = *(const f32x4*)(lb + col0 + bj * HALF + 4 * n);
        }
#pragma unroll
        for (int ai = 0; ai < 2; ++ai)
#pragma unroll
            for (int m = 0; m < 4; ++m) { bf16_t* rowp = base + (size_t)(row0 + ai * HALF + m * 16) * ldc + col0;
#pragma unroll
                for (int bj = 0; bj < 2; ++bj) { f32x4 v[2] = {acc[ai][bj][m][0], acc[ai][bj][m][1]};
                    u32x4 w;
                    if (ACT == 1) {
#pragma unroll
                        for (int n = 0; n < 2; ++n)
#pragma unroll
                            for (int e = 0; e < 4; ++e) v[n][e] = v[n][e] * sigmoid_f(v[n][e]);
                    }
                    if (ACT == 2) {
#pragma unroll
                        for (int n = 0; n < 2; ++n)
#pragma unroll
                            for (int e = 0; e < 4; ++e) { const float x = fminf(fmaxf(v[n][e], -30.f), 30.f), l = lbv[bj][n][e]; v[n][e] = __logf(l + (1.0f - l) * sigmoid_f(x)); }
                        w.x = cvt_pk_f16(v[0][0], v[0][1]); w.y = cvt_pk_f16(v[0][2], v[0][3]); w.z = cvt_pk_f16(v[1][0], v[1][1]); w.w = cvt_pk_f16(v[1][2], v[1][3]);
                    } else {
                        w.x = cvt_pk_bf16(v[0][0], v[0][1]); w.y = cvt_pk_bf16(v[0][2], v[0][3]); w.z = cvt_pk_bf16(v[1][0], v[1][1]); w.w = cvt_pk_bf16(v[1][2], v[1][3]);
                    }
                    *(u32x4*)(rowp + bj * HALF) = w; }
                if (ACT != 0) __builtin_amdgcn_sched_barrier(0); }
    }
    __device__ __forceinline__ void operator()(const f32x4 (&acc)[2][2][4][2], const Unit& u, int wr, int wc, int fr, int fq) const {
        const int seg = u.pn >> 2, row0 = u.pm * BM + wr * 64 + fr, col0 = (u.pn & 3) * BM + wc * 32 + 8 * fq;
        unsigned char* ws = kargs()->ws; const float* lb = (const float*)(ws + WS_LB) + l * 1024;
        const size_t off = seg == 0 ? WS_U : seg == 2 ? WS_Q : seg == 3 ? WS_LF : seg == 4 ? WS_V : seg == 1 ? WS_MIX : WS_MIX + 2048;
        const int ldc = (seg == 1 || seg == 5) ? 2048 : 1024;
        bf16_t* base = (bf16_t*)(ws + off);
        if (seg == 3) tile<2>(acc, base, ldc, row0, col0, lb);
        else if (seg == 1 || seg == 5) tile<1>(acc, base, ldc, row0, col0, lb);
        else tile<0>(acc, base, ldc, row0, col0, lb);
    }
};

struct EpiPool {
    static constexpr bool PERM = true, AFTER_DRAIN = false;
    int l;
    __device__ __forceinline__ void operator()(const f32x4 (&acc)[2][2][4][2], const Unit& u, int wr, int wc, int fr, int fq) const {
        const int row0 = u.pm * BM + wr * 64 + fr, col0 = u.pn * BM + wc * 32 + 8 * fq;
        const KArgs ka = kargs(); bf16_t* MIX = (bf16_t*)(ka->ws + WS_MIX); const float* pscale = ka->in[IN_PSCALE] + l * 1024;
        f32x4 sv[2][2];
#pragma unroll
        for (int bj = 0; bj < 2; ++bj)
#pragma unroll
            for (int n = 0; n < 2; ++n) sv[bj][n] = *(const f32x4*)(pscale + col0 + bj * HALF + 4 * n);
#pragma unroll
        for (int ai = 0; ai < 2; ++ai)
#pragma unroll
            for (int m = 0; m < 4; ++m) { bf16_t* rowp = MIX + (size_t)(row0 + ai * HALF + m * 16) * 2048 + col0;
#pragma unroll
                for (int bj = 0; bj < 2; ++bj) { const u32x4 gw = *(const u32x4*)(rowp + bj * HALF);
                    const f32x4 v0 = acc[ai][bj][m][0] * sv[bj][0], v1 = acc[ai][bj][m][1] * sv[bj][1];
                    u32x4 w; w.x = cvt_pk_bf16(v0[0] * bf_lo(gw.x), v0[1] * bf_hi(gw.x)); w.y = cvt_pk_bf16(v0[2] * bf_lo(gw.y), v0[3] * bf_hi(gw.y));
                    w.z = cvt_pk_bf16(v1[0] * bf_lo(gw.z), v1[1] * bf_hi(gw.z)); w.w = cvt_pk_bf16(v1[2] * bf_lo(gw.w), v1[3] * bf_hi(gw.w));
                    *(u32x4*)(rowp + bj * HALF) = w; }
                if (m & 1) asm volatile("" ::: "memory"); }
    }
};

template <class Epi, class Sched, bool ALIGN_EPI = false, bool SP2 = false>
__device__ __forceinline__ void gemm_phase(PG8_LAS unsigned char* lds, const Gemm g, const Sched& S, const Epi& E, const int tid_in) {
    int tid_ = tid_in; asm volatile("" : "+v"(tid_));
    const int tid = tid_, wid = __builtin_amdgcn_readfirstlane(tid >> 6), lane = tid & 63, wr = wid >> 2, wc = wid & 3, fr = lane & 15, fq = lane >> 4;
    const int K = g.K, nt = K / BK;
    unsigned voffA[2], voffB[2];
#pragma unroll
    for (int i = 0; i < 2; ++i) { int R, C; stage_rc(tid * 16 + i * 8192, R, C); const int Rb = Epi::PERM ? ((R & ~31) + perm32(R & 31)) : R;
        voffA[i] = (unsigned)(R * g.lda + C) * 2u; voffB[i] = (unsigned)(Rb * K + C) * 2u; }
    const size_t kstep = (size_t)(BK * 2);
    const size_t hstepA = (size_t)HALF * g.lda * 2, hstepB = (size_t)HALF * K * 2;
    const size_t tstepA = 2 * hstepA, tstepB = 2 * hstepB;
    const size_t acolB = (size_t)g.acol * 2;
    const unsigned ldsw = (unsigned)wid * 1024u;
    const int aoff = lds_byte(wr * 64 + fr, fq * 8), boff = lds_byte(wc * 32 + fr, fq * 8);
#define PG8_SA(b, h) (((b) * 2 + (h)) * HTB)
#define PG8_SB(b, h) ((4 + (b) * 2 + (h)) * HTB)
#define PG8_STAGE(bufoff, gbase, voff) do { _Pragma("unroll") for (int _i = 0; _i < 2; ++_i) \
        __builtin_amdgcn_global_load_lds((const unsigned*)((const char*)(gbase) + (voff)[_i]), (PG8_LAS unsigned*)(lds + (bufoff) + ldsw + _i * 8192), 16, 0, 0); } while (0)
#define PG8_LDA(dst, b, h) do { _Pragma("unroll") for (int m = 0; m < 4; ++m) _Pragma("unroll") for (int k = 0; k < 2; ++k) dst[m][k] = *(const PG8_LAS bf16x8*)(lds + PG8_SA(b, h) + aoff + m * 2048 + k * 1024); } while (0)
#define PG8_LDB(dst, b, h) do { _Pragma("unroll") for (int n = 0; n < 2; ++n) _Pragma("unroll") for (int k = 0; k < 2; ++k) dst[n][k] = *(const PG8_LAS bf16x8*)(lds + PG8_SB(b, h) + boff + n * 2048 + k * 1024); } while (0)
#define PG8_MMA(ai, bj, At, Bt) do { __builtin_amdgcn_s_setprio(1); _Pragma("unroll") for (int m = 0; m < 4; ++m) _Pragma("unroll") for (int n = 0; n < 2; ++n) _Pragma("unroll") for (int k = 0; k < 2; ++k) \
        acc[ai][bj][m][n] = __builtin_amdgcn_mfma_f32_16x16x32_bf16(Bt[n][k], At[m][k], acc[ai][bj][m][n], 0, 0, 0); __builtin_amdgcn_s_setprio(0); } while (0)
#define PG8_WAIT_V(n) asm volatile("s_waitcnt vmcnt(" #n ")" ::: "memory")
#define PG8_WAIT_L(n) asm volatile("s_waitcnt lgkmcnt(" #n ")" ::: "memory")
#define PG8_BAR __builtin_amdgcn_s_barrier()
#define PG8_SCHED __builtin_amdgcn_sched_barrier(0)
    Unit cur, nxt; int ui = 0;
    if (!S.next(0, cur)) return;
    f32x4 acc[2][2][4][2];
#pragma unroll
    for (int a = 0; a < 2; ++a)
#pragma unroll
        for (int b = 0; b < 2; ++b)
#pragma unroll
            for (int m = 0; m < 4; ++m)
#pragma unroll
                for (int n = 0; n < 2; ++n) acc[a][b][m][n] = (f32x4){0.f, 0.f, 0.f, 0.f};
    bf16x8 At[4][2], B0[2][2], B1[2][2];
    const char* cA = (const char*)g.A + (size_t)cur.pm * tstepA + (size_t)cur.pn * acolB; const char* cB = (const char*)g.Bt + (size_t)cur.pn * tstepB;
    S.a_ready(cur);
    if constexpr (SP2) {
        PG8_STAGE(PG8_SB(0, 0), cB, voffB); PG8_STAGE(PG8_SB(0, 1), cB + hstepB, voffB); PG8_STAGE(PG8_SA(0, 0), cA, voffA); PG8_STAGE(PG8_SA(0, 1), cA + hstepA, voffA);
        if (wr == 1) PG8_BAR;
        PG8_WAIT_V(2); PG8_BAR;
        PG8_STAGE(PG8_SB(1, 0), cB + kstep, voffB); PG8_STAGE(PG8_SA(1, 0), cA + kstep, voffA); PG8_STAGE(PG8_SB(1, 1), cB + hstepB + kstep, voffB);
        PG8_WAIT_V(6); PG8_BAR;
    } else {
        PG8_STAGE(PG8_SB(0, 0), cB, voffB); PG8_STAGE(PG8_SA(0, 0), cA, voffA); PG8_STAGE(PG8_SB(0, 1), cB + hstepB, voffB); PG8_STAGE(PG8_SA(0, 1), cA + hstepA, voffA);
        if (wr == 1) PG8_BAR;
        PG8_WAIT_V(4); PG8_BAR;
        PG8_STAGE(PG8_SB(1, 0), cB + kstep, voffB); PG8_STAGE(PG8_SA(1, 0), cA + kstep, voffA); PG8_STAGE(PG8_SB(1, 1), cB + hstepB + kstep, voffB);
        PG8_WAIT_V(6); PG8_BAR;
    }
    for (;;) {
        const bool has_next = S.next(ui + 1, nxt);
        const char* nA = has_next ? (const char*)g.A + (size_t)nxt.pm * tstepA + (size_t)nxt.pn * acolB : cA; const char* nB = has_next ? (const char*)g.Bt + (size_t)nxt.pn * tstepB : cB;
        for (int t = 0; t < nt; t += 2) {
            const bool last = (t == nt - 2);
            const char* a1 = cA + (size_t)(t + 1) * kstep;
            const char* a2 = last ? nA : cA + (size_t)(t + 2) * kstep; const char* b2 = last ? nB : cB + (size_t)(t + 2) * kstep;
            const char* a3 = a2 + kstep; const char* b3 = b2 + kstep;
            if (last && has_next) S.a_ready(nxt);
            if constexpr (SP2) {
            PG8_LDB(B0, 0, 0); PG8_LDB(B1, 0, 1); PG8_SCHED; PG8_LDA(At, 0, 0); PG8_STAGE(PG8_SA(1, 1), a1 + hstepA, voffA);
            PG8_WAIT_V(8); PG8_WAIT_L(0); PG8_BAR; PG8_MMA(0, 0, At, B0); PG8_MMA(0, 1, At, B1); PG8_BAR; PG8_SCHED;
            PG8_LDA(At, 0, 1); PG8_STAGE(PG8_SB(0, 0), b2, voffB); PG8_STAGE(PG8_SB(0, 1), b2 + hstepB, voffB); PG8_STAGE(PG8_SA(0, 0), a2, voffA);
            PG8_WAIT_V(8); PG8_WAIT_L(0); PG8_BAR; PG8_MMA(1, 0, At, B0); PG8_MMA(1, 1, At, B1); PG8_BAR; PG8_SCHED;
            PG8_LDB(B0, 1, 0); PG8_LDB(B1, 1, 1); PG8_SCHED; PG8_LDA(At, 1, 0); PG8_STAGE(PG8_SA(0, 1), a2 + hstepA, voffA);
            PG8_WAIT_V(8); PG8_WAIT_L(0); PG8_BAR; PG8_MMA(0, 0, At, B0); PG8_MMA(0, 1, At, B1); PG8_BAR; PG8_SCHED;
            PG8_LDA(At, 1, 1); PG8_STAGE(PG8_SB(1, 0), b3, voffB); PG8_STAGE(PG8_SB(1, 1), b3 + hstepB, voffB); PG8_STAGE(PG8_SA(1, 0), a3, voffA);
            PG8_WAIT_V(8); PG8_WAIT_L(0); PG8_BAR; PG8_MMA(1, 0, At, B0); PG8_MMA(1, 1, At, B1); PG8_BAR; PG8_SCHED;
            } else {
            PG8_LDB(B0, 0, 0); PG8_SCHED; PG8_LDA(At, 0, 0); PG8_STAGE(PG8_SA(1, 1), a1 + hstepA, voffA);
            PG8_WAIT_L(8); PG8_BAR; PG8_WAIT_L(0); PG8_MMA(0, 0, At, B0); PG8_BAR; PG8_SCHED;
            PG8_LDB(B1, 0, 1); PG8_STAGE(PG8_SB(0, 0), b2, voffB);
            PG8_BAR; PG8_WAIT_L(0); PG8_MMA(0, 1, At, B1); PG8_BAR;
            PG8_LDA(At, 0, 1); PG8_STAGE(PG8_SA(0, 0), a2, voffA);
            PG8_BAR; PG8_WAIT_L(0); PG8_MMA(1, 0, At, B0); PG8_BAR; PG8_SCHED;
            PG8_STAGE(PG8_SB(0, 1), b2 + hstepB, voffB);
            PG8_WAIT_V(6); PG8_BAR; PG8_MMA(1, 1, At, B1); PG8_BAR;
            PG8_LDB(B0, 1, 0); PG8_SCHED; PG8_LDA(At, 1, 0); PG8_STAGE(PG8_SA(0, 1), a2 + hstepA, voffA);
            PG8_WAIT_L(8); PG8_BAR; PG8_WAIT_L(0); PG8_MMA(0, 0, At, B0); PG8_BAR; PG8_SCHED;
            PG8_LDB(B1, 1, 1); PG8_STAGE(PG8_SB(1, 0), b3, voffB);
            PG8_BAR; PG8_WAIT_L(0); PG8_MMA(0, 1, At, B1); PG8_BAR;
            PG8_LDA(At, 1, 1); PG8_STAGE(PG8_SA(1, 0), a3, voffA);
            PG8_BAR; PG8_WAIT_L(0); PG8_MMA(1, 0, At, B0); PG8_BAR; PG8_SCHED;
            PG8_STAGE(PG8_SB(1, 1), b3 + hstepB, voffB);
            PG8_WAIT_V(6); PG8_BAR; PG8_MMA(1, 1, At, B1); PG8_BAR;
            }
        }
        if constexpr (ALIGN_EPI) { if (wr == 0) PG8_BAR; }
        if constexpr (!Epi::AFTER_DRAIN) { E(acc, cur, wr, wc, fr, fq); S.done(cur); }
        if (!has_next) break;
#pragma unroll
        for (int a = 0; a < 2; ++a)
#pragma unroll
            for (int b = 0; b < 2; ++b)
#pragma unroll
                for (int m = 0; m < 4; ++m)
#pragma unroll
                    for (int n = 0; n < 2; ++n) acc[a][b][m][n] = (f32x4){0.f, 0.f, 0.f, 0.f};
        cur = nxt; cA = nA; cB = nB; ++ui;
        if constexpr (ALIGN_EPI) { if (wr == 1) PG8_BAR; }
    }
    PG8_WAIT_V(0);
    if constexpr (!ALIGN_EPI) { if (wr == 0) PG8_BAR; }
    PG8_BAR;
    if constexpr (Epi::AFTER_DRAIN) { E.fused(acc, cur, wr, wc, fr, fq, lds, wid, lane); S.done(cur); }
#undef PG8_SA
#undef PG8_SB
#undef PG8_STAGE
#undef PG8_LDA
#undef PG8_LDB
#undef PG8_MMA
#undef PG8_WAIT_V
#undef PG8_WAIT_L
#undef PG8_BAR
#undef PG8_SCHED
}
}

#define PG8_SP2 true
#define PG8_ALIGN true

constexpr int RING_OFF = 0, RING_BYTES = 131072;
constexpr int LDSCTL_OFF = RING_BYTES, MISC_OFF = LDSCTL_OFF + 320;
constexpr int LDS_BYTES = 147456;

#define GAS __attribute__((address_space(1)))
#define LAS __attribute__((address_space(3)))
typedef unsigned short bf16;
typedef unsigned v4u __attribute__((ext_vector_type(4)));
typedef unsigned v2u __attribute__((ext_vector_type(2)));
typedef float f32x4 __attribute__((ext_vector_type(4)));
typedef short bf16x8 __attribute__((ext_vector_type(8)));
typedef GAS unsigned gu32;
typedef GAS unsigned long long gu64;
#define RLX_AGENT __ATOMIC_RELAXED, __HIP_MEMORY_SCOPE_AGENT
#define LDS_WAIT() asm volatile("s_waitcnt lgkmcnt(0)" ::: "memory")
#define VM_WAIT() asm volatile("s_waitcnt vmcnt(0)" ::: "memory")
__device__ __forceinline__ unsigned f2bf(float f) { unsigned u = __builtin_bit_cast(unsigned, f); return (u + 0x7fffu + ((u >> 16) & 1u)) >> 16; }
__device__ __forceinline__ unsigned pk2(float lo, float hi) { return f2bf(lo) | (f2bf(hi) << 16); }
__device__ __forceinline__ float bflo(unsigned w) { return __uint_as_float(w << 16); }
__device__ __forceinline__ float bfhi(unsigned w) { return __uint_as_float(w & 0xffff0000u); }
__device__ __forceinline__ float h2f_lo(unsigned w) { typedef _Float16 h2 __attribute__((ext_vector_type(2))); return (float)__builtin_bit_cast(h2, w).x; }
__device__ __forceinline__ float h2f_hi(unsigned w) { typedef _Float16 h2 __attribute__((ext_vector_type(2))); return (float)__builtin_bit_cast(h2, w).y; }

#define XB_TMO      128
#define XB_XCNT(j)  (256  + 64 * (j))
#define XB_XSUB(j)  (1280 + 64 * (j))
#define XB_XGEN(j)  (2304 + 64 * (j))
#define XB_TOP      3328
#define XB_TOPGEN   3392
#define XCD_BAR_WORDS 3456
#define XB_SPIN_CAP (1u << 18)

__device__ __forceinline__ unsigned xb_ld(unsigned* p)              { return __hip_atomic_load(p, __ATOMIC_RELAXED, __HIP_MEMORY_SCOPE_AGENT); }
__device__ __forceinline__ unsigned xb_add(unsigned* p, unsigned v) { return __hip_atomic_fetch_add(p, v, __ATOMIC_RELAXED, __HIP_MEMORY_SCOPE_AGENT); }
__device__ __forceinline__ unsigned xb_xcc_id() { return (unsigned)__builtin_amdgcn_s_getreg((3 << 11) | 20) & 0xFu; }
#define XB_SPIN(cond, bar) do { unsigned _sp = 0; while (cond) { __builtin_amdgcn_s_sleep(1); \
    if ((++_sp & 255u) == 0u) { if (xb_ld(&(bar)[XB_TMO])) break; if (_sp > XB_SPIN_CAP) { atomicAdd(&(bar)[XB_TMO], 1u); break; } } } } while (0)

__device__ __forceinline__ int lane_now() { int l; asm volatile("v_mbcnt_lo_u32_b32 %0, -1, 0\n\tv_mbcnt_hi_u32_b32 %0, -1, %0" : "=v"(l)); return l; }
struct XcdBarrier { unsigned* bar; unsigned x; volatile LAS unsigned* st; int wave0; };

__device__ __forceinline__ XcdBarrier xcd_barrier_post(unsigned* bar, volatile LAS unsigned* st) {
    XcdBarrier b; b.bar = bar; b.x = xb_xcc_id(); b.st = st; b.wave0 = __builtin_amdgcn_readfirstlane(threadIdx.x >> 6);
    if (threadIdx.x == 0) (void)xb_add(&bar[XB_XCNT(b.x)], 1u);
    return b;
}
__device__ __forceinline__ void xcd_barrier_complete(unsigned* bar, unsigned x, unsigned& nloc, unsigned& nx) {
    const unsigned G = gridDim.x * gridDim.y * gridDim.z;
    unsigned sum, cnt, mine, sp = 0u;
    for (;;) {
        sum = 0u; cnt = 0u; mine = 0u;
#pragma unroll
        for (unsigned j = 0; j < 16; ++j) { const unsigned c = xb_ld(&bar[XB_XCNT(j)]); sum += c; cnt += (c > 0u) ? 1u : 0u; mine = (j == x) ? c : mine; }
        if (sum == G) break;
        __builtin_amdgcn_s_sleep(1);
        if ((++sp & 255u) == 0u) { if (xb_ld(&bar[XB_TMO])) break; if (sp > XB_SPIN_CAP) { atomicAdd(&bar[XB_TMO], 1u); break; } }
    }
    nloc = mine > 0u ? mine : 1u; nx = cnt > 0u ? cnt : 1u;
}
__device__ __forceinline__ void xcd_barrier_census(const XcdBarrier& b) {
    if (b.wave0 == 0 && lane_now() == 0) { unsigned nloc, nx; xcd_barrier_complete(b.bar, b.x, nloc, nx); b.st[0] = nloc; b.st[1] = nx; }
}
__device__ __forceinline__ void xcd_barrier(const XcdBarrier& b) {
    asm volatile("s_waitcnt vmcnt(0)" ::: "memory");
    __syncthreads();
    if (b.wave0 == 0 && lane_now() == 0) {
        unsigned* bar = b.bar;
        __builtin_amdgcn_s_waitcnt(0);
        const unsigned nloc = b.st[0], nx = b.st[1];
        const unsigned old = xb_add(&bar[XB_XSUB(b.x)], 1u);
        const unsigned gen = old / nloc;
        if (old + 1u == (gen + 1u) * nloc) {
            __builtin_amdgcn_fence(__ATOMIC_RELEASE, "agent");
            asm volatile("s_waitcnt vmcnt(0)" ::: "memory");
            const unsigned og = xb_add(&bar[XB_TOP], 1u);
            const unsigned tg = og / nx;
            if (og + 1u == (tg + 1u) * nx) xb_add(&bar[XB_TOPGEN], 1u);
            else XB_SPIN(xb_ld(&bar[XB_TOPGEN]) == tg, bar);
            __builtin_amdgcn_fence(__ATOMIC_ACQUIRE, "agent");
            xb_add(&bar[XB_XGEN(b.x)], 1u);
            asm volatile("s_waitcnt vmcnt(0)" ::: "memory");
        } else {
            XB_SPIN(xb_ld(&bar[XB_XGEN(b.x)]) == gen, bar);
            __builtin_amdgcn_fence(__ATOMIC_ACQUIRE, "agent");
            asm volatile("s_waitcnt vmcnt(0)" ::: "memory");
        }
    }
    __syncthreads();
}

struct Frame {
    LAS unsigned char* lds;
    volatile LAS unsigned* MISC;
    gu32* ctl;
    int tid, lane, wave, wave0;
    int G, bid;
};
#define REFRESH_IDS(F) do { int w_ = (F).wave0; asm volatile("" : "+s"(w_)); int l_ = lane_now(); asm volatile("" : "+v"(l_)); (F).wave = w_; (F).lane = l_; (F).tid = w_ * 64 + l_; \
    int b_ = blockIdx.x, g_ = gridDim.x; asm volatile("" : "+s"(b_), "+s"(g_)); (F).bid = b_; (F).G = g_; } while (0)

__device__ __forceinline__ float shfl_x(float v, int o, int lane) { return __int_as_float(__builtin_amdgcn_ds_bpermute((lane ^ o) << 2, __float_as_int(v))); }
__device__ __forceinline__ float wave_sum(float v, int lane) {
#pragma unroll
    for (int o = 1; o < 64; o <<= 1) v += shfl_x(v, o, lane);
    return v;
}
__device__ __forceinline__ void p0_transpose_item(const float* W, int K, int N, bf16* WT, LAS float* scr, int item, int lane) {
    const int nblk = N / 32, kb = item / nblk, nb = item % nblk, k0 = 64 * kb, n0 = 32 * nb;
#pragma unroll 8
    for (int i = 0; i < 32; ++i) { const int kk = 2 * i + (lane >> 5); scr[kk * 33 + (lane & 31)] = W[(size_t)(k0 + kk) * N + n0 + (lane & 31)]; }
    LDS_WAIT(); asm volatile("" ::: "memory");
    const int c = lane & 7;
#pragma unroll
    for (int j = 0; j < 4; ++j) { const int n = (lane >> 3) + 8 * j; const LAS float* s = scr + (8 * c) * 33 + n;
        v4u o; o.x = pk2(s[0 * 33], s[1 * 33]); o.y = pk2(s[2 * 33], s[3 * 33]); o.z = pk2(s[4 * 33], s[5 * 33]); o.w = pk2(s[6 * 33], s[7 * 33]);
        *(GAS v4u*)(WT + (size_t)(n0 + n) * K + k0 + 8 * c) = o; }
    LDS_WAIT(); asm volatile("" ::: "memory");
}

__device__ __forceinline__ void p0_prologue(Frame& F) {
    REFRESH_IDS(F);
    const KArgs ka = kargs(); const float* P_win = ka->in[IN_WIN]; const float* P_wout = ka->in[IN_WOUT]; const float* P_poolw = ka->in[IN_POOLW]; bf16* P_WIN = (bf16*)(ka->ws + WS_WIN); bf16* P_WOUT = (bf16*)(ka->ws + WS_WOUT); bf16* P_WPOOL = (bf16*)(ka->ws + WS_WPOOL); const float* P_hlb = ka->in[IN_HLB]; float* P_lb = (float*)(ka->ws + WS_LB); const float* P_adaw = ka->in[IN_ADAW]; const float* P_adab = ka->in[IN_ADAB]; const float* P_c = ka->in[IN_C]; float* P_mod = (float*)(ka->ws + WS_MOD);
    LAS float* scr = (LAS float*)(F.lds + RING_OFF + F.wave * 16384);
    const int gw = F.bid * NWAVES + F.wave, NGW = F.G * NWAVES;
    constexpr int I_IN = (D / 64) * (NZ / 32), I_OUT = (MIXW / 64) * (D / 32), I_PW = (256 / 64) * (256 / 32);
    constexpr int NITEMS = DEPTH * (I_IN + I_OUT + 4 * I_PW);
    for (int it = gw; it < NITEMS; it += NGW) {
        int r = it;
        if (r < DEPTH * I_IN) { const int l = r / I_IN; p0_transpose_item(P_win + (size_t)l * D * NZ, D, NZ, P_WIN + (size_t)l * NZ * D, scr, r % I_IN, F.lane); continue; } r -= DEPTH * I_IN;
        if (r < DEPTH * I_OUT) { const int l = r / I_OUT; p0_transpose_item(P_wout + (size_t)l * MIXW * D, MIXW, D, P_WOUT + (size_t)l * D * MIXW, scr, r % I_OUT, F.lane); continue; } r -= DEPTH * I_OUT;
        { const int lg = r / I_PW; p0_transpose_item(P_poolw + (size_t)lg * 65536, 256, 256, P_WPOOL + (size_t)lg * 65536, scr, r % I_PW, F.lane); }
    }
    if (F.bid == 0) for (int j = F.tid; j < 1024; j += NWAVES * 64) { const float a0 = P_hlb[j], a1 = P_hlb[1024 + j]; P_lb[j] = 0.f; P_lb[1024 + j] = 1.0f / (1.0f + __expf(a0 - a1)); }
    constexpr int AITEMS = DEPTH * (3 * D / 8);
    for (int it = NGW - 1 - gw; it < AITEMS; it += NGW) {
        const int l = it / (3 * D / 8), n0 = (it % (3 * D / 8)) * 8;
        float acc[16][8];
#pragma unroll
        for (int b = 0; b < 16; ++b)
#pragma unroll
            for (int j = 0; j < 8; ++j) acc[b][j] = 0.f;
        for (int i = 0; i < 16; ++i) {
            const int k = F.lane + 64 * i;
            const float* wp = P_adaw + ((size_t)l * D + k) * (3 * D) + n0;
            const f32x4 w0 = *(const f32x4*)wp, w1 = *(const f32x4*)(wp + 4);
#pragma unroll
            for (int b = 0; b < 16; ++b) { const float cv = P_c[b * D + k], s = cv * __builtin_amdgcn_rcpf(1.0f + __expf(-cv));
#pragma unroll
                for (int j = 0; j < 4; ++j) { acc[b][j] += s * w0[j]; acc[b][4 + j] += s * w1[j]; } }
        }
        float* av = &acc[0][0];
#define TR_STEP(N, OFF) _Pragma("unroll") for (int i = 0; i < (N) / 2; ++i) { const bool up = (F.lane & (OFF)) != 0; const float keep = up ? av[i + (N) / 2] : av[i], send = up ? av[i] : av[i + (N) / 2]; av[i] = keep + shfl_x(send, (OFF), F.lane); }
        TR_STEP(128, 32) TR_STEP(64, 16) TR_STEP(32, 8) TR_STEP(16, 4) TR_STEP(8, 2) TR_STEP(4, 1)
#undef TR_STEP
        { const int b = F.lane >> 2, j = (F.lane & 3) * 2; const float* bp = P_adab + l * 3 * D + n0 + j;
          float* mp = P_mod + ((size_t)l * BATCH + b) * (3 * D) + n0 + j; mp[0] = av[0] + bp[0]; mp[1] = av[1] + bp[1]; }
    }
}

__device__ __forceinline__ void rowpass(Frame& F, int l) {
    REFRESH_IDS(F);
    const KArgs ka = kargs(); const float* P_x = ka->in[IN_X]; float* P_out = ka->out; bf16* P_Y = (bf16*)(ka->ws + WS_Y); float* P_mod = (float*)(ka->ws + WS_MOD); const float* P_npost = ka->in[IN_NPOST]; const float* P_npre = ka->in[IN_NPRE]; bf16* P_XN = (bf16*)(ka->ws + WS_XN);
    const int gw = F.bid * NWAVES + F.wave, NGW = F.G * NWAVES;
    const int ln = l + 1;
    for (int m = gw; m < M; m += NGW) {
        const int b = m / SEQ;
        f32x4 v[4];
        const float* xin = (l <= 0 ? P_x : (const float*)P_out) + (size_t)m * D;
#pragma unroll
        for (int j = 0; j < 4; ++j) v[j] = *((const GAS f32x4*)xin + F.lane + 64 * j);
        if (l >= 0) {
            const GAS v2u* yr = (const GAS v2u*)(P_Y + (size_t)m * D) + F.lane;
            f32x4 y[4]; float ss = 0.f;
#pragma unroll
            for (int j = 0; j < 4; ++j) { const v2u w = yr[64 * j]; y[j] = (f32x4){bflo(w.x), bfhi(w.x), bflo(w.y), bfhi(w.y)}; ss += (y[j].x * y[j].x + y[j].y * y[j].y) + (y[j].z * y[j].z + y[j].w * y[j].w); }
            const float r = __builtin_amdgcn_rsqf(wave_sum(ss, F.lane) * (1.f / D) + EPS);
            const float* gate = P_mod + ((size_t)l * BATCH + b) * (3 * D) + 2 * D;
            const float* wp = P_npost + l * D;
#pragma unroll
            for (int j = 0; j < 4; ++j) { const f32x4 g = *((const f32x4*)gate + F.lane + 64 * j), w = *((const f32x4*)wp + F.lane + 64 * j); v[j] = v[j] + g * (y[j] * r * w);
                *((GAS f32x4*)(P_out + (size_t)m * D) + F.lane + 64 * j) = v[j]; }
        }
        if (ln < DEPTH) {
            float ss = 0.f;
#pragma unroll
            for (int j = 0; j < 4; ++j) ss += (v[j].x * v[j].x + v[j].y * v[j].y) + (v[j].z * v[j].z + v[j].w * v[j].w);
            const float r = __builtin_amdgcn_rsqf(wave_sum(ss, F.lane) * (1.f / D) + EPS);
            const float* shift = P_mod + ((size_t)ln * BATCH + b) * (3 * D); const float* scale = shift + D; const float* wp = P_npre + ln * D;
            GAS v2u* o = (GAS v2u*)(P_XN + (size_t)m * D) + F.lane;
#pragma unroll
            for (int j = 0; j < 4; ++j) { const f32x4 sh = *((const f32x4*)shift + F.lane + 64 * j), sc = *((const f32x4*)scale + F.lane + 64 * j), w = *((const f32x4*)wp + F.lane + 64 * j);
                const f32x4 h = v[j] * r * w * (sc + 1.0f) + sh; v2u pw; pw.x = pk2(h.x, h.y); pw.y = pk2(h.z, h.w); o[64 * j] = pw; }
        }
    }
}

__device__ __forceinline__ void dpass(Frame& F, const int first, const int count) {
    const KArgs ka = kargs(); bf16* P_U = (bf16*)(ka->ws + WS_U); bf16* DP = (bf16*)(ka->ws + WS_XN);
    constexpr int RUN = 32;
    const int g = F.tid >> 7, w = 2 << g;
    for (int run = first; run < M / RUN; run += count) {
        const int t0 = run * RUN, tp0 = t0 & (SEQ - 1);
        const GAS unsigned* up = (const GAS unsigned*)(P_U + (size_t)t0 * D) + F.tid;
        GAS unsigned* dp = (GAS unsigned*)(DP + (size_t)t0 * D) + F.tid;
        float s0 = 0.f, s1 = 0.f;
        for (int i = 1; i < w; ++i) if (tp0 - i >= 0) { const unsigned xw = up[-(long)i * (D / 2)]; s0 += bflo(xw); s1 += bfhi(xw); }
        for (int r = 0; r < RUN; ++r) {
            const unsigned xw = up[(long)r * (D / 2)]; const float x0 = bflo(xw), x1 = bfhi(xw); s0 += x0; s1 += x1;
            const int tp = tp0 + r;
            const float inv = 1.0f / (float)(tp + 1 < w ? tp + 1 : w);
            dp[(long)r * (D / 2)] = pk2(s0 * inv - x0, s1 * inv - x1);
            if (tp + 1 >= w) { const unsigned yw = up[(long)(r + 1 - w) * (D / 2)]; s0 -= bflo(yw); s1 -= bfhi(yw); }
        }
    }
}

__device__ __forceinline__ void hgrn_naive(Frame& F, int l) {
    REFRESH_IDS(F);
    const KArgs ka = kargs(); const float* P_hnw = ka->in[IN_HNW]; bf16* P_Q = (bf16*)(ka->ws + WS_Q); bf16* P_LF = (bf16*)(ka->ws + WS_LF); bf16* P_V = (bf16*)(ka->ws + WS_V); bf16* P_MIX = (bf16*)(ka->ws + WS_MIX);
    LAS float* qs = (LAS float*)(F.lds + RING_OFF);
    LAS float* fs = qs + 2048; LAS float* ks = fs + 2048; LAS float* vs = ks + 2048;
    LAS float* part = vs + 2048;
    const int v = F.tid & 127, kg = F.tid >> 7;
    const float* nw = P_hnw + l * HD;
    for (int unit = F.bid; unit < BATCH * NHEAD; unit += F.G) {
        const int b = unit / NHEAD, h = unit % NHEAD;
        float S[32];
#pragma unroll
        for (int i = 0; i < 32; ++i) S[i] = 0.f;
        const size_t rb = (size_t)b * SEQ;
        for (int t0 = 0; t0 < SEQ; t0 += 16) {
            { const int tt = F.tid >> 5, ch = (F.tid & 31) * 4; const size_t off = (rb + t0 + tt) * D + h * HD + ch;
              const v2u qw = *(const GAS v2u*)(P_Q + off), lw = *(const GAS v2u*)(P_LF + off), vw = *(const GAS v2u*)(P_V + off);
              const float lf[4] = {h2f_lo(lw.x), h2f_hi(lw.x), h2f_lo(lw.y), h2f_hi(lw.y)};
              const float qq[4] = {bflo(qw.x), bfhi(qw.x), bflo(qw.y), bfhi(qw.y)}, vv[4] = {bflo(vw.x), bfhi(vw.x), bflo(vw.y), bfhi(vw.y)};
#pragma unroll
              for (int e = 0; e < 4; ++e) { const float f = __expf(lf[e]); fs[tt * 128 + ch + e] = f; ks[tt * 128 + ch + e] = 1.0f - f; qs[tt * 128 + ch + e] = qq[e]; vs[tt * 128 + ch + e] = vv[e]; } }
            __syncthreads();
            for (int tt = 0; tt < 16; ++tt) {
                const float vv = vs[tt * 128 + v]; float po = 0.f;
#pragma unroll
                for (int i = 0; i < 32; ++i) { const float f = fs[tt * 128 + kg * 32 + i], k = ks[tt * 128 + kg * 32 + i], q = qs[tt * 128 + kg * 32 + i]; S[i] = f * S[i] + k * vv; po += q * S[i]; }
                part[(tt * 4 + kg) * 128 + v] = po;
            }
            __syncthreads();
#pragma unroll
            for (int e = 0; e < 2; ++e) { const int tt = F.wave * 2 + e;
                float o0 = 0.f, o1 = 0.f;
#pragma unroll
                for (int k4 = 0; k4 < 4; ++k4) { o0 += part[(tt * 4 + k4) * 128 + F.lane]; o1 += part[(tt * 4 + k4) * 128 + 64 + F.lane]; }
                const float r = __builtin_amdgcn_rsqf(wave_sum(o0 * o0 + o1 * o1, F.lane) * (1.f / HD) + EPS);
                GAS bf16* gp = (GAS bf16*)(P_MIX + (rb + t0 + tt) * MIXW + D + h * HD);
                const float g0 = __uint_as_float((unsigned)gp[F.lane] << 16), g1 = __uint_as_float((unsigned)gp[64 + F.lane] << 16);
                gp[F.lane] = (bf16)f2bf(o0 * r * nw[F.lane] * g0); gp[64 + F.lane] = (bf16)f2bf(o1 * r * nw[64 + F.lane] * g1); }
        }
        __syncthreads();
    }
}

namespace hg {
typedef short bf16x8 __attribute__((ext_vector_type(8)));
typedef short s16x4 __attribute__((ext_vector_type(4)));
typedef float f32x4 __attribute__((ext_vector_type(4)));
typedef float f32x2 __attribute__((ext_vector_type(2)));
typedef unsigned u32x2 __attribute__((ext_vector_type(2)));
typedef unsigned u32x4 __attribute__((ext_vector_type(4)));
typedef __bf16 bf16x2_t __attribute__((ext_vector_type(2)));
constexpr int L_QT = 0, L_QB = 16384, L_K1 = 24576, L_K2 = 32768, L_KH = 49152  , L_V = 67584  , L_P = 86016  ,
              L_DEC = 92160  , L_TOT = 92672  , L_SSQ = 96768  , L_RS = 98816  , L_END = 100864;
constexpr int VSTR = 288;
__device__ __forceinline__ unsigned cvtpk(float lo, float hi) { f32x2 v = {lo, hi}; bf16x2_t b = __builtin_convertvector(v, bf16x2_t); return __builtin_bit_cast(unsigned, b); }
__device__ __forceinline__ int perm32x(int x) { return 8 * ((x >> 2) & 3) + 4 * (x >> 4) + (x & 3); }
__device__ __forceinline__ bf16x8 ld128(const LAS unsigned char* p) { return *(const LAS bf16x8*)p; }
__device__ __forceinline__ s16x4 ldtr(const LAS unsigned char* p) { typedef short v4i16_t __attribute__((ext_vector_type(4))); return __builtin_bit_cast(s16x4, __builtin_amdgcn_ds_read_tr16_b64_v4i16((LAS v4i16_t*)p)); }
__device__ __forceinline__ bf16x8 cat(s16x4 a, s16x4 b) { return (bf16x8){a[0], a[1], a[2], a[3], b[0], b[1], b[2], b[3]}; }
#define HG_DPP(v, ctrl) __int_as_float(__builtin_amdgcn_update_dpp(0, __float_as_int(v), (ctrl), 0xf, 0xf, true))
__device__ __forceinline__ float row16_sum(float v) {
    v += HG_DPP(v, 0xB1); v += HG_DPP(v, 0x4E); v += HG_DPP(v, 0x141); v += HG_DPP(v, 0x140); return v;
}
#define HG_LBAR() do { asm volatile("s_waitcnt lgkmcnt(0)" ::: "memory"); __builtin_amdgcn_s_barrier(); asm volatile("" ::: "memory"); } while (0)

__device__ __forceinline__ void hgrn_unit(LAS unsigned char* lds, const int tid, const int lane, const int wave, const int b, const int h,
                                          const bf16* Qg, const bf16* LFg, const bf16* Vg, bf16* MIXg, const float* nw) {
    const int c16 = lane & 15, g = lane >> 4, cp = lane, tg = wave;
    const int c0 = 2 * cp, pcl = perm32x(c0 & 31), pcg = c0 >> 5;
    const size_t rowbase = (size_t)b * SEQ;
    const GAS unsigned* Qp = (const GAS unsigned*)(Qg + rowbase * D + h * HD) + cp + (size_t)(8 * tg) * (D / 2);
    const GAS unsigned* Lp = (const GAS unsigned*)(LFg + rowbase * D + h * HD) + cp + (size_t)(8 * tg) * (D / 2);
    const GAS u32x4* Vp = (const GAS u32x4*)(Vg + (rowbase + (tid >> 3)) * D + h * HD + (tid & 7) * 16);
    GAS bf16* Gp = (GAS bf16*)(MIXg + (rowbase + 4 * g) * MIXW + D + h * HD + 16 * wave + c16);
    const float nwv = nw[16 * wave + c16];
    const int ew = ((tg >> 1) * 4 + pcg) * 1024 + (((tg & 1) * 512 + pcl * 2) ^ ((tg & 1) * 32));
    const int ewb = (((tg & 3) >> 1) * 4 + pcg) * 1024 + (((tg & 1) * 512 + pcl * 2) ^ ((tg & 1) * 32));
    const int ekh = (8 * tg) * VSTR + c0 * 2;
    const int evw = (tid >> 3) * VSTR + (tid & 7) * 32;
    const int lo = (c16 * 64 + 16 * g) ^ ((c16 >> 3) << 5);
    const int trq = (c16 >> 2) * VSTR + (c16 & 3) * 8 + (4 * g) * VSTR;
    f32x4 S[8];
#pragma unroll
    for (int i = 0; i < 8; ++i) S[i] = (f32x4){0.f, 0.f, 0.f, 0.f};
    if (wave == 0) { *(LAS u32x2*)(lds + L_P + 0 * 1024 + lane * 16 + 8) = (u32x2){0u, 0u}; *(LAS u32x2*)(lds + L_P + 3 * 1024 + lane * 16 + 8) = (u32x2){0u, 0u}; }
    unsigned qr[8], lr[8]; u32x4 vr[2]; unsigned short gr[16];
#define HG_LOADS(c) do { _Pragma("unroll") for (int i = 0; i < 8; ++i) { qr[i] = Qp[((size_t)(c) * 64 + i) * (D / 2)]; lr[i] = Lp[((size_t)(c) * 64 + i) * (D / 2)]; } \
        vr[0] = Vp[(size_t)(c) * 64 * (D / 8)]; vr[1] = Vp[(size_t)(c) * 64 * (D / 8) + 1]; } while (0)
    HG_LOADS(0);
#pragma unroll 1
    for (int c = 0; c < SEQ / 64; ++c) {
        float p0[8], p1[8]; float a0 = 0.f, a1 = 0.f;
#pragma unroll
        for (int i = 0; i < 8; ++i) { a0 += h2f_lo(lr[i]); a1 += h2f_hi(lr[i]); p0[i] = a0; p1[i] = a1; }
        *(LAS f32x2*)(lds + L_TOT + (tg * 128 + c0) * 4) = (f32x2){a0, a1};
        *(LAS u32x4*)(lds + L_V + evw) = vr[0]; *(LAS u32x4*)(lds + L_V + evw + 16) = vr[1];
        HG_LBAR();
        float off0 = 0.f, off1 = 0.f, R0 = 0.f, R1 = 0.f, L0 = 0.f, L1 = 0.f;
#pragma unroll
        for (int j = 0; j < 8; ++j) { const f32x2 t = *(const LAS f32x2*)(lds + L_TOT + (j * 128 + c0) * 4);
            if (j < tg) { off0 += t.x; off1 += t.y; } if (j < 4) { R0 += t.x; R1 += t.y; } L0 += t.x; L1 += t.y; }
        const float eR0 = __expf(R0), eR1 = __expf(R1), eLR0 = __expf(L0 - R0), eLR1 = __expf(L1 - R1);
        if (tg == 0) *(LAS f32x2*)(lds + L_DEC + c0 * 4) = (f32x2){__expf(L0), __expf(L1)};
        if (tg >= 4) {
#pragma unroll
            for (int i = 0; i < 8; ++i) {
                const float B0 = off0 + p0[i], B1 = off1 + p1[i], q0 = bflo(qr[i]), q1 = bfhi(qr[i]);
                const float k0 = 1.0f - __expf(h2f_lo(lr[i])), k1 = 1.0f - __expf(h2f_hi(lr[i]));
                const float e10 = __expf(B0 - R0), e11 = __expf(B1 - R1), e20 = __expf(fminf(R0 - B0, 80.f)), e21 = __expf(fminf(R1 - B1, 80.f));
                *(LAS unsigned*)(lds + L_QT + ew + 64 * i) = cvtpk(q0 * e10 * eR0, q1 * e11 * eR1);
                *(LAS unsigned*)(lds + L_QB + ewb + 64 * i) = cvtpk(q0 * e10, q1 * e11);
                *(LAS unsigned*)(lds + L_K2 + ew + 64 * i) = cvtpk(k0 * e20, k1 * e21);
                *(LAS unsigned*)(lds + L_KH + ekh + VSTR * i) = cvtpk(k0 * e20 * eLR0, k1 * e21 * eLR1);
            }
        } else {
#pragma unroll
            for (int i = 0; i < 8; ++i) {
                const float B0 = off0 + p0[i], B1 = off1 + p1[i], q0 = bflo(qr[i]), q1 = bfhi(qr[i]);
                const float k0 = 1.0f - __expf(h2f_lo(lr[i])), k1 = 1.0f - __expf(h2f_hi(lr[i]));
                const float e00 = __expf(B0), e01 = __expf(B1), e30 = __expf(fminf(-B0, 80.f)), e31 = __expf(fminf(-B1, 80.f));
                const float k20 = k0 * e30 * eR0, k21 = k1 * e31 * eR1;
                *(LAS unsigned*)(lds + L_QT + ew + 64 * i) = cvtpk(q0 * e00, q1 * e01);
                *(LAS unsigned*)(lds + L_K1 + ewb + 64 * i) = cvtpk(k0 * e30, k1 * e31);
                *(LAS unsigned*)(lds + L_K2 + ew + 64 * i) = cvtpk(k20, k21);
                *(LAS unsigned*)(lds + L_KH + ekh + VSTR * i) = cvtpk(k20 * eLR0, k21 * eLR1);
            }
        }
        HG_LBAR();
        if (c + 1 < SEQ / 64) HG_LOADS(c + 1);
#pragma unroll
        for (int tb = 0; tb < 4; ++tb)
#pragma unroll
            for (int r = 0; r < 4; ++r) gr[tb * 4 + r] = Gp[((size_t)c * 64 + 16 * tb + r) * MIXW];
#pragma unroll
        for (int rep = 0; rep < 2; ++rep) {
            const int ti = wave + 8 * rep;
            if (ti < 10) {
                const int tb = ti < 1 ? 0 : ti < 3 ? 1 : ti < 6 ? 2 : 3, sb = ti - (tb == 0 ? 0 : tb == 1 ? 1 : tb == 2 ? 3 : 6);
                const LAS unsigned char* kb = lds + (tb < 2 ? L_K1 : L_K2) + sb * 4096 + lo;
                const LAS unsigned char* qb = lds + (tb < 2 ? L_QT + tb * 4096 : L_QB + (tb - 2) * 4096) + lo;
                f32x4 acc = (f32x4){0.f, 0.f, 0.f, 0.f};
#pragma unroll
                for (int ks = 0; ks < 4; ++ks) acc = __builtin_amdgcn_mfma_f32_16x16x32_bf16(ld128(kb + ks * 1024), ld128(qb + ks * 1024), acc, 0, 0, 0);
                if (sb == tb) {
#pragma unroll
                    for (int r = 0; r < 4; ++r) acc[r] = (4 * g + r <= c16) ? acc[r] : 0.f;
                }
                const int fi = tb < 2 ? tb : 2 * tb - 2 + (sb >> 1);
                *(LAS u32x2*)(lds + L_P + fi * 1024 + lane * 16 + 8 * (sb & 1)) = (u32x2){cvtpk(acc[0], acc[1]), cvtpk(acc[2], acc[3])};
            }
        }
        bf16x8 vb[2];
#pragma unroll
        for (int kk = 0; kk < 2; ++kk) { const LAS unsigned char* vp = lds + L_V + trq + (32 * kk) * VSTR + (16 * wave) * 2; vb[kk] = cat(ldtr(vp), ldtr(vp + 16 * VSTR)); }
        f32x4 o[4];
#pragma unroll
        for (int tb = 0; tb < 4; ++tb) o[tb] = (f32x4){0.f, 0.f, 0.f, 0.f};
#pragma unroll
        for (int kk = 0; kk < 4; ++kk) {
            const u32x4 sw = (u32x4){cvtpk(S[2 * kk][0], S[2 * kk][1]), cvtpk(S[2 * kk][2], S[2 * kk][3]), cvtpk(S[2 * kk + 1][0], S[2 * kk + 1][1]), cvtpk(S[2 * kk + 1][2], S[2 * kk + 1][3])};
            const bf16x8 sbf = __builtin_bit_cast(bf16x8, sw);
#pragma unroll
            for (int tb = 0; tb < 4; ++tb) o[tb] = __builtin_amdgcn_mfma_f32_16x16x32_bf16(ld128(lds + L_QT + (tb * 4 + kk) * 1024 + lo), sbf, o[tb], 0, 0, 0);
        }
#pragma unroll
        for (int dkb = 0; dkb < 8; ++dkb) {
            const f32x4 dv = *(const LAS f32x4*)(lds + L_DEC + (16 * dkb + 4 * g) * 4);
            f32x4 s = S[dkb] * dv;
#pragma unroll
            for (int kk = 0; kk < 2; ++kk) { const LAS unsigned char* kp = lds + L_KH + trq + (32 * kk) * VSTR + (16 * dkb) * 2;
                s = __builtin_amdgcn_mfma_f32_16x16x32_bf16(cat(ldtr(kp), ldtr(kp + 16 * VSTR)), vb[kk], s, 0, 0, 0); }
            S[dkb] = s;
        }
        HG_LBAR();
        o[0] = __builtin_amdgcn_mfma_f32_16x16x32_bf16(ld128(lds + L_P + 0 * 1024 + lane * 16), vb[0], o[0], 0, 0, 0);
        o[1] = __builtin_amdgcn_mfma_f32_16x16x32_bf16(ld128(lds + L_P + 1 * 1024 + lane * 16), vb[0], o[1], 0, 0, 0);
        o[2] = __builtin_amdgcn_mfma_f32_16x16x32_bf16(ld128(lds + L_P + 2 * 1024 + lane * 16), vb[0], o[2], 0, 0, 0);
        o[2] = __builtin_amdgcn_mfma_f32_16x16x32_bf16(ld128(lds + L_P + 3 * 1024 + lane * 16), vb[1], o[2], 0, 0, 0);
        o[3] = __builtin_amdgcn_mfma_f32_16x16x32_bf16(ld128(lds + L_P + 4 * 1024 + lane * 16), vb[0], o[3], 0, 0, 0);
        o[3] = __builtin_amdgcn_mfma_f32_16x16x32_bf16(ld128(lds + L_P + 5 * 1024 + lane * 16), vb[1], o[3], 0, 0, 0);
#pragma unroll
        for (int tb = 0; tb < 4; ++tb) { f32x4 q2 = o[tb] * o[tb];
#pragma unroll
            for (int r = 0; r < 4; ++r) q2[r] = row16_sum(q2[r]);
            if (c16 == 0) *(LAS f32x4*)(lds + L_SSQ + (wave * 64 + 16 * tb + 4 * g) * 4) = q2; }
        HG_LBAR();
        { float ss = 0.f;
#pragma unroll
          for (int w2 = 0; w2 < 8; ++w2) ss += *(const LAS float*)(lds + L_SSQ + (w2 * 64 + lane) * 4);
          *(LAS float*)(lds + L_RS + (wave * 64 + lane) * 4) = __builtin_amdgcn_rsqf(ss * (1.0f / HD) + EPS); }
        asm volatile("s_waitcnt lgkmcnt(0)" ::: "memory");
#pragma unroll
        for (int tb = 0; tb < 4; ++tb) { const f32x4 rs = *(const LAS f32x4*)(lds + L_RS + (wave * 64 + 16 * tb + 4 * g) * 4);
#pragma unroll
            for (int r = 0; r < 4; ++r) Gp[((size_t)c * 64 + 16 * tb + r) * MIXW] = (bf16)f2bf(o[tb][r] * rs[r] * nwv * __uint_as_float((unsigned)gr[tb * 4 + r] << 16)); }
    }
#undef HG_LOADS
    HG_LBAR();
}
}


__device__ __forceinline__ void mixer_phase(Frame& F, const int l) {
    REFRESH_IDS(F);
    const int nh = F.G < BATCH * NHEAD ? F.G : BATCH * NHEAD;
    if (F.bid < nh) {
        const KArgs ka = kargs(); const float* nw = ka->in[IN_HNW] + l * HD;
        const bf16* Qg = (const bf16*)(ka->ws + WS_Q); const bf16* LFg = (const bf16*)(ka->ws + WS_LF); const bf16* Vg = (const bf16*)(ka->ws + WS_V); bf16* MIXg = (bf16*)(ka->ws + WS_MIX);
        for (int unit = F.bid; unit < BATCH * NHEAD; unit += nh) hg::hgrn_unit(F.lds + RING_OFF, F.tid, F.lane, F.wave, unit / NHEAD, unit % NHEAD, Qg, LFg, Vg, MIXg, nw);
    }
    if (F.G > nh) { if (F.bid >= nh) dpass(F, F.bid - nh, F.G - nh); }
    else dpass(F, F.bid, F.G);
}

#ifndef DBG_KINDS
#define DBG_KINDS 0x7f
#endif
#define KIND(j) ((DBG_KINDS >> (j)) & 1)
#define IN(k) (lo <= (k) && (k) < hi)
#define BOTH(k) (IN(k) && IN((k) + 1))
#define GRID_BAR() do { if (N_LAUNCHES == 1) xcd_barrier(bar); } while (0)
template <int l> __device__ __forceinline__ void layer_phases(Frame& F, const XcdBarrier& bar, const int lo, const int hi) {
        const int p = 2 + 5 * l;
    if (KIND(2) && IN(p)) {
        const KArgs ka = kargs(); bf16* P_XN = (bf16*)(ka->ws + WS_XN); bf16* P_WIN = (bf16*)(ka->ws + WS_WIN);
        pg8::Gemm g{P_XN, P_WIN + (size_t)l * NZ * D, M, NZ, D, D, 0}; pg8::StaticOrder S; REFRESH_IDS(F); S.init(M, NZ, F.G, F.bid);
        pg8::EpiZ E{l};
        pg8::gemm_phase<pg8::EpiZ, pg8::StaticOrder, PG8_ALIGN, PG8_SP2>(F.lds + RING_OFF, g, S, E, F.tid);
        if (BOTH(p)) GRID_BAR();
    }
    if (KIND(3) && IN(p + 1)) {
#if defined(HGRN_NAIVE)
        REFRESH_IDS(F); dpass(F, F.bid, F.G);
        hgrn_naive(F, l);
#else
        mixer_phase(F, l);
#endif
        if (BOTH(p + 1)) GRID_BAR();
    }
    if (KIND(4) && IN(p + 2)) {
        const KArgs ka = kargs(); bf16* P_XN = (bf16*)(ka->ws + WS_XN); bf16* P_WPOOL = (bf16*)(ka->ws + WS_WPOOL);
        pg8::Gemm g{P_XN, P_WPOOL + (size_t)l * 4 * 65536, M, D, 256, D, 256}; pg8::StaticOrder S; REFRESH_IDS(F); S.init(M, D, F.G, F.bid);
        pg8::EpiPool E{l};
        pg8::gemm_phase<pg8::EpiPool, pg8::StaticOrder, PG8_ALIGN, PG8_SP2>(F.lds + RING_OFF, g, S, E, F.tid);
        if (BOTH(p + 2)) GRID_BAR();
    }
    if (KIND(5) && IN(p + 3)) {
        const KArgs ka = kargs(); bf16* P_MIX = (bf16*)(ka->ws + WS_MIX); bf16* P_WOUT = (bf16*)(ka->ws + WS_WOUT);
        pg8::Gemm g{P_MIX, P_WOUT + (size_t)l * D * MIXW, M, D, MIXW, MIXW, 0}; pg8::StaticOrder S; REFRESH_IDS(F); S.init(M, D, F.G, F.bid);
        pg8::EpiBf16Plain E{WS_Y, D};
        pg8::gemm_phase<pg8::EpiBf16Plain, pg8::StaticOrder, PG8_ALIGN, PG8_SP2>(F.lds + RING_OFF, g, S, E, F.tid);
        if (BOTH(p + 3)) GRID_BAR();
    }
    if (KIND(6) && IN(p + 4)) {
        rowpass(F, l);
        if (BOTH(p + 4)) GRID_BAR();
    }
}

__global__ void __launch_bounds__(NWAVES * 64, 2) skel_fwd(Args args) {
    extern __shared__ __attribute__((aligned(16))) unsigned char lds[];
    Frame F;
    F.lds = (LAS unsigned char*)lds;
    F.MISC = (volatile LAS unsigned*)(F.lds + MISC_OFF);
    F.tid = threadIdx.x; F.lane = F.tid & 63; F.wave = __builtin_amdgcn_readfirstlane(F.tid >> 6); F.wave0 = F.wave;
    F.G = gridDim.x; F.bid = blockIdx.x;
    F.ctl = (gu32*)(args.ws + WS_CTL);
    for (int u = F.tid; u < (LDS_BYTES - LDSCTL_OFF) / 4; u += NWAVES * 64) ((LAS unsigned*)(F.lds + LDSCTL_OFF))[u] = 0u;
    __syncthreads();
    XcdBarrier bar; bar.bar = (unsigned*)(F.ctl + CW_BAR); bar.x = 0; bar.st = nullptr; bar.wave0 = F.wave0;
    if (N_LAUNCHES == 1) bar = xcd_barrier_post((unsigned*)(F.ctl + CW_BAR), F.MISC + 8);
    const int lo = (N_LAUNCHES == 1) ? 0 : args.ph_lo, hi = (N_LAUNCHES == 1) ? N_PHASES : args.ph_hi;

    if (KIND(0) && IN(0)) { p0_prologue(F); if (N_LAUNCHES == 1) xcd_barrier_census(bar); if (BOTH(0)) GRID_BAR(); }
    if (KIND(1) && IN(1)) { rowpass(F, -1); if (BOTH(1)) GRID_BAR(); }
    layer_phases<0>(F, bar, lo, hi);
    layer_phases<1>(F, bar, lo, hi);
    static_assert(DEPTH == 2, "two explicit layer_phases calls");
#undef IN
#undef BOTH
}

extern "C" void kernel_launch(void* const* d_in, const int* in_sizes, int n_in, void* d_out, int out_size, void* d_ws, size_t ws_size, hipStream_t stream) {
    static int grid = 0;
    if (grid == 0) {
        if (n_in != 12 || in_sizes[0] != M * D || out_size != M * D || ws_size < WS_END) { fprintf(stderr, "kernel_launch: unexpected shapes: n_in %d in0 %d out %d ws %zu\n", n_in, n_in > 0 ? in_sizes[0] : -1, out_size, ws_size); grid = -1; return; }
        int dev = 0, cus = 0, per_cu = 0;
        if (hipGetDevice(&dev) != hipSuccess || hipDeviceGetAttribute(&cus, hipDeviceAttributeMultiprocessorCount, dev) != hipSuccess) { grid = -1; return; }
        if (hipFuncSetAttribute((const void*)skel_fwd, hipFuncAttributeMaxDynamicSharedMemorySize, LDS_BYTES) != hipSuccess) { fprintf(stderr, "kernel_launch: hipFuncSetAttribute failed\n"); grid = -1; return; }
        if (hipOccupancyMaxActiveBlocksPerMultiprocessor(&per_cu, (const void*)skel_fwd, NWAVES * 64, LDS_BYTES) != hipSuccess || per_cu < 1) { fprintf(stderr, "kernel_launch: occupancy query says %d blocks per CU\n", per_cu); per_cu = 1; }
        (void)hipGetLastError();
        grid = cus;
    }
    if (grid < 0) return;
    if (hipMemsetAsync((char*)d_ws + WS_CTL, 0, CTL_ZERO_BYTES, stream) != hipSuccess) { fprintf(stderr, "kernel_launch: memset failed\n"); return; }
    Args a{};
    for (int i = 0; i < 12; ++i) a.in[i] = (const float*)d_in[i];
    a.out = (float*)d_out; a.ws = (unsigned char*)d_ws;
    for (int li = 0; li < N_LAUNCHES; ++li) {
        a.ph_lo = (N_LAUNCHES == 1) ? 0 : li; a.ph_hi = (N_LAUNCHES == 1) ? N_PHASES : li + 1; a.li = li;
        hipLaunchKernelGGL(skel_fwd, dim3(grid), dim3(NWAVES * 64), LDS_BYTES, stream, a);
        const hipError_t le = hipPeekAtLastError();
        if (le != hipSuccess) { fprintf(stderr, "kernel_launch: launch %d failed: %s\n", li, hipGetErrorName(le)); break; }
    }
}
```

```cpp
#include <hip/hip_runtime.h>
#include <cstdio>
#include <cstdint>

#ifndef MK_N_LAUNCHES
#define MK_N_LAUNCHES 1
#endif

constexpr int NWAVES = 8;
constexpr int N_LAUNCHES = MK_N_LAUNCHES;
constexpr int BATCH = 16, SEQ = 2048, D = 1024, DEPTH = 2, NZ = 6144, MIXW = 2048, NHEAD = 8, HD = 128;
constexpr int M = BATCH * SEQ;
constexpr float EPS = 1e-6f;
constexpr int N_PHASES = 2 + 4 * DEPTH;

constexpr size_t MiB = 1u << 20;
constexpr size_t WS_CTL = 0, CTL_ZERO_BYTES = 1 * MiB;
constexpr size_t WS_MOD = 1 * MiB;
constexpr size_t WS_LB = 1 * MiB + 512 * 1024;
constexpr size_t WS_WIN = 2 * MiB;
constexpr size_t WS_WOUT = 26 * MiB;
constexpr size_t WS_WPOOL = 34 * MiB;
constexpr size_t WS_XN = 36 * MiB;
constexpr size_t WS_U = 100 * MiB, WS_Q = 164 * MiB, WS_LF = 228 * MiB, WS_V = 292 * MiB;
constexpr size_t WS_MIX = 356 * MiB;
constexpr size_t WS_Y = WS_U;
constexpr size_t WS_END = 484 * MiB;
constexpr int CW_TMO = 0, CW_CODE = 1;
constexpr int CW_BAR = 4096;


struct Args { const float* in[12]; float* out; unsigned char* ws; int ph_lo, ph_hi, li, pad; };
typedef const __attribute__((address_space(4))) Args* KArgs;
__device__ __forceinline__ KArgs kargs() { KArgs p = (KArgs)__builtin_amdgcn_kernarg_segment_ptr(); asm volatile("" : "+s"(p)); return p; }
enum { IN_X = 0, IN_C, IN_NPRE, IN_ADAW, IN_ADAB, IN_WIN, IN_POOLW, IN_PSCALE, IN_HLB, IN_HNW, IN_WOUT, IN_NPOST };

namespace pg8 {
#define PG8_LAS __attribute__((address_space(3)))
typedef unsigned short bf16_t;
typedef short bf16x8 __attribute__((ext_vector_type(8)));
typedef float f32x4 __attribute__((ext_vector_type(4)));
typedef unsigned u32x4 __attribute__((ext_vector_type(4)));
constexpr int BM = 256, BK = 64, HALF = 128, HTB = HALF * BK * 2  , STAGE_BYTES = 8 * HTB, NXCD = 8, WGM = 8;

__host__ __device__ __forceinline__ int lds_byte(int r, int c) { const int st = (r >> 4) * 2 + (c >> 5), rr = r & 15, cc = c & 31, ob = rr * 64 + cc * 2; return st * 1024 + (ob ^ (((ob >> 9) & 1) << 5)); }
__host__ __device__ __forceinline__ void stage_rc(int b, int& R, int& C) { const int st = b / 1024, sb = b % 1024, swz = sb ^ (((sb >> 9) & 1) << 5); R = (st >> 1) * 16 + swz / 64; C = (st & 1) * 32 + (swz % 64) / 2; }
__host__ __device__ __forceinline__ int perm32(int rho) { const int n = rho >> 4, i = rho & 15; return 8 * (i >> 2) + 4 * n + (i & 3); }

struct Unit { int pm, pn; };
struct Gemm { const bf16_t* A; const bf16_t* Bt; int M, N, K, lda, acol; };

struct StaticOrder {
    int nM, nN, nwg, G, c;
    __host__ __device__ void init(int M, int N, int G_, int c_) { nM = M / BM; nN = N / BM; nwg = nM * nN; G = G_; c = c_; }
    __host__ __device__ bool next(int i, Unit& u) const {
        const long L = (long)i * G + c; if (L >= nwg) return false;
        int wgid = (int)L; { const int q = nwg / NXCD, r = nwg % NXCD, xcd = wgid % NXCD, off = wgid / NXCD; wgid = (xcd < r ? xcd * (q + 1) : r * (q + 1) + (xcd - r) * q) + off; }
        const int nig = WGM * nN, gid = wgid / nig, fm = gid * WGM, gsz = (nM - fm) < WGM ? (nM - fm) : WGM;
        u.pm = fm + ((wgid % nig) % gsz); u.pn = (wgid % nig) / gsz; return true;
    }
    __device__ __forceinline__ void a_ready(const Unit&) const {}
    __device__ __forceinline__ void done(const Unit&) const {}
};

__device__ __forceinline__ unsigned cvt_pk_bf16(float lo, float hi) { unsigned r; asm volatile("v_cvt_pk_bf16_f32 %0, %1, %2" : "=v"(r) : "v"(lo), "v"(hi)); return r; }
__device__ __forceinline__ unsigned cvt_pk_f16(float lo, float hi) { typedef _Float16 h2 __attribute__((ext_vector_type(2))); h2 v; v.x = (_Float16)lo; v.y = (_Float16)hi; return __builtin_bit_cast(unsigned, v); }
__device__ __forceinline__ float bf_lo(unsigned w) { return __uint_as_float(w << 16); }
__device__ __forceinline__ float bf_hi(unsigned w) { return __uint_as_float(w & 0xffff0000u); }
__device__ __forceinline__ float sigmoid_f(float x) { return __builtin_amdgcn_rcpf(1.0f + __expf(-x)); }

struct EpiBf16Plain {
    static constexpr bool PERM = true, AFTER_DRAIN = false;
    size_t ws_off; int ldc;
    __device__ __forceinline__ void operator()(const f32x4 (&acc)[2][2][4][2], const Unit& u, int wr, int wc, int fr, int fq) const {
        const int row0 = u.pm * BM + wr * 64 + fr, col0 = u.pn * BM + wc * 32 + 8 * fq;
        bf16_t* O = (bf16_t*)(kargs()->ws + ws_off);
#pragma unroll
        for (int ai = 0; ai < 2; ++ai)
#pragma unroll
            for (int m = 0; m < 4; ++m) { bf16_t* rowp = O + (size_t)(row0 + ai * HALF + m * 16) * ldc + col0;
#pragma unroll
                for (int bj = 0; bj < 2; ++bj) { const f32x4 v0 = acc[ai][bj][m][0], v1 = acc[ai][bj][m][1];
                    u32x4 w; w.x = cvt_pk_bf16(v0[0], v0[1]); w.y = cvt_pk_bf16(v0[2], v0[3]); w.z = cvt_pk_bf16(v1[0], v1[1]); w.w = cvt_pk_bf16(v1[2], v1[3]);
                    *(u32x4*)(rowp + bj * HALF) = w; } }
    }
};

struct EpiZ {
    static constexpr bool PERM = true, AFTER_DRAIN = false;
    int l;
    template <int ACT> __device__ __forceinline__ void tile(const f32x4 (&acc)[2][2][4][2], bf16_t* base, int ldc, int row0, int col0, const float* lb) const {
        f32x4 lbv[2][2];
        if (ACT == 2) {
#pragma unroll
            for (int bj = 0; bj < 2; ++bj)
#pragma unroll
                for (int n = 0; n < 2; ++n) lbv[bj][n] = *(const f32x4*)(lb + col0 + bj * HALF + 4 * n);
        }
#pragma unroll
        for (int ai = 0; ai < 2; ++ai)
#pragma unroll
            for (int m = 0; m < 4; ++m) { bf16_t* rowp = base + (size_t)(row0 + ai * HALF + m * 16) * ldc + col0;
#pragma unroll
                for (int bj = 0; bj < 2; ++bj) { f32x4 v[2] = {acc[ai][bj][m][0], acc[ai][bj][m][1]};
                    u32x4 w;
                    if (ACT == 1) {
#pragma unroll
                        for (int n = 0; n < 2; ++n)
#pragma unroll
                            for (int e = 0; e < 4; ++e) v[n][e] = v[n][e] * sigmoid_f(v[n][e]);
                    }
                    if (ACT == 2) {
#pragma unroll
                        for (int n = 0; n < 2; ++n)
#pragma unroll
                            for (int e = 0; e < 4; ++e) { const float x = fminf(fmaxf(v[n][e], -30.f), 30.f), l = lbv[bj][n][e]; v[n][e] = __logf(l + (1.0f - l) * sigmoid_f(x)); }
                        w.x = cvt_pk_f16(v[0][0], v[0][1]); w.y = cvt_pk_f16(v[0][2], v[0][3]); w.z = cvt_pk_f16(v[1][0], v[1][1]); w.w = cvt_pk_f16(v[1][2], v[1][3]);
                    } else {
                        w.x = cvt_pk_bf16(v[0][0], v[0][1]); w.y = cvt_pk_bf16(v[0][2], v[0][3]); w.z = cvt_pk_bf16(v[1][0], v[1][1]); w.w = cvt_pk_bf16(v[1][2], v[1][3]);
                    }
                    *(u32x4*)(rowp + bj * HALF) = w; }
                if (ACT != 0) __builtin_amdgcn_sched_barrier(0); }
    }
    __device__ __forceinline__ void operator()(const f32x4 (&acc)[2][2][4][2], const Unit& u, int wr, int wc, int fr, int fq) const {
        const int seg = u.pn >> 2, row0 = u.pm * BM + wr * 64 + fr, col0 = (u.pn & 3) * BM + wc * 32 + 8 * fq;
        unsigned char* ws = kargs()->ws; const float* lb = (const float*)(ws + WS_LB) + l * 1024;
        const size_t off = seg == 0 ? WS_U : seg == 2 ? WS_Q : seg == 3 ? WS_LF : seg == 4 ? WS_V : seg == 1 ? WS_MIX : WS_MIX + 2048;
        const int ldc = (seg == 1 || seg == 5) ? 2048 : 1024;
        bf16_t* base = (bf16_t*)(ws + off);
        if (seg == 3) tile<2>(acc, base, ldc, row0, col0, lb);
        else if (seg == 1 || seg == 5) tile<1>(acc, base, ldc, row0, col0, lb);
        else tile<0>(acc, base, ldc, row0, col0, lb);
    }
};

struct EpiPool {
    static constexpr bool PERM = true, AFTER_DRAIN = false;
    int l;
    __device__ __forceinline__ void operator()(const f32x4 (&acc)[2][2][4][2], const Unit& u, int wr, int wc, int fr, int fq) const {
        const int row0 = u.pm * BM + wr * 64 + fr, col0 = u.pn * BM + wc * 32 + 8 * fq;
        const KArgs ka = kargs(); bf16_t* MIX = (bf16_t*)(ka->ws + WS_MIX); const float* pscale = ka->in[IN_PSCALE] + l * 1024;
        f32x4 sv[2][2];
#pragma unroll
        for (int bj = 0; bj < 2; ++bj)
#pragma unroll
            for (int n = 0; n < 2; ++n) sv[bj][n] = *(const f32x4*)(pscale + col0 + bj * HALF + 4 * n);
#pragma unroll
        for (int ai = 0; ai < 2; ++ai)
#pragma unroll
            for (int m = 0; m < 4; ++m) { bf16_t* rowp = MIX + (size_t)(row0 + ai * HALF + m * 16) * 2048 + col0;
#pragma unroll
                for (int bj = 0; bj < 2; ++bj) { const u32x4 gw = *(const u32x4*)(rowp + bj * HALF);
                    const f32x4 v0 = acc[ai][bj][m][0] * sv[bj][0], v1 = acc[ai][bj][m][1] * sv[bj][1];
                    u32x4 w; w.x = cvt_pk_bf16(v0[0] * bf_lo(gw.x), v0[1] * bf_hi(gw.x)); w.y = cvt_pk_bf16(v0[2] * bf_lo(gw.y), v0[3] * bf_hi(gw.y));
                    w.z = cvt_pk_bf16(v1[0] * bf_lo(gw.z), v1[1] * bf_hi(gw.z)); w.w = cvt_pk_bf16(v1[2] * bf_lo(gw.w), v1[3] * bf_hi(gw.w));
                    *(u32x4*)(rowp + bj * HALF) = w; }
                if (m & 1) asm volatile("" ::: "memory"); }
    }
};

template <class Epi, class Sched, bool ALIGN_EPI = false, bool SP2 = false>
__device__ __forceinline__ void gemm_phase(PG8_LAS unsigned char* lds, const Gemm g, const Sched& S, const Epi& E, const int tid_in) {
    int tid_ = tid_in; asm volatile("" : "+v"(tid_));
    const int tid = tid_, wid = __builtin_amdgcn_readfirstlane(tid >> 6), lane = tid & 63, wr = wid >> 2, wc = wid & 3, fr = lane & 15, fq = lane >> 4;
    const int K = g.K, nt = K / BK;
    unsigned voffA[2], voffB[2];
#pragma unroll
    for (int i = 0; i < 2; ++i) { int R, C; stage_rc(tid * 16 + i * 8192, R, C); const int Rb = Epi::PERM ? ((R & ~31) + perm32(R & 31)) : R;
        voffA[i] = (unsigned)(R * g.lda + C) * 2u; voffB[i] = (unsigned)(Rb * K + C) * 2u; }
    const size_t kstep = (size_t)(BK * 2);
    const size_t hstepA = (size_t)HALF * g.lda * 2, hstepB = (size_t)HALF * K * 2;
    const size_t tstepA = 2 * hstepA, tstepB = 2 * hstepB;
    const size_t acolB = (size_t)g.acol * 2;
    const unsigned ldsw = (unsigned)wid * 1024u;
    const int aoff = lds_byte(wr * 64 + fr, fq * 8), boff = lds_byte(wc * 32 + fr, fq * 8);
#define PG8_SA(b, h) (((b) * 2 + (h)) * HTB)
#define PG8_SB(b, h) ((4 + (b) * 2 + (h)) * HTB)
#define PG8_STAGE(bufoff, gbase, voff) do { _Pragma("unroll") for (int _i = 0; _i < 2; ++_i) \
        __builtin_amdgcn_global_load_lds((const unsigned*)((const char*)(gbase) + (voff)[_i]), (PG8_LAS unsigned*)(lds + (bufoff) + ldsw + _i * 8192), 16, 0, 0); } while (0)
#define PG8_LDA(dst, b, h) do { _Pragma("unroll") for (int m = 0; m < 4; ++m) _Pragma("unroll") for (int k = 0; k < 2; ++k) dst[m][k] = *(const PG8_LAS bf16x8*)(lds + PG8_SA(b, h) + aoff + m * 2048 + k * 1024); } while (0)
#define PG8_LDB(dst, b, h) do { _Pragma("unroll") for (int n = 0; n < 2; ++n) _Pragma("unroll") for (int k = 0; k < 2; ++k) dst[n][k] = *(const PG8_LAS bf16x8*)(lds + PG8_SB(b, h) + boff + n * 2048 + k * 1024); } while (0)
#define PG8_MMA(ai, bj, At, Bt) do { __builtin_amdgcn_s_setprio(1); _Pragma("unroll") for (int m = 0; m < 4; ++m) _Pragma("unroll") for (int n = 0; n < 2; ++n) _Pragma("unroll") for (int k = 0; k < 2; ++k) \
        acc[ai][bj][m][n] = __builtin_amdgcn_mfma_f32_16x16x32_bf16(Bt[n][k], At[m][k], acc[ai][bj][m][n], 0, 0, 0); __builtin_amdgcn_s_setprio(0); } while (0)
#define PG8_WAIT_V(n) asm volatile("s_waitcnt vmcnt(" #n ")" ::: "memory")
#define PG8_WAIT_L(n) asm volatile("s_waitcnt lgkmcnt(" #n ")" ::: "memory")
#define PG8_BAR __builtin_amdgcn_s_barrier()
#define PG8_SCHED __builtin_amdgcn_sched_barrier(0)
    Unit cur, nxt; int ui = 0;
    if (!S.next(0, cur)) return;
    f32x4 acc[2][2][4][2];
#pragma unroll
    for (int a = 0; a < 2; ++a)
#pragma unroll
        for (int b = 0; b < 2; ++b)
#pragma unroll
            for (int m = 0; m < 4; ++m)
#pragma unroll
                for (int n = 0; n < 2; ++n) acc[a][b][m][n] = (f32x4){0.f, 0.f, 0.f, 0.f};
    bf16x8 At[4][2], B0[2][2], B1[2][2];
    const char* cA = (const char*)g.A + (size_t)cur.pm * tstepA + (size_t)cur.pn * acolB; const char* cB = (const char*)g.Bt + (size_t)cur.pn * tstepB;
    S.a_ready(cur);
    if constexpr (SP2) {
        PG8_STAGE(PG8_SB(0, 0), cB, voffB); PG8_STAGE(PG8_SB(0, 1), cB + hstepB, voffB); PG8_STAGE(PG8_SA(0, 0), cA, voffA); PG8_STAGE(PG8_SA(0, 1), cA + hstepA, voffA);
        if (wr == 1) PG8_BAR;
        PG8_WAIT_V(2); PG8_BAR;
        PG8_STAGE(PG8_SB(1, 0), cB + kstep, voffB); PG8_STAGE(PG8_SA(1, 0), cA + kstep, voffA); PG8_STAGE(PG8_SB(1, 1), cB + hstepB + kstep, voffB);
        PG8_WAIT_V(6); PG8_BAR;
    } else {
        PG8_STAGE(PG8_SB(0, 0), cB, voffB); PG8_STAGE(PG8_SA(0, 0), cA, voffA); PG8_STAGE(PG8_SB(0, 1), cB + hstepB, voffB); PG8_STAGE(PG8_SA(0, 1), cA + hstepA, voffA);
        if (wr == 1) PG8_BAR;
        PG8_WAIT_V(4); PG8_BAR;
        PG8_STAGE(PG8_SB(1, 0), cB + kstep, voffB); PG8_STAGE(PG8_SA(1, 0), cA + kstep, voffA); PG8_STAGE(PG8_SB(1, 1), cB + hstepB + kstep, voffB);
        PG8_WAIT_V(6); PG8_BAR;
    }
    for (;;) {
        const bool has_next = S.next(ui + 1, nxt);
        const char* nA = has_next ? (const char*)g.A + (size_t)nxt.pm * tstepA + (size_t)nxt.pn * acolB : cA; const char* nB = has_next ? (const char*)g.Bt + (size_t)nxt.pn * tstepB : cB;
        for (int t = 0; t < nt; t += 2) {
            const bool last = (t == nt - 2);
            const char* a1 = cA + (size_t)(t + 1) * kstep;
            const char* a2 = last ? nA : cA + (size_t)(t + 2) * kstep; const char* b2 = last ? nB : cB + (size_t)(t + 2) * kstep;
            const char* a3 = a2 + kstep; const char* b3 = b2 + kstep;
            if (last && has_next) S.a_ready(nxt);
            if constexpr (SP2) {
            PG8_LDB(B0, 0, 0); PG8_LDB(B1, 0, 1); PG8_SCHED; PG8_LDA(At, 0, 0); PG8_STAGE(PG8_SA(1, 1), a1 + hstepA, voffA);
            PG8_WAIT_V(8); PG8_WAIT_L(0); PG8_BAR; PG8_MMA(0, 0, At, B0); PG8_MMA(0, 1, At, B1); PG8_BAR; PG8_SCHED;
            PG8_LDA(At, 0, 1); PG8_STAGE(PG8_SB(0, 0), b2, voffB); PG8_STAGE(PG8_SB(0, 1), b2 + hstepB, voffB); PG8_STAGE(PG8_SA(0, 0), a2, voffA);
            PG8_WAIT_V(8); PG8_WAIT_L(0); PG8_BAR; PG8_MMA(1, 0, At, B0); PG8_MMA(1, 1, At, B1); PG8_BAR; PG8_SCHED;
            PG8_LDB(B0, 1, 0); PG8_LDB(B1, 1, 1); PG8_SCHED; PG8_LDA(At, 1, 0); PG8_STAGE(PG8_SA(0, 1), a2 + hstepA, voffA);
            PG8_WAIT_V(8); PG8_WAIT_L(0); PG8_BAR; PG8_MMA(0, 0, At, B0); PG8_MMA(0, 1, At, B1); PG8_BAR; PG8_SCHED;
            PG8_LDA(At, 1, 1); PG8_STAGE(PG8_SB(1, 0), b3, voffB); PG8_STAGE(PG8_SB(1, 1), b3 + hstepB, voffB); PG8_STAGE(PG8_SA(1, 0), a3, voffA);
            PG8_WAIT_V(8); PG8_WAIT_L(0); PG8_BAR; PG8_MMA(1, 0, At, B0); PG8_MMA(1, 1, At, B1); PG8_BAR; PG8_SCHED;
            } else {
            PG8_LDB(B0, 0, 0); PG8_SCHED; PG8_LDA(At, 0, 0); PG8_STAGE(PG8_SA(1, 1), a1 + hstepA, voffA);
            PG8_WAIT_L(8); PG8_BAR; PG8_WAIT_L(0); PG8_MMA(0, 0, At, B0); PG8_BAR; PG8_SCHED;
            PG8_LDB(B1, 0, 1); PG8_STAGE(PG8_SB(0, 0), b2, voffB);
            PG8_BAR; PG8_WAIT_L(0); PG8_MMA(0, 1, At, B1); PG8_BAR;
            PG8_LDA(At, 0, 1); PG8_STAGE(PG8_SA(0, 0), a2, voffA);
            PG8_BAR; PG8_WAIT_L(0); PG8_MMA(1, 0, At, B0); PG8_BAR; PG8_SCHED;
            PG8_STAGE(PG8_SB(0, 1), b2 + hstepB, voffB);
            PG8_WAIT_V(6); PG8_BAR; PG8_MMA(1, 1, At, B1); PG8_BAR;
            PG8_LDB(B0, 1, 0); PG8_SCHED; PG8_LDA(At, 1, 0); PG8_STAGE(PG8_SA(0, 1), a2 + hstepA, voffA);
            PG8_WAIT_L(8); PG8_BAR; PG8_WAIT_L(0); PG8_MMA(0, 0, At, B0); PG8_BAR; PG8_SCHED;
            PG8_LDB(B1, 1, 1); PG8_STAGE(PG8_SB(1, 0), b3, voffB);
            PG8_BAR; PG8_WAIT_L(0); PG8_MMA(0, 1, At, B1); PG8_BAR;
            PG8_LDA(At, 1, 1); PG8_STAGE(PG8_SA(1, 0), a3, voffA);
            PG8_BAR; PG8_WAIT_L(0); PG8_MMA(1, 0, At, B0); PG8_BAR; PG8_SCHED;
            PG8_STAGE(PG8_SB(1, 1), b3 + hstepB, voffB);
            PG8_WAIT_V(6); PG8_BAR; PG8_MMA(1, 1, At, B1); PG8_BAR;
            }
        }
        if constexpr (ALIGN_EPI) { if (wr == 0) PG8_BAR; }
        if constexpr (!Epi::AFTER_DRAIN) { E(acc, cur, wr, wc, fr, fq); S.done(cur); }
        if (!has_next) break;
#pragma unroll
        for (int a = 0; a < 2; ++a)
#pragma unroll
            for (int b = 0; b < 2; ++b)
#pragma unroll
                for (int m = 0; m < 4; ++m)
#pragma unroll
                    for (int n = 0; n < 2; ++n) acc[a][b][m][n] = (f32x4){0.f, 0.f, 0.f, 0.f};
        cur = nxt; cA = nA; cB = nB; ++ui;
        if constexpr (ALIGN_EPI) { if (wr == 1) PG8_BAR; }
    }
    PG8_WAIT_V(0);
    if constexpr (!ALIGN_EPI) { if (wr == 0) PG8_BAR; }
    PG8_BAR;
    if constexpr (Epi::AFTER_DRAIN) { E.fused(acc, cur, wr, wc, fr, fq, lds, wid, lane); S.done(cur); }
#undef PG8_SA
#undef PG8_SB
#undef PG8_STAGE
#undef PG8_LDA
#undef PG8_LDB
#undef PG8_MMA
#undef PG8_WAIT_V
#undef PG8_WAIT_L
#undef PG8_BAR
#undef PG8_SCHED
}
}

#define PG8_SP2 true
#define PG8_ALIGN true

constexpr int RING_OFF = 0, RING_BYTES = 131072;
constexpr int LDSCTL_OFF = RING_BYTES, MISC_OFF = LDSCTL_OFF + 320;
constexpr int LDS_BYTES = 147456;

#define GAS __attribute__((address_space(1)))
#define LAS __attribute__((address_space(3)))
typedef unsigned short bf16;
typedef unsigned v4u __attribute__((ext_vector_type(4)));
typedef unsigned v2u __attribute__((ext_vector_type(2)));
typedef float f32x4 __attribute__((ext_vector_type(4)));
typedef short bf16x8 __attribute__((ext_vector_type(8)));
typedef GAS unsigned gu32;
typedef GAS unsigned long long gu64;
#define RLX_AGENT __ATOMIC_RELAXED, __HIP_MEMORY_SCOPE_AGENT
#define LDS_WAIT() asm volatile("s_waitcnt lgkmcnt(0)" ::: "memory")
#define VM_WAIT() asm volatile("s_waitcnt vmcnt(0)" ::: "memory")
__device__ __forceinline__ unsigned f2bf(float f) { unsigned u = __builtin_bit_cast(unsigned, f); return (u + 0x7fffu + ((u >> 16) & 1u)) >> 16; }
__device__ __forceinline__ unsigned pk2(float lo, float hi) { return f2bf(lo) | (f2bf(hi) << 16); }
__device__ __forceinline__ float bflo(unsigned w) { return __uint_as_float(w << 16); }
__device__ __forceinline__ float bfhi(unsigned w) { return __uint_as_float(w & 0xffff0000u); }
__device__ __forceinline__ float h2f_lo(unsigned w) { typedef _Float16 h2 __attribute__((ext_vector_type(2))); return (float)__builtin_bit_cast(h2, w).x; }
__device__ __forceinline__ float h2f_hi(unsigned w) { typedef _Float16 h2 __attribute__((ext_vector_type(2))); return (float)__builtin_bit_cast(h2, w).y; }

#define XB_TMO      128
#define XB_XCNT(j)  (256  + 64 * (j))
#define XB_XSUB(j)  (1280 + 64 * (j))
#define XB_XGEN(j)  (2304 + 64 * (j))
#define XB_TOP      3328
#define XB_TOPGEN   3392
#define XCD_BAR_WORDS 3456
#define XB_SPIN_CAP (1u << 18)

__device__ __forceinline__ unsigned xb_ld(unsigned* p)              { return __hip_atomic_load(p, __ATOMIC_RELAXED, __HIP_MEMORY_SCOPE_AGENT); }
__device__ __forceinline__ unsigned xb_add(unsigned* p, unsigned v) { return __hip_atomic_fetch_add(p, v, __ATOMIC_RELAXED, __HIP_MEMORY_SCOPE_AGENT); }
__device__ __forceinline__ unsigned xb_xcc_id() { return (unsigned)__builtin_amdgcn_s_getreg((3 << 11) | 20) & 0xFu; }
#define XB_SPIN(cond, bar) do { unsigned _sp = 0; while (cond) { __builtin_amdgcn_s_sleep(1); \
    if ((++_sp & 255u) == 0u) { if (xb_ld(&(bar)[XB_TMO])) break; if (_sp > XB_SPIN_CAP) { atomicAdd(&(bar)[XB_TMO], 1u); break; } } } } while (0)

__device__ __forceinline__ int lane_now() { int l; asm volatile("v_mbcnt_lo_u32_b32 %0, -1, 0\n\tv_mbcnt_hi_u32_b32 %0, -1, %0" : "=v"(l)); return l; }
struct XcdBarrier { unsigned* bar; unsigned x; volatile LAS unsigned* st; int wave0; };

__device__ __forceinline__ XcdBarrier xcd_barrier_post(unsigned* bar, volatile LAS unsigned* st) {
    XcdBarrier b; b.bar = bar; b.x = xb_xcc_id(); b.st = st; b.wave0 = __builtin_amdgcn_readfirstlane(threadIdx.x >> 6);
    if (threadIdx.x == 0) (void)xb_add(&bar[XB_XCNT(b.x)], 1u);
    return b;
}
__device__ __forceinline__ void xcd_barrier_complete(unsigned* bar, unsigned x, unsigned& nloc, unsigned& nx) {
    const unsigned G = gridDim.x * gridDim.y * gridDim.z;
    unsigned sum, cnt, mine, sp = 0u;
    for (;;) {
        sum = 0u; cnt = 0u; mine = 0u;
#pragma unroll
        for (unsigned j = 0; j < 16; ++j) { const unsigned c = xb_ld(&bar[XB_XCNT(j)]); sum += c; cnt += (c > 0u) ? 1u : 0u; mine = (j == x) ? c : mine; }
        if (sum == G) break;
        __builtin_amdgcn_s_sleep(1);
        if ((++sp & 255u) == 0u) { if (xb_ld(&bar[XB_TMO])) break; if (sp > XB_SPIN_CAP) { atomicAdd(&bar[XB_TMO], 1u); break; } }
    }
    nloc = mine > 0u ? mine : 1u; nx = cnt > 0u ? cnt : 1u;
}
__device__ __forceinline__ void xcd_barrier_census(const XcdBarrier& b) {
    if (b.wave0 == 0 && lane_now() == 0) { unsigned nloc, nx; xcd_barrier_complete(b.bar, b.x, nloc, nx); b.st[0] = nloc; b.st[1] = nx; }
}
__device__ __forceinline__ void xcd_barrier(const XcdBarrier& b) {
    asm volatile("s_waitcnt vmcnt(0)" ::: "memory");
    __syncthreads();
    if (b.wave0 == 0 && lane_now() == 0) {
        unsigned* bar = b.bar;
        __builtin_amdgcn_s_waitcnt(0);
        const unsigned nloc = b.st[0], nx = b.st[1];
        const unsigned old = xb_add(&bar[XB_XSUB(b.x)], 1u);
        const unsigned gen = old / nloc;
        if (old + 1u == (gen + 1u) * nloc) {
            __builtin_amdgcn_fence(__ATOMIC_RELEASE, "agent");
            asm volatile("s_waitcnt vmcnt(0)" ::: "memory");
            const unsigned og = xb_add(&bar[XB_TOP], 1u);
            const unsigned tg = og / nx;
            if (og + 1u == (tg + 1u) * nx) xb_add(&bar[XB_TOPGEN], 1u);
            else XB_SPIN(xb_ld(&bar[XB_TOPGEN]) == tg, bar);
            __builtin_amdgcn_fence(__ATOMIC_ACQUIRE, "agent");
            xb_add(&bar[XB_XGEN(b.x)], 1u);
            asm volatile("s_waitcnt vmcnt(0)" ::: "memory");
        } else {
            XB_SPIN(xb_ld(&bar[XB_XGEN(b.x)]) == gen, bar);
            __builtin_amdgcn_fence(__ATOMIC_ACQUIRE, "agent");
            asm volatile("s_waitcnt vmcnt(0)" ::: "memory");
        }
    }
    __syncthreads();
}

struct Frame {
    LAS unsigned char* lds;
    volatile LAS unsigned* MISC;
    gu32* ctl;
    int tid, lane, wave, wave0;
    int G, bid;
};
#define REFRESH_IDS(F) do { int w_ = (F).wave0; asm volatile("" : "+s"(w_)); int l_ = lane_now(); asm volatile("" : "+v"(l_)); (F).wave = w_; (F).lane = l_; (F).tid = w_ * 64 + l_; \
    int b_ = blockIdx.x, g_ = gridDim.x; asm volatile("" : "+s"(b_), "+s"(g_)); (F).bid = b_; (F).G = g_; } while (0)

__device__ __forceinline__ float shfl_x(float v, int o, int lane) { return __int_as_float(__builtin_amdgcn_ds_bpermute((lane ^ o) << 2, __float_as_int(v))); }
__device__ __forceinline__ float wave_sum(float v, int lane) {
#pragma unroll
    for (int o = 1; o < 64; o <<= 1) v += shfl_x(v, o, lane);
    return v;
}
__device__ __forceinline__ void p0_transpose_item(const float* W, int K, int N, bf16* WT, LAS float* scr, int item, int lane) {
    const int nblk = N / 32, kb = item / nblk, nb = item % nblk, k0 = 64 * kb, n0 = 32 * nb;
#pragma unroll 8
    for (int i = 0; i < 32; ++i) { const int kk = 2 * i + (lane >> 5); scr[kk * 33 + (lane & 31)] = W[(size_t)(k0 + kk) * N + n0 + (lane & 31)]; }
    LDS_WAIT(); asm volatile("" ::: "memory");
    const int c = lane & 7;
#pragma unroll
    for (int j = 0; j < 4; ++j) { const int n = (lane >> 3) + 8 * j; const LAS float* s = scr + (8 * c) * 33 + n;
        v4u o; o.x = pk2(s[0 * 33], s[1 * 33]); o.y = pk2(s[2 * 33], s[3 * 33]); o.z = pk2(s[4 * 33], s[5 * 33]); o.w = pk2(s[6 * 33], s[7 * 33]);
        *(GAS v4u*)(WT + (size_t)(n0 + n) * K + k0 + 8 * c) = o; }
    LDS_WAIT(); asm volatile("" ::: "memory");
}

__device__ __forceinline__ void p0_prologue(Frame& F) {
    REFRESH_IDS(F);
    const KArgs ka = kargs(); const float* P_hlb = ka->in[IN_HLB]; float* P_lb = (float*)(ka->ws + WS_LB); const float* P_adaw = ka->in[IN_ADAW]; const float* P_adab = ka->in[IN_ADAB]; const float* P_c = ka->in[IN_C]; float* P_mod = (float*)(ka->ws + WS_MOD);
    const int gw = F.bid * NWAVES + F.wave, NGW = F.G * NWAVES;
    if (F.bid == 0) for (int j = F.tid; j < 1024; j += NWAVES * 64) { const float a0 = P_hlb[j], a1 = P_hlb[1024 + j]; P_lb[j] = 0.f; P_lb[1024 + j] = 1.0f / (1.0f + __expf(a0 - a1)); }
    constexpr int AITEMS = DEPTH * (3 * D / 8);
    for (int it = gw; it < AITEMS; it += NGW) {
        const int l = it / (3 * D / 8), n0 = (it % (3 * D / 8)) * 8;
        float acc[16][8];
#pragma unroll
        for (int b = 0; b < 16; ++b)
#pragma unroll
            for (int j = 0; j < 8; ++j) acc[b][j] = 0.f;
        for (int i = 0; i < 16; ++i) {
            const int k = F.lane + 64 * i;
            const float* wp = P_adaw + ((size_t)l * D + k) * (3 * D) + n0;
            const f32x4 w0 = *(const f32x4*)wp, w1 = *(const f32x4*)(wp + 4);
#pragma unroll
            for (int b = 0; b < 16; ++b) { const float cv = P_c[b * D + k], s = cv * __builtin_amdgcn_rcpf(1.0f + __expf(-cv));
#pragma unroll
                for (int j = 0; j < 4; ++j) { acc[b][j] += s * w0[j]; acc[b][4 + j] += s * w1[j]; } }
        }
        float* av = &acc[0][0];
#define TR_STEP(N, OFF) _Pragma("unroll") for (int i = 0; i < (N) / 2; ++i) { const bool up = (F.lane & (OFF)) != 0; const float keep = up ? av[i + (N) / 2] : av[i], send = up ? av[i] : av[i + (N) / 2]; av[i] = keep + shfl_x(send, (OFF), F.lane); }
        TR_STEP(128, 32) TR_STEP(64, 16) TR_STEP(32, 8) TR_STEP(16, 4) TR_STEP(8, 2) TR_STEP(4, 1)
#undef TR_STEP
        { const int b = F.lane >> 2, j = (F.lane & 3) * 2; const float* bp = P_adab + l * 3 * D + n0 + j;
          float* mp = P_mod + ((size_t)l * BATCH + b) * (3 * D) + n0 + j; mp[0] = av[0] + bp[0]; mp[1] = av[1] + bp[1]; }
    }
}

__device__ __forceinline__ void p1_fold_tile(Frame& F, const float* w_in, const float* pool_w, bf16* WIN, const int tile) {
    const int nb = tile & 1, kb = (tile >> 1) & 15, g = (tile >> 5) & 3, l = tile >> 7;
    LAS float* As = (LAS float*)(F.lds + RING_OFF);
    LAS float* Bs = As + 64 * 132;
    const int ty = F.tid >> 5, tx = F.tid & 31;
    float acc[4][4];
#pragma unroll
    for (int i = 0; i < 4; ++i)
#pragma unroll
        for (int j = 0; j < 4; ++j) acc[i][j] = 0.f;
    const float* Ag = w_in + ((size_t)l * D + kb * 64) * NZ + g * 256;
    const float* Bg = pool_w + ((size_t)(l * 4 + g) * 256) * 256 + nb * 128;
    for (int ch = 0; ch < 2; ++ch) {
        { const int r = F.tid >> 3, c4 = (F.tid & 7) * 16;
#pragma unroll
          for (int j = 0; j < 4; ++j) *(LAS f32x4*)(As + r * 132 + c4 + 4 * j) = *(const GAS f32x4*)(Ag + (size_t)r * NZ + ch * 128 + c4 + 4 * j); }
        { const int r = F.tid >> 2, c4 = (F.tid & 3) * 32;
#pragma unroll
          for (int j = 0; j < 8; ++j) *(LAS f32x4*)(Bs + r * 128 + c4 + 4 * j) = *(const GAS f32x4*)(Bg + (size_t)(ch * 128 + r) * 256 + c4 + 4 * j); }
        __syncthreads();
#pragma unroll 4
        for (int c = 0; c < 128; c += 4) {
            f32x4 a[4], bq[4];
#pragma unroll
            for (int i = 0; i < 4; ++i) a[i] = *(const LAS f32x4*)(As + (4 * ty + i) * 132 + c);
#pragma unroll
            for (int q = 0; q < 4; ++q) bq[q] = *(const LAS f32x4*)(Bs + (c + q) * 128 + 4 * tx);
#pragma unroll
            for (int i = 0; i < 4; ++i)
#pragma unroll
                for (int q = 0; q < 4; ++q)
#pragma unroll
                    for (int j = 0; j < 4; ++j) acc[i][j] += a[i][q] * bq[q][j];
        }
        __syncthreads();
    }
#pragma unroll
    for (int j = 0; j < 4; ++j) { v2u o; o.x = pk2(acc[0][j], acc[1][j]); o.y = pk2(acc[2][j], acc[3][j]);
        *(GAS v2u*)(WIN + ((size_t)l * NZ + g * 256 + nb * 128 + 4 * tx + j) * D + kb * 64 + 4 * ty) = o; }
}
__device__ __forceinline__ void p1_weights(Frame& F) {
    REFRESH_IDS(F);
    const KArgs ka = kargs(); const float* P_win = ka->in[IN_WIN]; const float* P_wout = ka->in[IN_WOUT]; const float* P_poolw = ka->in[IN_POOLW]; bf16* P_WIN = (bf16*)(ka->ws + WS_WIN); bf16* P_WOUT = (bf16*)(ka->ws + WS_WOUT);
    for (int tile = F.bid; tile < DEPTH * 4 * 16 * 2; tile += F.G) p1_fold_tile(F, P_win, P_poolw, P_WIN, tile);
    LAS float* scr = (LAS float*)(F.lds + RING_OFF + F.wave * 16384);
    const int gw = F.bid * NWAVES + F.wave, NGW = F.G * NWAVES;
    constexpr int NB_IN = (NZ - D) / 32;
    constexpr int I_IN = (D / 64) * NB_IN, I_OUT = (MIXW / 64) * (D / 32);
    constexpr int NITEMS = DEPTH * (I_IN + I_OUT);
    for (int it = gw; it < NITEMS; it += NGW) {
        int r = it;
        if (r < DEPTH * I_IN) { const int l = r / I_IN, q = r % I_IN, kb = q / NB_IN, nb = q % NB_IN + D / 32;
            p0_transpose_item(P_win + (size_t)l * D * NZ, D, NZ, P_WIN + (size_t)l * NZ * D, scr, kb * (NZ / 32) + nb, F.lane); continue; } r -= DEPTH * I_IN;
        { const int l = r / I_OUT; p0_transpose_item(P_wout + (size_t)l * MIXW * D, MIXW, D, P_WOUT + (size_t)l * D * MIXW, scr, r % I_OUT, F.lane); }
    }
}

__device__ __forceinline__ void rowpass(Frame& F, int l) {
    REFRESH_IDS(F);
    const KArgs ka = kargs(); const float* P_x = ka->in[IN_X]; float* P_out = ka->out; bf16* P_Y = (bf16*)(ka->ws + WS_Y); float* P_mod = (float*)(ka->ws + WS_MOD); const float* P_npost = ka->in[IN_NPOST]; const float* P_npre = ka->in[IN_NPRE]; bf16* P_XN = (bf16*)(ka->ws + WS_XN);
    const int gw = F.bid * NWAVES + F.wave, NGW = F.G * NWAVES;
    const int ln = l + 1;
    for (int m = gw; m < M; m += NGW) {
        const int b = m / SEQ;
        f32x4 v[4];
        const float* xin = (l <= 0 ? P_x : (const float*)P_out) + (size_t)m * D;
#pragma unroll
        for (int j = 0; j < 4; ++j) v[j] = *((const GAS f32x4*)xin + F.lane + 64 * j);
        if (l >= 0) {
            const GAS v2u* yr = (const GAS v2u*)(P_Y + (size_t)m * D) + F.lane;
            f32x4 y[4]; float ss = 0.f;
#pragma unroll
            for (int j = 0; j < 4; ++j) { const v2u w = yr[64 * j]; y[j] = (f32x4){bflo(w.x), bfhi(w.x), bflo(w.y), bfhi(w.y)}; ss += (y[j].x * y[j].x + y[j].y * y[j].y) + (y[j].z * y[j].z + y[j].w * y[j].w); }
            const float r = __builtin_amdgcn_rsqf(wave_sum(ss, F.lane) * (1.f / D) + EPS);
            const float* gate = P_mod + ((size_t)l * BATCH + b) * (3 * D) + 2 * D;
            const float* wp = P_npost + l * D;
#pragma unroll
            for (int j = 0; j < 4; ++j) { const f32x4 g = *((const f32x4*)gate + F.lane + 64 * j), w = *((const f32x4*)wp + F.lane + 64 * j); v[j] = v[j] + g * (y[j] * r * w);
                *((GAS f32x4*)(P_out + (size_t)m * D) + F.lane + 64 * j) = v[j]; }
        }
        if (ln < DEPTH) {
            float ss = 0.f;
#pragma unroll
            for (int j = 0; j < 4; ++j) ss += (v[j].x * v[j].x + v[j].y * v[j].y) + (v[j].z * v[j].z + v[j].w * v[j].w);
            const float r = __builtin_amdgcn_rsqf(wave_sum(ss, F.lane) * (1.f / D) + EPS);
            const float* shift = P_mod + ((size_t)ln * BATCH + b) * (3 * D); const float* scale = shift + D; const float* wp = P_npre + ln * D;
            GAS v2u* o = (GAS v2u*)(P_XN + (size_t)m * D) + F.lane;
#pragma unroll
            for (int j = 0; j < 4; ++j) { const f32x4 sh = *((const f32x4*)shift + F.lane + 64 * j), sc = *((const f32x4*)scale + F.lane + 64 * j), w = *((const f32x4*)wp + F.lane + 64 * j);
                const f32x4 h = v[j] * r * w * (sc + 1.0f) + sh; v2u pw; pw.x = pk2(h.x, h.y); pw.y = pk2(h.z, h.w); o[64 * j] = pw; }
        }
    }
}

__device__ __forceinline__ void pool_pass(Frame& F, const int l, const int first, const int count) {
    const KArgs ka = kargs(); const bf16* U = (const bf16*)(ka->ws + WS_U); bf16* MIXp = (bf16*)(ka->ws + WS_MIX); const float* ps = ka->in[IN_PSCALE] + l * 1024;
    constexpr int RUN = 64;
    const int c8 = (F.tid & 127) * 8, w = 2 << (c8 >> 8);
    f32x4 sc0 = *(const f32x4*)(ps + c8), sc1 = *(const f32x4*)(ps + c8 + 4);
    for (int it = first; it < M / RUN / 4; it += count) {
        const int t0 = (it * 4 + (F.tid >> 7)) * RUN, tp0 = t0 & (SEQ - 1);
        const GAS v4u* up = (const GAS v4u*)(U + (size_t)t0 * D + c8);
        GAS v4u* gp = (GAS v4u*)(MIXp + (size_t)t0 * MIXW + c8);
        float s[8];
#pragma unroll
        for (int e = 0; e < 8; ++e) s[e] = 0.f;
        for (int i = 1; i <= 16; ++i) if (i <= w && tp0 - i >= 0) { const v4u x = up[-(long)i * (D / 8)];
            s[0] += bflo(x.x); s[1] += bfhi(x.x); s[2] += bflo(x.y); s[3] += bfhi(x.y); s[4] += bflo(x.z); s[5] += bfhi(x.z); s[6] += bflo(x.w); s[7] += bfhi(x.w); }
#pragma unroll 8
        for (int r = 0; r < RUN; ++r) {
            const int tp = tp0 + r; const bool sub = tp >= w;
            const v4u x = up[(long)r * (D / 8)], gq = gp[(long)r * (MIXW / 8)];
            v4u y = (v4u){0u, 0u, 0u, 0u}; if (sub) y = up[(long)(r - w) * (D / 8)];
            const float xv[8] = {bflo(x.x), bfhi(x.x), bflo(x.y), bfhi(x.y), bflo(x.z), bfhi(x.z), bflo(x.w), bfhi(x.w)};
            const float yv[8] = {bflo(y.x), bfhi(y.x), bflo(y.y), bfhi(y.y), bflo(y.z), bfhi(y.z), bflo(y.w), bfhi(y.w)};
            const float gv[8] = {bflo(gq.x), bfhi(gq.x), bflo(gq.y), bfhi(gq.y), bflo(gq.z), bfhi(gq.z), bflo(gq.w), bfhi(gq.w)};
            const float inv = 1.0f / (float)(tp + 1 < w ? tp + 1 : w);
            float o[8];
#pragma unroll
            for (int e = 0; e < 8; ++e) { s[e] += xv[e] - yv[e]; o[e] = (s[e] * inv - xv[e]) * (e < 4 ? sc0[e] : sc1[e - 4]) * gv[e]; }
            v4u ov; ov.x = pk2(o[0], o[1]); ov.y = pk2(o[2], o[3]); ov.z = pk2(o[4], o[5]); ov.w = pk2(o[6], o[7]);
            gp[(long)r * (MIXW / 8)] = ov;
        }
    }
}

__device__ __forceinline__ void hgrn_naive(Frame& F, int l) {
    REFRESH_IDS(F);
    const KArgs ka = kargs(); const float* P_hnw = ka->in[IN_HNW]; bf16* P_Q = (bf16*)(ka->ws + WS_Q); bf16* P_LF = (bf16*)(ka->ws + WS_LF); bf16* P_V = (bf16*)(ka->ws + WS_V); bf16* P_MIX = (bf16*)(ka->ws + WS_MIX);
    LAS float* qs = (LAS float*)(F.lds + RING_OFF);
    LAS float* fs = qs + 2048; LAS float* ks = fs + 2048; LAS float* vs = ks + 2048;
    LAS float* part = vs + 2048;
    const int v = F.tid & 127, kg = F.tid >> 7;
    const float* nw = P_hnw + l * HD;
    for (int unit = F.bid; unit < BATCH * NHEAD; unit += F.G) {
        const int b = unit / NHEAD, h = unit % NHEAD;
        float S[32];
#pragma unroll
        for (int i = 0; i < 32; ++i) S[i] = 0.f;
        const size_t rb = (size_t)b * SEQ;
        for (int t0 = 0; t0 < SEQ; t0 += 16) {
            { const int tt = F.tid >> 5, ch = (F.tid & 31) * 4; const size_t off = (rb + t0 + tt) * D + h * HD + ch;
              const v2u qw = *(const GAS v2u*)(P_Q + off), lw = *(const GAS v2u*)(P_LF + off), vw = *(const GAS v2u*)(P_V + off);
              const float lf[4] = {h2f_lo(lw.x), h2f_hi(lw.x), h2f_lo(lw.y), h2f_hi(lw.y)};
              const float qq[4] = {bflo(qw.x), bfhi(qw.x), bflo(qw.y), bfhi(qw.y)}, vv[4] = {bflo(vw.x), bfhi(vw.x), bflo(vw.y), bfhi(vw.y)};
#pragma unroll
              for (int e = 0; e < 4; ++e) { const float f = __expf(lf[e]); fs[tt * 128 + ch + e] = f; ks[tt * 128 + ch + e] = 1.0f - f; qs[tt * 128 + ch + e] = qq[e]; vs[tt * 128 + ch + e] = vv[e]; } }
            __syncthreads();
            for (int tt = 0; tt < 16; ++tt) {
                const float vv = vs[tt * 128 + v]; float po = 0.f;
#pragma unroll
                for (int i = 0; i < 32; ++i) { const float f = fs[tt * 128 + kg * 32 + i], k = ks[tt * 128 + kg * 32 + i], q = qs[tt * 128 + kg * 32 + i]; S[i] = f * S[i] + k * vv; po += q * S[i]; }
                part[(tt * 4 + kg) * 128 + v] = po;
            }
            __syncthreads();
#pragma unroll
            for (int e = 0; e < 2; ++e) { const int tt = F.wave * 2 + e;
                float o0 = 0.f, o1 = 0.f;
#pragma unroll
                for (int k4 = 0; k4 < 4; ++k4) { o0 += part[(tt * 4 + k4) * 128 + F.lane]; o1 += part[(tt * 4 + k4) * 128 + 64 + F.lane]; }
                const float r = __builtin_amdgcn_rsqf(wave_sum(o0 * o0 + o1 * o1, F.lane) * (1.f / HD) + EPS);
                GAS bf16* gp = (GAS bf16*)(P_MIX + (rb + t0 + tt) * MIXW + D + h * HD);
                const float g0 = __uint_as_float((unsigned)gp[F.lane] << 16), g1 = __uint_as_float((unsigned)gp[64 + F.lane] << 16);
                gp[F.lane] = (bf16)f2bf(o0 * r * nw[F.lane] * g0); gp[64 + F.lane] = (bf16)f2bf(o1 * r * nw[64 + F.lane] * g1); }
        }
        __syncthreads();
    }
}

namespace hg {
typedef short bf16x8 __attribute__((ext_vector_type(8)));
typedef short s16x4 __attribute__((ext_vector_type(4)));
typedef float f32x4 __attribute__((ext_vector_type(4)));
typedef float f32x2 __attribute__((ext_vector_type(2)));
typedef unsigned u32x2 __attribute__((ext_vector_type(2)));
typedef unsigned u32x4 __attribute__((ext_vector_type(4)));
typedef __bf16 bf16x2_t __attribute__((ext_vector_type(2)));
constexpr int L_QT = 0, L_QB = 16384, L_K1 = 24576, L_K2 = 32768, L_KH = 49152  , L_V = 67584  , L_P = 86016  ,
              L_DEC = 92160  , L_TOT = 92672  , L_SSQ = 96768  , L_RS = 98816  , L_END = 100864;
constexpr int VSTR = 288;
__device__ __forceinline__ unsigned cvtpk(float lo, float hi) { f32x2 v = {lo, hi}; bf16x2_t b = __builtin_convertvector(v, bf16x2_t); return __builtin_bit_cast(unsigned, b); }
__device__ __forceinline__ int perm32x(int x) { return 8 * ((x >> 2) & 3) + 4 * (x >> 4) + (x & 3); }
__device__ __forceinline__ bf16x8 ld128(const LAS unsigned char* p) { return *(const LAS bf16x8*)p; }
__device__ __forceinline__ s16x4 ldtr(const LAS unsigned char* p) { typedef short v4i16_t __attribute__((ext_vector_type(4))); return __builtin_bit_cast(s16x4, __builtin_amdgcn_ds_read_tr16_b64_v4i16((LAS v4i16_t*)p)); }
__device__ __forceinline__ bf16x8 cat(s16x4 a, s16x4 b) { return (bf16x8){a[0], a[1], a[2], a[3], b[0], b[1], b[2], b[3]}; }
#define HG_DPP(v, ctrl) __int_as_float(__builtin_amdgcn_update_dpp(0, __float_as_int(v), (ctrl), 0xf, 0xf, true))
__device__ __forceinline__ float row16_sum(float v) {
    v += HG_DPP(v, 0xB1); v += HG_DPP(v, 0x4E); v += HG_DPP(v, 0x141); v += HG_DPP(v, 0x140); return v;
}
#ifdef PROBE_SEG
#define HG_SEG(k) do { if (probe) { const unsigned long long now_ = __builtin_amdgcn_s_memrealtime(); volatile LAS unsigned long long* pa_ = (volatile LAS unsigned long long*)(lds + 131072 + 2048); pa_[k] += now_ - pa_[15]; pa_[15] = now_; } } while (0)
#else
#define HG_SEG(k) do { } while (0)
#endif
#define HG_LBAR() do { asm volatile("s_waitcnt lgkmcnt(0)" ::: "memory"); __builtin_amdgcn_s_barrier(); asm volatile("" ::: "memory"); } while (0)

__device__ __forceinline__ void hgrn_unit(LAS unsigned char* lds, const int tid, const int lane, const int wave, const int b, const int h,
                                          const bf16* Qg, const bf16* LFg, const bf16* Vg, bf16* MIXg, const float* nw) {
    const int c16 = lane & 15, g = lane >> 4, cp = lane, tg = wave;
    const int c0 = 2 * cp, pcl = perm32x(c0 & 31), pcg = c0 >> 5;
    const size_t rowbase = (size_t)b * SEQ;
    const GAS unsigned* Qp = (const GAS unsigned*)(Qg + rowbase * D + h * HD) + cp + (size_t)(8 * tg) * (D / 2);
    const GAS unsigned* Lp = (const GAS unsigned*)(LFg + rowbase * D + h * HD) + cp + (size_t)(8 * tg) * (D / 2);
    const GAS u32x4* Vp = (const GAS u32x4*)(Vg + (rowbase + (tid >> 3)) * D + h * HD + (tid & 7) * 16);
    GAS bf16* Gp = (GAS bf16*)(MIXg + (rowbase + 4 * g) * MIXW + D + h * HD + 16 * wave + c16);
    const float nwv = nw[16 * wave + c16];
    const int ew = ((tg >> 1) * 4 + pcg) * 1024 + (((tg & 1) * 512 + pcl * 2) ^ ((tg & 1) * 32));
    const int ewb = (((tg & 3) >> 1) * 4 + pcg) * 1024 + (((tg & 1) * 512 + pcl * 2) ^ ((tg & 1) * 32));
    const int ekh = (8 * tg) * VSTR + c0 * 2;
    const int evw = (tid >> 3) * VSTR + (tid & 7) * 32;
    const int lo = (c16 * 64 + 16 * g) ^ ((c16 >> 3) << 5);
    const int trq = (c16 >> 2) * VSTR + (c16 & 3) * 8 + (4 * g) * VSTR;
    f32x4 S[8];
#pragma unroll
    for (int i = 0; i < 8; ++i) S[i] = (f32x4){0.f, 0.f, 0.f, 0.f};
#ifdef PROBE_SEG
    const bool probe = (blockIdx.x == 0 && tid == 0);
    if (probe) ((volatile LAS unsigned long long*)(lds + 131072 + 2048))[15] = __builtin_amdgcn_s_memrealtime();
#endif
    if (wave == 0) { *(LAS u32x2*)(lds + L_P + 0 * 1024 + lane * 16 + 8) = (u32x2){0u, 0u}; *(LAS u32x2*)(lds + L_P + 3 * 1024 + lane * 16 + 8) = (u32x2){0u, 0u}; }
    unsigned qr[8], lr[8]; u32x4 vr[2]; unsigned short gr[16];
#define HG_LOADS(c) do { _Pragma("unroll") for (int i = 0; i < 8; ++i) { qr[i] = Qp[((size_t)(c) * 64 + i) * (D / 2)]; lr[i] = Lp[((size_t)(c) * 64 + i) * (D / 2)]; } \
        vr[0] = Vp[(size_t)(c) * 64 * (D / 8)]; vr[1] = Vp[(size_t)(c) * 64 * (D / 8) + 1]; } while (0)
    HG_LOADS(0);
#pragma unroll 1
    for (int c = 0; c < SEQ / 64; ++c) {
        float p0[8], p1[8]; float a0 = 0.f, a1 = 0.f;
#pragma unroll
        for (int i = 0; i < 8; ++i) { a0 += h2f_lo(lr[i]); a1 += h2f_hi(lr[i]); p0[i] = a0; p1[i] = a1; }
        *(LAS f32x2*)(lds + L_TOT + (tg * 128 + c0) * 4) = (f32x2){a0, a1};
        *(LAS u32x4*)(lds + L_V + evw) = vr[0]; *(LAS u32x4*)(lds + L_V + evw + 16) = vr[1];
        HG_LBAR();
        HG_SEG(0);
        float off0 = 0.f, off1 = 0.f, R0 = 0.f, R1 = 0.f, L0 = 0.f, L1 = 0.f;
#pragma unroll
        for (int j = 0; j < 8; ++j) { const f32x2 t = *(const LAS f32x2*)(lds + L_TOT + (j * 128 + c0) * 4);
            if (j < tg) { off0 += t.x; off1 += t.y; } if (j < 4) { R0 += t.x; R1 += t.y; } L0 += t.x; L1 += t.y; }
        const float eR0 = __expf(R0), eR1 = __expf(R1), eLR0 = __expf(L0 - R0), eLR1 = __expf(L1 - R1);
        if (tg == 0) *(LAS f32x2*)(lds + L_DEC + c0 * 4) = (f32x2){__expf(L0), __expf(L1)};
        if (tg >= 4) {
#pragma unroll
            for (int i = 0; i < 8; ++i) {
                const float B0 = off0 + p0[i], B1 = off1 + p1[i], q0 = bflo(qr[i]), q1 = bfhi(qr[i]);
                const float k0 = 1.0f - __expf(h2f_lo(lr[i])), k1 = 1.0f - __expf(h2f_hi(lr[i]));
                const float e10 = __expf(B0 - R0), e11 = __expf(B1 - R1), e20 = __expf(fminf(R0 - B0, 80.f)), e21 = __expf(fminf(R1 - B1, 80.f));
                *(LAS unsigned*)(lds + L_QT + ew + 64 * i) = cvtpk(q0 * e10 * eR0, q1 * e11 * eR1);
                *(LAS unsigned*)(lds + L_QB + ewb + 64 * i) = cvtpk(q0 * e10, q1 * e11);
                *(LAS unsigned*)(lds + L_K2 + ew + 64 * i) = cvtpk(k0 * e20, k1 * e21);
                *(LAS unsigned*)(lds + L_KH + ekh + VSTR * i) = cvtpk(k0 * e20 * eLR0, k1 * e21 * eLR1);
            }
        } else {
#pragma unroll
            for (int i = 0; i < 8; ++i) {
                const float B0 = off0 + p0[i], B1 = off1 + p1[i], q0 = bflo(qr[i]), q1 = bfhi(qr[i]);
                const float k0 = 1.0f - __expf(h2f_lo(lr[i])), k1 = 1.0f - __expf(h2f_hi(lr[i]));
                const float e00 = __expf(B0), e01 = __expf(B1), e30 = __expf(fminf(-B0, 80.f)), e31 = __expf(fminf(-B1, 80.f));
                const float k20 = k0 * e30 * eR0, k21 = k1 * e31 * eR1;
                *(LAS unsigned*)(lds + L_QT + ew + 64 * i) = cvtpk(q0 * e00, q1 * e01);
                *(LAS unsigned*)(lds + L_K1 + ewb + 64 * i) = cvtpk(k0 * e30, k1 * e31);
                *(LAS unsigned*)(lds + L_K2 + ew + 64 * i) = cvtpk(k20, k21);
                *(LAS unsigned*)(lds + L_KH + ekh + VSTR * i) = cvtpk(k20 * eLR0, k21 * eLR1);
            }
        }
        HG_LBAR();
        HG_SEG(1);
        if (c + 1 < SEQ / 64) HG_LOADS(c + 1);
#pragma unroll
        for (int tb = 0; tb < 4; ++tb)
#pragma unroll
            for (int r = 0; r < 4; ++r) gr[tb * 4 + r] = Gp[((size_t)c * 64 + 16 * tb + r) * MIXW];
#pragma unroll
        for (int rep = 0; rep < 2; ++rep) {
            const int ti = wave + 8 * rep;
            if (ti < 10) {
                const int tb = ti < 1 ? 0 : ti < 3 ? 1 : ti < 6 ? 2 : 3, sb = ti - (tb == 0 ? 0 : tb == 1 ? 1 : tb == 2 ? 3 : 6);
                const LAS unsigned char* kb = lds + (tb < 2 ? L_K1 : L_K2) + sb * 4096 + lo;
                const LAS unsigned char* qb = lds + (tb < 2 ? L_QT + tb * 4096 : L_QB + (tb - 2) * 4096) + lo;
                f32x4 acc = (f32x4){0.f, 0.f, 0.f, 0.f};
#pragma unroll
                for (int ks = 0; ks < 4; ++ks) acc = __builtin_amdgcn_mfma_f32_16x16x32_bf16(ld128(kb + ks * 1024), ld128(qb + ks * 1024), acc, 0, 0, 0);
                if (sb == tb) {
#pragma unroll
                    for (int r = 0; r < 4; ++r) acc[r] = (4 * g + r <= c16) ? acc[r] : 0.f;
                }
                const int fi = tb < 2 ? tb : 2 * tb - 2 + (sb >> 1);
                *(LAS u32x2*)(lds + L_P + fi * 1024 + lane * 16 + 8 * (sb & 1)) = (u32x2){cvtpk(acc[0], acc[1]), cvtpk(acc[2], acc[3])};
            }
        }
        HG_SEG(2);
        bf16x8 vb[2];
#pragma unroll
        for (int kk = 0; kk < 2; ++kk) { const LAS unsigned char* vp = lds + L_V + trq + (32 * kk) * VSTR + (16 * wave) * 2; vb[kk] = cat(ldtr(vp), ldtr(vp + 16 * VSTR)); }
        f32x4 o[4];
#pragma unroll
        for (int tb = 0; tb < 4; ++tb) o[tb] = (f32x4){0.f, 0.f, 0.f, 0.f};
#pragma unroll
        for (int kk = 0; kk < 4; ++kk) {
            const u32x4 sw = (u32x4){cvtpk(S[2 * kk][0], S[2 * kk][1]), cvtpk(S[2 * kk][2], S[2 * kk][3]), cvtpk(S[2 * kk + 1][0], S[2 * kk + 1][1]), cvtpk(S[2 * kk + 1][2], S[2 * kk + 1][3])};
            const bf16x8 sbf = __builtin_bit_cast(bf16x8, sw);
#pragma unroll
            for (int tb = 0; tb < 4; ++tb) o[tb] = __builtin_amdgcn_mfma_f32_16x16x32_bf16(ld128(lds + L_QT + (tb * 4 + kk) * 1024 + lo), sbf, o[tb], 0, 0, 0);
        }
#pragma unroll
        for (int dkb = 0; dkb < 8; ++dkb) {
            const f32x4 dv = *(const LAS f32x4*)(lds + L_DEC + (16 * dkb + 4 * g) * 4);
            f32x4 s = S[dkb] * dv;
#pragma unroll
            for (int kk = 0; kk < 2; ++kk) { const LAS unsigned char* kp = lds + L_KH + trq + (32 * kk) * VSTR + (16 * dkb) * 2;
                s = __builtin_amdgcn_mfma_f32_16x16x32_bf16(cat(ldtr(kp), ldtr(kp + 16 * VSTR)), vb[kk], s, 0, 0, 0); }
            S[dkb] = s;
        }
        HG_LBAR();
        HG_SEG(3);
        o[0] = __builtin_amdgcn_mfma_f32_16x16x32_bf16(ld128(lds + L_P + 0 * 1024 + lane * 16), vb[0], o[0], 0, 0, 0);
        o[1] = __builtin_amdgcn_mfma_f32_16x16x32_bf16(ld128(lds + L_P + 1 * 1024 + lane * 16), vb[0], o[1], 0, 0, 0);
        o[2] = __builtin_amdgcn_mfma_f32_16x16x32_bf16(ld128(lds + L_P + 2 * 1024 + lane * 16), vb[0], o[2], 0, 0, 0);
        o[2] = __builtin_amdgcn_mfma_f32_16x16x32_bf16(ld128(lds + L_P + 3 * 1024 + lane * 16), vb[1], o[2], 0, 0, 0);
        o[3] = __builtin_amdgcn_mfma_f32_16x16x32_bf16(ld128(lds + L_P + 4 * 1024 + lane * 16), vb[0], o[3], 0, 0, 0);
        o[3] = __builtin_amdgcn_mfma_f32_16x16x32_bf16(ld128(lds + L_P + 5 * 1024 + lane * 16), vb[1], o[3], 0, 0, 0);
#pragma unroll
        for (int tb = 0; tb < 4; ++tb) { f32x4 q2 = o[tb] * o[tb];
#pragma unroll
            for (int r = 0; r < 4; ++r) q2[r] = row16_sum(q2[r]);
            if (c16 == 0) *(LAS f32x4*)(lds + L_SSQ + (wave * 64 + 16 * tb + 4 * g) * 4) = q2; }
        HG_LBAR();
        HG_SEG(4);
        { float ss = 0.f;
#pragma unroll
          for (int w2 = 0; w2 < 8; ++w2) ss += *(const LAS float*)(lds + L_SSQ + (w2 * 64 + lane) * 4);
          *(LAS float*)(lds + L_RS + (wave * 64 + lane) * 4) = __builtin_amdgcn_rsqf(ss * (1.0f / HD) + EPS); }
        asm volatile("s_waitcnt lgkmcnt(0)" ::: "memory");
#pragma unroll
        for (int tb = 0; tb < 4; ++tb) { const f32x4 rs = *(const LAS f32x4*)(lds + L_RS + (wave * 64 + 16 * tb + 4 * g) * 4);
#pragma unroll
            for (int r = 0; r < 4; ++r) Gp[((size_t)c * 64 + 16 * tb + r) * MIXW] = (bf16)f2bf(o[tb][r] * rs[r] * nwv * __uint_as_float((unsigned)gr[tb * 4 + r] << 16)); }
        HG_SEG(5);
    }
#undef HG_LOADS
    HG_LBAR();
}
}


__device__ __forceinline__ void mixer_phase(Frame& F, const int l) {
    REFRESH_IDS(F);
    const int nh = F.G < BATCH * NHEAD ? F.G : BATCH * NHEAD;
    if (F.bid < nh) {
        const KArgs ka = kargs(); const float* nw = ka->in[IN_HNW] + l * HD;
        const bf16* Qg = (const bf16*)(ka->ws + WS_Q); const bf16* LFg = (const bf16*)(ka->ws + WS_LF); const bf16* Vg = (const bf16*)(ka->ws + WS_V); bf16* MIXg = (bf16*)(ka->ws + WS_MIX);
        for (int unit = F.bid; unit < BATCH * NHEAD; unit += nh) hg::hgrn_unit(F.lds + RING_OFF, F.tid, F.lane, F.wave, unit / NHEAD, unit % NHEAD, Qg, LFg, Vg, MIXg, nw);
    }
    if (F.G > nh) { if (F.bid >= nh) pool_pass(F, l, F.bid - nh, F.G - nh); }
    else pool_pass(F, l, F.bid, F.G);
}

#ifndef DBG_KINDS
#define DBG_KINDS 0x7f
#endif
#define KIND(j) ((DBG_KINDS >> (j)) & 1)
#define IN(k) (lo <= (k) && (k) < hi)
#define BOTH(k) (IN(k) && IN((k) + 1))
#define GRID_BAR() do { if (N_LAUNCHES == 1) xcd_barrier(bar); } while (0)
#if defined(PROBE_PHASE) && !defined(PROBE_PHASE_END)
#define PROBE_PHASE_END (PROBE_PHASE + 1)
#endif
#ifdef PROBE_PHASE
constexpr int STAMP_OFF = LDSCTL_OFF + 1024;
#define STAMP(k) do { if (F.bid == 0 && F.wave0 == 0 && lane_now() == 0) *(volatile LAS unsigned long long*)(F.lds + STAMP_OFF + 8 * (k)) = __builtin_amdgcn_s_memrealtime(); } while (0)
#else
#define STAMP(k) do { } while (0)
#endif
template <int l> __device__ __forceinline__ void layer_phases(Frame& F, const XcdBarrier& bar, const int lo, const int hi) {
        const int p = 2 + 4 * l;
    if (KIND(2) && IN(p)) {
        const KArgs ka = kargs(); bf16* P_XN = (bf16*)(ka->ws + WS_XN); bf16* P_WIN = (bf16*)(ka->ws + WS_WIN);
        pg8::Gemm g{P_XN, P_WIN + (size_t)l * NZ * D, M, NZ, D, D, 0}; pg8::StaticOrder S; REFRESH_IDS(F); S.init(M, NZ, F.G, F.bid);
        pg8::EpiZ E{l};
        pg8::gemm_phase<pg8::EpiZ, pg8::StaticOrder, PG8_ALIGN, PG8_SP2>(F.lds + RING_OFF, g, S, E, F.tid);
        if (BOTH(p)) GRID_BAR();
    }
    STAMP(p + 1);
    if (KIND(3) && IN(p + 1)) {
#if defined(HGRN_NAIVE)
        REFRESH_IDS(F); pool_pass(F, l, F.bid, F.G);
        hgrn_naive(F, l);
#else
        mixer_phase(F, l);
#endif
        if (BOTH(p + 1)) GRID_BAR();
    }
    STAMP(p + 2);
    if (KIND(5) && IN(p + 2)) {
        const KArgs ka = kargs(); bf16* P_MIX = (bf16*)(ka->ws + WS_MIX); bf16* P_WOUT = (bf16*)(ka->ws + WS_WOUT);
        pg8::Gemm g{P_MIX, P_WOUT + (size_t)l * D * MIXW, M, D, MIXW, MIXW, 0}; pg8::StaticOrder S; REFRESH_IDS(F); S.init(M, D, F.G, F.bid);
        pg8::EpiBf16Plain E{WS_Y, D};
        pg8::gemm_phase<pg8::EpiBf16Plain, pg8::StaticOrder, PG8_ALIGN, PG8_SP2>(F.lds + RING_OFF, g, S, E, F.tid);
        if (BOTH(p + 2)) GRID_BAR();
    }
    STAMP(p + 3);
    if (KIND(6) && IN(p + 3)) {
        rowpass(F, l);
        if (BOTH(p + 3)) GRID_BAR();
    }
    STAMP(p + 4);
}

__global__ void __launch_bounds__(NWAVES * 64, 2) skel_fwd(Args args) {
    extern __shared__ __attribute__((aligned(16))) unsigned char lds[];
    Frame F;
    F.lds = (LAS unsigned char*)lds;
    F.MISC = (volatile LAS unsigned*)(F.lds + MISC_OFF);
    F.tid = threadIdx.x; F.lane = F.tid & 63; F.wave = __builtin_amdgcn_readfirstlane(F.tid >> 6); F.wave0 = F.wave;
    F.G = gridDim.x; F.bid = blockIdx.x;
    F.ctl = (gu32*)(args.ws + WS_CTL);
    for (int u = F.tid; u < (LDS_BYTES - LDSCTL_OFF) / 4; u += NWAVES * 64) ((LAS unsigned*)(F.lds + LDSCTL_OFF))[u] = 0u;
    __syncthreads();
    XcdBarrier bar; bar.bar = (unsigned*)(F.ctl + CW_BAR); bar.x = 0; bar.st = nullptr; bar.wave0 = F.wave0;
    if (N_LAUNCHES == 1) bar = xcd_barrier_post((unsigned*)(F.ctl + CW_BAR), F.MISC + 8);
    const int lo = (N_LAUNCHES == 1) ? 0 : args.ph_lo, hi = (N_LAUNCHES == 1) ? N_PHASES : args.ph_hi;

    STAMP(0);
    if (KIND(0) && IN(0)) { p0_prologue(F); if (N_LAUNCHES == 1) xcd_barrier_census(bar); if (BOTH(0)) GRID_BAR(); }
    STAMP(1);
    if (KIND(1) && IN(1)) { p1_weights(F); rowpass(F, -1); if (BOTH(1)) GRID_BAR(); }
    STAMP(2);
    layer_phases<0>(F, bar, lo, hi);
    layer_phases<1>(F, bar, lo, hi);
    static_assert(DEPTH == 2, "two explicit layer_phases calls");
#ifdef PROBE_SEG
    if (F.bid == 0 && F.wave0 == 0 && lane_now() == 0) {
        const unsigned long long span = ((volatile LAS unsigned long long*)(F.lds + 131072 + 2048))[PROBE_SEG];
        const unsigned long long t0 = __builtin_amdgcn_s_memrealtime();
        while (__builtin_amdgcn_s_memrealtime() - t0 < span) __builtin_amdgcn_s_sleep(8);
    }
#endif
#ifdef PROBE_PHASE
    if (F.bid == 0 && F.wave0 == 0 && lane_now() == 0) {
        const unsigned long long span = *(volatile LAS unsigned long long*)(F.lds + STAMP_OFF + 8 * (PROBE_PHASE_END)) - *(volatile LAS unsigned long long*)(F.lds + STAMP_OFF + 8 * (PROBE_PHASE));
        const unsigned long long t0 = __builtin_amdgcn_s_memrealtime();
        while (__builtin_amdgcn_s_memrealtime() - t0 < span) __builtin_amdgcn_s_sleep(8);
    }
#endif
#undef IN
#undef BOTH
}

extern "C" void kernel_launch(void* const* d_in, const int* in_sizes, int n_in, void* d_out, int out_size, void* d_ws, size_t ws_size, hipStream_t stream) {
    static int grid = 0;
    if (grid == 0) {
        if (n_in != 12 || in_sizes[0] != M * D || out_size != M * D || ws_size < WS_END) { fprintf(stderr, "kernel_launch: unexpected shapes: n_in %d in0 %d out %d ws %zu\n", n_in, n_in > 0 ? in_sizes[0] : -1, out_size, ws_size); grid = -1; return; }
        int dev = 0, cus = 0, per_cu = 0;
        if (hipGetDevice(&dev) != hipSuccess || hipDeviceGetAttribute(&cus, hipDeviceAttributeMultiprocessorCount, dev) != hipSuccess) { grid = -1; return; }
        if (hipFuncSetAttribute((const void*)skel_fwd, hipFuncAttributeMaxDynamicSharedMemorySize, LDS_BYTES) != hipSuccess) { fprintf(stderr, "kernel_launch: hipFuncSetAttribute failed\n"); grid = -1; return; }
        if (hipOccupancyMaxActiveBlocksPerMultiprocessor(&per_cu, (const void*)skel_fwd, NWAVES * 64, LDS_BYTES) != hipSuccess || per_cu < 1) { fprintf(stderr, "kernel_launch: occupancy query says %d blocks per CU\n", per_cu); per_cu = 1; }
        (void)hipGetLastError();
        grid = cus;
    }
    if (grid < 0) return;
    if (hipMemsetAsync((char*)d_ws + WS_CTL, 0, CTL_ZERO_BYTES, stream) != hipSuccess) { fprintf(stderr, "kernel_launch: memset failed\n"); return; }
    Args a{};
    for (int i = 0; i < 12; ++i) a.in[i] = (const float*)d_in[i];
    a.out = (float*)d_out; a.ws = (unsigned char*)d_ws;
    for (int li = 0; li < N_LAUNCHES; ++li) {
        a.ph_lo = (N_LAUNCHES == 1) ? 0 : li; a.ph_hi = (N_LAUNCHES == 1) ? N_PHASES : li + 1; a.li = li;
        hipLaunchKernelGGL(skel_fwd, dim3(grid), dim3(NWAVES * 64), LDS_BYTES, stream, a);
        const hipError_t le = hipPeekAtLastError();
        if (le != hipSuccess) { fprintf(stderr, "kernel_launch: launch %d failed: %s\n", li, hipGetErrorName(le)); break; }
    }
}
```

```cpp
#include <hip/hip_runtime.h>
#include <cstdio>
#include <cstdint>

#ifndef MK_N_LAUNCHES
#define MK_N_LAUNCHES 1
#endif

constexpr int NWAVES = 8;
constexpr int N_LAUNCHES = MK_N_LAUNCHES;
constexpr int BATCH = 16, SEQ = 2048, D = 1024, DEPTH = 2, NZ = 6144, MIXW = 2048, NHEAD = 8, HD = 128;
constexpr int M = BATCH * SEQ;
constexpr float EPS = 1e-6f;
constexpr int N_PHASES = 2 + 4 * DEPTH;

constexpr size_t MiB = 1u << 20;
constexpr size_t WS_CTL = 0, CTL_ZERO_BYTES = 1 * MiB;
constexpr size_t WS_MOD = 1 * MiB;
constexpr size_t WS_LB = 1 * MiB + 512 * 1024;
constexpr size_t WS_WIN = 2 * MiB;
constexpr size_t WS_WOUT = 26 * MiB;
constexpr size_t WS_WPOOL = 34 * MiB;
constexpr size_t WS_XN = 36 * MiB;
constexpr size_t WS_U = 100 * MiB, WS_Q = 164 * MiB, WS_LF = 228 * MiB, WS_V = 292 * MiB;
constexpr size_t WS_MIX = 356 * MiB;
constexpr size_t WS_Y = WS_U;
constexpr size_t WS_END = 484 * MiB;
constexpr int CW_TMO = 0, CW_CODE = 1;
constexpr int CW_BAR = 4096;


struct Args { const float* in[12]; float* out; unsigned char* ws; int ph_lo, ph_hi, li, pad; };
typedef const __attribute__((address_space(4))) Args* KArgs;
__device__ __forceinline__ KArgs kargs() { KArgs p = (KArgs)__builtin_amdgcn_kernarg_segment_ptr(); asm volatile("" : "+s"(p)); return p; }
enum { IN_X = 0, IN_C, IN_NPRE, IN_ADAW, IN_ADAB, IN_WIN, IN_POOLW, IN_PSCALE, IN_HLB, IN_HNW, IN_WOUT, IN_NPOST };

namespace pg8 {
#define PG8_LAS __attribute__((address_space(3)))
typedef unsigned short bf16_t;
typedef short bf16x8 __attribute__((ext_vector_type(8)));
typedef float f32x4 __attribute__((ext_vector_type(4)));
typedef unsigned u32x4 __attribute__((ext_vector_type(4)));
constexpr int BM = 256, BK = 64, HALF = 128, HTB = HALF * BK * 2  , STAGE_BYTES = 8 * HTB, NXCD = 8, WGM = 8;

__host__ __device__ __forceinline__ int lds_byte(int r, int c) { const int st = (r >> 4) * 2 + (c >> 5), rr = r & 15, cc = c & 31, ob = rr * 64 + cc * 2; return st * 1024 + (ob ^ (((ob >> 9) & 1) << 5)); }
__host__ __device__ __forceinline__ void stage_rc(int b, int& R, int& C) { const int st = b / 1024, sb = b % 1024, swz = sb ^ (((sb >> 9) & 1) << 5); R = (st >> 1) * 16 + swz / 64; C = (st & 1) * 32 + (swz % 64) / 2; }
__host__ __device__ __forceinline__ int perm32(int rho) { const int n = rho >> 4, i = rho & 15; return 8 * (i >> 2) + 4 * n + (i & 3); }

struct Unit { int pm, pn; };
struct Gemm { const bf16_t* A; const bf16_t* Bt; int M, N, K, lda, acol; };

struct StaticOrder {
    int nM, nN, nwg, G, c;
    __host__ __device__ void init(int M, int N, int G_, int c_) { nM = M / BM; nN = N / BM; nwg = nM * nN; G = G_; c = c_; }
    __host__ __device__ bool next(int i, Unit& u) const {
        const long L = (long)i * G + c; if (L >= nwg) return false;
        int wgid = (int)L; { const int q = nwg / NXCD, r = nwg % NXCD, xcd = wgid % NXCD, off = wgid / NXCD; wgid = (xcd < r ? xcd * (q + 1) : r * (q + 1) + (xcd - r) * q) + off; }
        const int nig = WGM * nN, gid = wgid / nig, fm = gid * WGM, gsz = (nM - fm) < WGM ? (nM - fm) : WGM;
        u.pm = fm + ((wgid % nig) % gsz); u.pn = (wgid % nig) / gsz; return true;
    }
    __device__ __forceinline__ void a_ready(const Unit&) const {}
    __device__ __forceinline__ void done(const Unit&) const {}
};

__device__ __forceinline__ unsigned cvt_pk_bf16(float lo, float hi) { unsigned r; asm volatile("v_cvt_pk_bf16_f32 %0, %1, %2" : "=v"(r) : "v"(lo), "v"(hi)); return r; }
__device__ __forceinline__ unsigned cvt_pk_f16(float lo, float hi) { typedef _Float16 h2 __attribute__((ext_vector_type(2))); h2 v; v.x = (_Float16)lo; v.y = (_Float16)hi; return __builtin_bit_cast(unsigned, v); }
__device__ __forceinline__ float bf_lo(unsigned w) { return __uint_as_float(w << 16); }
__device__ __forceinline__ float bf_hi(unsigned w) { return __uint_as_float(w & 0xffff0000u); }
__device__ __forceinline__ float sigmoid_f(float x) { return __builtin_amdgcn_rcpf(1.0f + __expf(-x)); }

struct EpiBf16Plain {
    static constexpr bool PERM = true, AFTER_DRAIN = false;
    size_t ws_off; int ldc;
    __device__ __forceinline__ void operator()(const f32x4 (&acc)[2][2][4][2], const Unit& u, int wr, int wc, int fr, int fq) const {
        const int row0 = u.pm * BM + wr * 64 + fr, col0 = u.pn * BM + wc * 32 + 8 * fq;
        bf16_t* O = (bf16_t*)(kargs()->ws + ws_off);
#pragma unroll
        for (int ai = 0; ai < 2; ++ai)
#pragma unroll
            for (int m = 0; m < 4; ++m) { bf16_t* rowp = O + (size_t)(row0 + ai * HALF + m * 16) * ldc + col0;
#pragma unroll
                for (int bj = 0; bj < 2; ++bj) { const f32x4 v0 = acc[ai][bj][m][0], v1 = acc[ai][bj][m][1];
                    u32x4 w; w.x = cvt_pk_bf16(v0[0], v0[1]); w.y = cvt_pk_bf16(v0[2], v0[3]); w.z = cvt_pk_bf16(v1[0], v1[1]); w.w = cvt_pk_bf16(v1[2], v1[3]);
                    *(u32x4*)(rowp + bj * HALF) = w; } }
    }
};

struct EpiZ {
    static constexpr bool PERM = true, AFTER_DRAIN = false;
    int l;
    template <int ACT> __device__ __forceinline__ void tile(const f32x4 (&acc)[2][2][4][2], bf16_t* base, int ldc, int row0, int col0, const float* lb) const {
        f32x4 lbv[2][2];
        if (ACT == 2) {
#pragma unroll
            for (int bj = 0; bj < 2; ++bj)
#pragma unroll
                for (int n = 0; n < 2; ++n) lbv[bj][n] = *(const f32x4*)(lb + col0 + bj * HALF + 4 * n);
        }
#pragma unroll
        for (int ai = 0; ai < 2; ++ai)
#pragma unroll
            for (int m = 0; m < 4; ++m) { bf16_t* rowp = base + (size_t)(row0 + ai * HALF + m * 16) * ldc + col0;
#pragma unroll
                for (int bj = 0; bj < 2; ++bj) { f32x4 v[2] = {acc[ai][bj][m][0], acc[ai][bj][m][1]};
                    u32x4 w;
                    if (ACT == 1) {
#pragma unroll
                        for (int n = 0; n < 2; ++n)
#pragma unroll
                            for (int e = 0; e < 4; ++e) v[n][e] = v[n][e] * sigmoid_f(v[n][e]);
                    }
                    if (ACT == 2) {
#pragma unroll
                        for (int n = 0; n < 2; ++n)
#pragma unroll
                            for (int e = 0; e < 4; ++e) { const float x = fminf(fmaxf(v[n][e], -30.f), 30.f), l = lbv[bj][n][e]; v[n][e] = __logf(l + (1.0f - l) * sigmoid_f(x)); }
                        w.x = cvt_pk_f16(v[0][0], v[0][1]); w.y = cvt_pk_f16(v[0][2], v[0][3]); w.z = cvt_pk_f16(v[1][0], v[1][1]); w.w = cvt_pk_f16(v[1][2], v[1][3]);
                    } else {
                        w.x = cvt_pk_bf16(v[0][0], v[0][1]); w.y = cvt_pk_bf16(v[0][2], v[0][3]); w.z = cvt_pk_bf16(v[1][0], v[1][1]); w.w = cvt_pk_bf16(v[1][2], v[1][3]);
                    }
                    *(u32x4*)(rowp + bj * HALF) = w; }
                if (ACT != 0) __builtin_amdgcn_sched_barrier(0); }
    }
    __device__ __forceinline__ void operator()(const f32x4 (&acc)[2][2][4][2], const Unit& u, int wr, int wc, int fr, int fq) const {
        const int seg = u.pn >> 2, row0 = u.pm * BM + wr * 64 + fr, col0 = (u.pn & 3) * BM + wc * 32 + 8 * fq;
        unsigned char* ws = kargs()->ws; const float* lb = (const float*)(ws + WS_LB) + l * 1024;
        const size_t off = seg == 0 ? WS_U : seg == 2 ? WS_Q : seg == 3 ? WS_LF : seg == 4 ? WS_V : seg == 1 ? WS_MIX : WS_MIX + 2048;
        const int ldc = (seg == 1 || seg == 5) ? 2048 : 1024;
        bf16_t* base = (bf16_t*)(ws + off);
        if (seg == 3) tile<2>(acc, base, ldc, row0, col0, lb);
        else if (seg == 1 || seg == 5) tile<1>(acc, base, ldc, row0, col0, lb);
        else tile<0>(acc, base, ldc, row0, col0, lb);
    }
};

struct EpiPool {
    static constexpr bool PERM = true, AFTER_DRAIN = false;
    int l;
    __device__ __forceinline__ void operator()(const f32x4 (&acc)[2][2][4][2], const Unit& u, int wr, int wc, int fr, int fq) const {
        const int row0 = u.pm * BM + wr * 64 + fr, col0 = u.pn * BM + wc * 32 + 8 * fq;
        const KArgs ka = kargs(); bf16_t* MIX = (bf16_t*)(ka->ws + WS_MIX); const float* pscale = ka->in[IN_PSCALE] + l * 1024;
        f32x4 sv[2][2];
#pragma unroll
        for (int bj = 0; bj < 2; ++bj)
#pragma unroll
            for (int n = 0; n < 2; ++n) sv[bj][n] = *(const f32x4*)(pscale + col0 + bj * HALF + 4 * n);
#pragma unroll
        for (int ai = 0; ai < 2; ++ai)
#pragma unroll
            for (int m = 0; m < 4; ++m) { bf16_t* rowp = MIX + (size_t)(row0 + ai * HALF + m * 16) * 2048 + col0;
#pragma unroll
                for (int bj = 0; bj < 2; ++bj) { const u32x4 gw = *(const u32x4*)(rowp + bj * HALF);
                    const f32x4 v0 = acc[ai][bj][m][0] * sv[bj][0], v1 = acc[ai][bj][m][1] * sv[bj][1];
                    u32x4 w; w.x = cvt_pk_bf16(v0[0] * bf_lo(gw.x), v0[1] * bf_hi(gw.x)); w.y = cvt_pk_bf16(v0[2] * bf_lo(gw.y), v0[3] * bf_hi(gw.y));
                    w.z = cvt_pk_bf16(v1[0] * bf_lo(gw.z), v1[1] * bf_hi(gw.z)); w.w = cvt_pk_bf16(v1[2] * bf_lo(gw.w), v1[3] * bf_hi(gw.w));
                    *(u32x4*)(rowp + bj * HALF) = w; }
                if (m & 1) asm volatile("" ::: "memory"); }
    }
};

template <class Epi, class Sched, bool ALIGN_EPI = false, bool SP2 = false>
__device__ __forceinline__ void gemm_phase(PG8_LAS unsigned char* lds, const Gemm g, const Sched& S, const Epi& E, const int tid_in) {
    int tid_ = tid_in; asm volatile("" : "+v"(tid_));
    const int tid = tid_, wid = __builtin_amdgcn_readfirstlane(tid >> 6), lane = tid & 63, wr = wid >> 2, wc = wid & 3, fr = lane & 15, fq = lane >> 4;
    const int K = g.K, nt = K / BK;
    unsigned voffA[2], voffB[2];
#pragma unroll
    for (int i = 0; i < 2; ++i) { int R, C; stage_rc(tid * 16 + i * 8192, R, C); const int Rb = Epi::PERM ? ((R & ~31) + perm32(R & 31)) : R;
        voffA[i] = (unsigned)(R * g.lda + C) * 2u; voffB[i] = (unsigned)(Rb * K + C) * 2u; }
    const size_t kstep = (size_t)(BK * 2);
    const size_t hstepA = (size_t)HALF * g.lda * 2, hstepB = (size_t)HALF * K * 2;
    const size_t tstepA = 2 * hstepA, tstepB = 2 * hstepB;
    const size_t acolB = (size_t)g.acol * 2;
    const unsigned ldsw = (unsigned)wid * 1024u;
    const int aoff = lds_byte(wr * 64 + fr, fq * 8), boff = lds_byte(wc * 32 + fr, fq * 8);
#define PG8_SA(b, h) (((b) * 2 + (h)) * HTB)
#define PG8_SB(b, h) ((4 + (b) * 2 + (h)) * HTB)
#define PG8_STAGE(bufoff, gbase, voff) do { _Pragma("unroll") for (int _i = 0; _i < 2; ++_i) \
        __builtin_amdgcn_global_load_lds((const unsigned*)((const char*)(gbase) + (voff)[_i]), (PG8_LAS unsigned*)(lds + (bufoff) + ldsw + _i * 8192), 16, 0, 0); } while (0)
#define PG8_LDA(dst, b, h) do { _Pragma("unroll") for (int m = 0; m < 4; ++m) _Pragma("unroll") for (int k = 0; k < 2; ++k) dst[m][k] = *(const PG8_LAS bf16x8*)(lds + PG8_SA(b, h) + aoff + m * 2048 + k * 1024); } while (0)
#define PG8_LDB(dst, b, h) do { _Pragma("unroll") for (int n = 0; n < 2; ++n) _Pragma("unroll") for (int k = 0; k < 2; ++k) dst[n][k] = *(const PG8_LAS bf16x8*)(lds + PG8_SB(b, h) + boff + n * 2048 + k * 1024); } while (0)
#define PG8_MMA(ai, bj, At, Bt) do { __builtin_amdgcn_s_setprio(1); _Pragma("unroll") for (int m = 0; m < 4; ++m) _Pragma("unroll") for (int n = 0; n < 2; ++n) _Pragma("unroll") for (int k = 0; k < 2; ++k) \
        acc[ai][bj][m][n] = __builtin_amdgcn_mfma_f32_16x16x32_bf16(Bt[n][k], At[m][k], acc[ai][bj][m][n], 0, 0, 0); __builtin_amdgcn_s_setprio(0); } while (0)
#define PG8_WAIT_V(n) asm volatile("s_waitcnt vmcnt(" #n ")" ::: "memory")
#define PG8_WAIT_L(n) asm volatile("s_waitcnt lgkmcnt(" #n ")" ::: "memory")
#define PG8_BAR __builtin_amdgcn_s_barrier()
#define PG8_SCHED __builtin_amdgcn_sched_barrier(0)
    Unit cur, nxt; int ui = 0;
    if (!S.next(0, cur)) return;
    f32x4 acc[2][2][4][2];
#pragma unroll
    for (int a = 0; a < 2; ++a)
#pragma unroll
        for (int b = 0; b < 2; ++b)
#pragma unroll
            for (int m = 0; m < 4; ++m)
#pragma unroll
                for (int n = 0; n < 2; ++n) acc[a][b][m][n] = (f32x4){0.f, 0.f, 0.f, 0.f};
    bf16x8 At[4][2], B0[2][2], B1[2][2];
    const char* cA = (const char*)g.A + (size_t)cur.pm * tstepA + (size_t)cur.pn * acolB; const char* cB = (const char*)g.Bt + (size_t)cur.pn * tstepB;
    S.a_ready(cur);
    if constexpr (SP2) {
        PG8_STAGE(PG8_SB(0, 0), cB, voffB); PG8_STAGE(PG8_SB(0, 1), cB + hstepB, voffB); PG8_STAGE(PG8_SA(0, 0), cA, voffA); PG8_STAGE(PG8_SA(0, 1), cA + hstepA, voffA);
        if (wr == 1) PG8_BAR;
        PG8_WAIT_V(2); PG8_BAR;
        PG8_STAGE(PG8_SB(1, 0), cB + kstep, voffB); PG8_STAGE(PG8_SA(1, 0), cA + kstep, voffA); PG8_STAGE(PG8_SB(1, 1), cB + hstepB + kstep, voffB);
        PG8_WAIT_V(6); PG8_BAR;
    } else {
        PG8_STAGE(PG8_SB(0, 0), cB, voffB); PG8_STAGE(PG8_SA(0, 0), cA, voffA); PG8_STAGE(PG8_SB(0, 1), cB + hstepB, voffB); PG8_STAGE(PG8_SA(0, 1), cA + hstepA, voffA);
        if (wr == 1) PG8_BAR;
        PG8_WAIT_V(4); PG8_BAR;
        PG8_STAGE(PG8_SB(1, 0), cB + kstep, voffB); PG8_STAGE(PG8_SA(1, 0), cA + kstep, voffA); PG8_STAGE(PG8_SB(1, 1), cB + hstepB + kstep, voffB);
        PG8_WAIT_V(6); PG8_BAR;
    }
    for (;;) {
        const bool has_next = S.next(ui + 1, nxt);
        const char* nA = has_next ? (const char*)g.A + (size_t)nxt.pm * tstepA + (size_t)nxt.pn * acolB : cA; const char* nB = has_next ? (const char*)g.Bt + (size_t)nxt.pn * tstepB : cB;
        for (int t = 0; t < nt; t += 2) {
            const bool last = (t == nt - 2);
            const char* a1 = cA + (size_t)(t + 1) * kstep;
            const char* a2 = last ? nA : cA + (size_t)(t + 2) * kstep; const char* b2 = last ? nB : cB + (size_t)(t + 2) * kstep;
            const char* a3 = a2 + kstep; const char* b3 = b2 + kstep;
            if (last && has_next) S.a_ready(nxt);
            if constexpr (SP2) {
            PG8_LDB(B0, 0, 0); PG8_LDB(B1, 0, 1); PG8_SCHED; PG8_LDA(At, 0, 0); PG8_STAGE(PG8_SA(1, 1), a1 + hstepA, voffA);
            PG8_WAIT_V(8); PG8_WAIT_L(0); PG8_BAR; PG8_MMA(0, 0, At, B0); PG8_MMA(0, 1, At, B1); PG8_BAR; PG8_SCHED;
            PG8_LDA(At, 0, 1); PG8_STAGE(PG8_SB(0, 0), b2, voffB); PG8_STAGE(PG8_SB(0, 1), b2 + hstepB, voffB); PG8_STAGE(PG8_SA(0, 0), a2, voffA);
            PG8_WAIT_V(8); PG8_WAIT_L(0); PG8_BAR; PG8_MMA(1, 0, At, B0); PG8_MMA(1, 1, At, B1); PG8_BAR; PG8_SCHED;
            PG8_LDB(B0, 1, 0); PG8_LDB(B1, 1, 1); PG8_SCHED; PG8_LDA(At, 1, 0); PG8_STAGE(PG8_SA(0, 1), a2 + hstepA, voffA);
            PG8_WAIT_V(8); PG8_WAIT_L(0); PG8_BAR; PG8_MMA(0, 0, At, B0); PG8_MMA(0, 1, At, B1); PG8_BAR; PG8_SCHED;
            PG8_LDA(At, 1, 1); PG8_STAGE(PG8_SB(1, 0), b3, voffB); PG8_STAGE(PG8_SB(1, 1), b3 + hstepB, voffB); PG8_STAGE(PG8_SA(1, 0), a3, voffA);
            PG8_WAIT_V(8); PG8_WAIT_L(0); PG8_BAR; PG8_MMA(1, 0, At, B0); PG8_MMA(1, 1, At, B1); PG8_BAR; PG8_SCHED;
            } else {
            PG8_LDB(B0, 0, 0); PG8_SCHED; PG8_LDA(At, 0, 0); PG8_STAGE(PG8_SA(1, 1), a1 + hstepA, voffA);
            PG8_WAIT_L(8); PG8_BAR; PG8_WAIT_L(0); PG8_MMA(0, 0, At, B0); PG8_BAR; PG8_SCHED;
            PG8_LDB(B1, 0, 1); PG8_STAGE(PG8_SB(0, 0), b2, voffB);
            PG8_BAR; PG8_WAIT_L(0); PG8_MMA(0, 1, At, B1); PG8_BAR;
            PG8_LDA(At, 0, 1); PG8_STAGE(PG8_SA(0, 0), a2, voffA);
            PG8_BAR; PG8_WAIT_L(0); PG8_MMA(1, 0, At, B0); PG8_BAR; PG8_SCHED;
            PG8_STAGE(PG8_SB(0, 1), b2 + hstepB, voffB);
            PG8_WAIT_V(6); PG8_BAR; PG8_MMA(1, 1, At, B1); PG8_BAR;
            PG8_LDB(B0, 1, 0); PG8_SCHED; PG8_LDA(At, 1, 0); PG8_STAGE(PG8_SA(0, 1), a2 + hstepA, voffA);
            PG8_WAIT_L(8); PG8_BAR; PG8_WAIT_L(0); PG8_MMA(0, 0, At, B0); PG8_BAR; PG8_SCHED;
            PG8_LDB(B1, 1, 1); PG8_STAGE(PG8_SB(1, 0), b3, voffB);
            PG8_BAR; PG8_WAIT_L(0); PG8_MMA(0, 1, At, B1); PG8_BAR;
            PG8_LDA(At, 1, 1); PG8_STAGE(PG8_SA(1, 0), a3, voffA);
            PG8_BAR; PG8_WAIT_L(0); PG8_MMA(1, 0, At, B0); PG8_BAR; PG8_SCHED;
            PG8_STAGE(PG8_SB(1, 1), b3 + hstepB, voffB);
            PG8_WAIT_V(6); PG8_BAR; PG8_MMA(1, 1, At, B1); PG8_BAR;
            }
        }
        if constexpr (ALIGN_EPI) { if (wr == 0) PG8_BAR; }
        if constexpr (!Epi::AFTER_DRAIN) { E(acc, cur, wr, wc, fr, fq); S.done(cur); }
        if (!has_next) break;
#pragma unroll
        for (int a = 0; a < 2; ++a)
#pragma unroll
            for (int b = 0; b < 2; ++b)
#pragma unroll
                for (int m = 0; m < 4; ++m)
#pragma unroll
                    for (int n = 0; n < 2; ++n) acc[a][b][m][n] = (f32x4){0.f, 0.f, 0.f, 0.f};
        cur = nxt; cA = nA; cB = nB; ++ui;
        if constexpr (ALIGN_EPI) { if (wr == 1) PG8_BAR; }
    }
    PG8_WAIT_V(0);
    if constexpr (!ALIGN_EPI) { if (wr == 0) PG8_BAR; }
    PG8_BAR;
    if constexpr (Epi::AFTER_DRAIN) { E.fused(acc, cur, wr, wc, fr, fq, lds, wid, lane); S.done(cur); }
#undef PG8_SA
#undef PG8_SB
#undef PG8_STAGE
#undef PG8_LDA
#undef PG8_LDB
#undef PG8_MMA
#undef PG8_WAIT_V
#undef PG8_WAIT_L
#undef PG8_BAR
#undef PG8_SCHED
}
}

#define PG8_SP2 true
#define PG8_ALIGN true

constexpr int RING_OFF = 0, RING_BYTES = 131072;
constexpr int LDSCTL_OFF = 141312  , MISC_OFF = LDSCTL_OFF + 320;
constexpr int LDS_BYTES = 147456;

#define GAS __attribute__((address_space(1)))
#define LAS __attribute__((address_space(3)))
typedef unsigned short bf16;
typedef unsigned v4u __attribute__((ext_vector_type(4)));
typedef unsigned v2u __attribute__((ext_vector_type(2)));
typedef float f32x4 __attribute__((ext_vector_type(4)));
typedef short bf16x8 __attribute__((ext_vector_type(8)));
typedef GAS unsigned gu32;
typedef GAS unsigned long long gu64;
#define RLX_AGENT __ATOMIC_RELAXED, __HIP_MEMORY_SCOPE_AGENT
#define LDS_WAIT() asm volatile("s_waitcnt lgkmcnt(0)" ::: "memory")
#define VM_WAIT() asm volatile("s_waitcnt vmcnt(0)" ::: "memory")
__device__ __forceinline__ unsigned f2bf(float f) { unsigned u = __builtin_bit_cast(unsigned, f); return (u + 0x7fffu + ((u >> 16) & 1u)) >> 16; }
__device__ __forceinline__ unsigned pk2(float lo, float hi) { return f2bf(lo) | (f2bf(hi) << 16); }
__device__ __forceinline__ float bflo(unsigned w) { return __uint_as_float(w << 16); }
__device__ __forceinline__ float bfhi(unsigned w) { return __uint_as_float(w & 0xffff0000u); }
__device__ __forceinline__ float h2f_lo(unsigned w) { typedef _Float16 h2 __attribute__((ext_vector_type(2))); return (float)__builtin_bit_cast(h2, w).x; }
__device__ __forceinline__ float h2f_hi(unsigned w) { typedef _Float16 h2 __attribute__((ext_vector_type(2))); return (float)__builtin_bit_cast(h2, w).y; }

#define XB_TMO      128
#define XB_XCNT(j)  (256  + 64 * (j))
#define XB_XSUB(j)  (1280 + 64 * (j))
#define XB_XGEN(j)  (2304 + 64 * (j))
#define XB_TOP      3328
#define XB_TOPGEN   3392
#define XCD_BAR_WORDS 3456
#define XB_SPIN_CAP (1u << 18)

__device__ __forceinline__ unsigned xb_ld(unsigned* p)              { return __hip_atomic_load(p, __ATOMIC_RELAXED, __HIP_MEMORY_SCOPE_AGENT); }
__device__ __forceinline__ unsigned xb_add(unsigned* p, unsigned v) { return __hip_atomic_fetch_add(p, v, __ATOMIC_RELAXED, __HIP_MEMORY_SCOPE_AGENT); }
__device__ __forceinline__ unsigned xb_xcc_id() { return (unsigned)__builtin_amdgcn_s_getreg((3 << 11) | 20) & 0xFu; }
#define XB_SPIN(cond, bar) do { unsigned _sp = 0; while (cond) { __builtin_amdgcn_s_sleep(1); \
    if ((++_sp & 255u) == 0u) { if (xb_ld(&(bar)[XB_TMO])) break; if (_sp > XB_SPIN_CAP) { atomicAdd(&(bar)[XB_TMO], 1u); break; } } } } while (0)

__device__ __forceinline__ int lane_now() { int l; asm volatile("v_mbcnt_lo_u32_b32 %0, -1, 0\n\tv_mbcnt_hi_u32_b32 %0, -1, %0" : "=v"(l)); return l; }
struct XcdBarrier { unsigned* bar; unsigned x; volatile LAS unsigned* st; int wave0; };

__device__ __forceinline__ XcdBarrier xcd_barrier_post(unsigned* bar, volatile LAS unsigned* st) {
    XcdBarrier b; b.bar = bar; b.x = xb_xcc_id(); b.st = st; b.wave0 = __builtin_amdgcn_readfirstlane(threadIdx.x >> 6);
    if (threadIdx.x == 0) (void)xb_add(&bar[XB_XCNT(b.x)], 1u);
    return b;
}
__device__ __forceinline__ void xcd_barrier_complete(unsigned* bar, unsigned x, unsigned& nloc, unsigned& nx) {
    const unsigned G = gridDim.x * gridDim.y * gridDim.z;
    unsigned sum, cnt, mine, sp = 0u;
    for (;;) {
        sum = 0u; cnt = 0u; mine = 0u;
#pragma unroll
        for (unsigned j = 0; j < 16; ++j) { const unsigned c = xb_ld(&bar[XB_XCNT(j)]); sum += c; cnt += (c > 0u) ? 1u : 0u; mine = (j == x) ? c : mine; }
        if (sum == G) break;
        __builtin_amdgcn_s_sleep(1);
        if ((++sp & 255u) == 0u) { if (xb_ld(&bar[XB_TMO])) break; if (sp > XB_SPIN_CAP) { atomicAdd(&bar[XB_TMO], 1u); break; } }
    }
    nloc = mine > 0u ? mine : 1u; nx = cnt > 0u ? cnt : 1u;
}
__device__ __forceinline__ void xcd_barrier_census(const XcdBarrier& b) {
    if (b.wave0 == 0 && lane_now() == 0) { unsigned nloc, nx; xcd_barrier_complete(b.bar, b.x, nloc, nx); b.st[0] = nloc; b.st[1] = nx; }
}
__device__ __forceinline__ void xcd_barrier(const XcdBarrier& b) {
    asm volatile("s_waitcnt vmcnt(0)" ::: "memory");
    __syncthreads();
    if (b.wave0 == 0 && lane_now() == 0) {
        unsigned* bar = b.bar;
        __builtin_amdgcn_s_waitcnt(0);
        const unsigned nloc = b.st[0], nx = b.st[1];
        const unsigned old = xb_add(&bar[XB_XSUB(b.x)], 1u);
        const unsigned gen = old / nloc;
        if (old + 1u == (gen + 1u) * nloc) {
            __builtin_amdgcn_fence(__ATOMIC_RELEASE, "agent");
            asm volatile("s_waitcnt vmcnt(0)" ::: "memory");
            const unsigned og = xb_add(&bar[XB_TOP], 1u);
            const unsigned tg = og / nx;
            if (og + 1u == (tg + 1u) * nx) xb_add(&bar[XB_TOPGEN], 1u);
            else XB_SPIN(xb_ld(&bar[XB_TOPGEN]) == tg, bar);
            __builtin_amdgcn_fence(__ATOMIC_ACQUIRE, "agent");
            xb_add(&bar[XB_XGEN(b.x)], 1u);
            asm volatile("s_waitcnt vmcnt(0)" ::: "memory");
        } else {
            XB_SPIN(xb_ld(&bar[XB_XGEN(b.x)]) == gen, bar);
            __builtin_amdgcn_fence(__ATOMIC_ACQUIRE, "agent");
            asm volatile("s_waitcnt vmcnt(0)" ::: "memory");
        }
    }
    __syncthreads();
}

struct Frame {
    LAS unsigned char* lds;
    volatile LAS unsigned* MISC;
    gu32* ctl;
    int tid, lane, wave, wave0;
    int G, bid;
};
#define REFRESH_IDS(F) do { int w_ = (F).wave0; asm volatile("" : "+s"(w_)); int l_ = lane_now(); asm volatile("" : "+v"(l_)); (F).wave = w_; (F).lane = l_; (F).tid = w_ * 64 + l_; \
    int b_ = blockIdx.x, g_ = gridDim.x; asm volatile("" : "+s"(b_), "+s"(g_)); (F).bid = b_; (F).G = g_; } while (0)

__device__ __forceinline__ float shfl_x(float v, int o, int lane) { return __int_as_float(__builtin_amdgcn_ds_bpermute((lane ^ o) << 2, __float_as_int(v))); }
__device__ __forceinline__ float wave_sum(float v, int lane) {
#pragma unroll
    for (int o = 1; o < 64; o <<= 1) v += shfl_x(v, o, lane);
    return v;
}
__device__ __forceinline__ void p0_transpose_item(const float* W, int K, int N, bf16* WT, LAS float* scr, int item, int lane) {
    const int nblk = N / 32, kb = item / nblk, nb = item % nblk, k0 = 64 * kb, n0 = 32 * nb;
#pragma unroll 8
    for (int i = 0; i < 32; ++i) { const int kk = 2 * i + (lane >> 5); scr[kk * 33 + (lane & 31)] = W[(size_t)(k0 + kk) * N + n0 + (lane & 31)]; }
    LDS_WAIT(); asm volatile("" ::: "memory");
    const int c = lane & 7;
#pragma unroll
    for (int j = 0; j < 4; ++j) { const int n = (lane >> 3) + 8 * j; const LAS float* s = scr + (8 * c) * 33 + n;
        v4u o; o.x = pk2(s[0 * 33], s[1 * 33]); o.y = pk2(s[2 * 33], s[3 * 33]); o.z = pk2(s[4 * 33], s[5 * 33]); o.w = pk2(s[6 * 33], s[7 * 33]);
        *(GAS v4u*)(WT + (size_t)(n0 + n) * K + k0 + 8 * c) = o; }
    LDS_WAIT(); asm volatile("" ::: "memory");
}

__device__ __forceinline__ void p0_prologue(Frame& F) {
    REFRESH_IDS(F);
    const KArgs ka = kargs(); const float* P_hlb = ka->in[IN_HLB]; float* P_lb = (float*)(ka->ws + WS_LB); const float* P_adaw = ka->in[IN_ADAW]; const float* P_adab = ka->in[IN_ADAB]; const float* P_c = ka->in[IN_C]; float* P_mod = (float*)(ka->ws + WS_MOD);
    const int gw = F.bid * NWAVES + F.wave, NGW = F.G * NWAVES;
    if (F.bid == 0) for (int j = F.tid; j < 1024; j += NWAVES * 64) { const float a0 = P_hlb[j], a1 = P_hlb[1024 + j]; P_lb[j] = 0.f; P_lb[1024 + j] = 1.0f / (1.0f + __expf(a0 - a1)); }
    constexpr int AITEMS = DEPTH * (3 * D / 8);
    for (int it = gw; it < AITEMS; it += NGW) {
        const int l = it / (3 * D / 8), n0 = (it % (3 * D / 8)) * 8;
        float acc[16][8];
#pragma unroll
        for (int b = 0; b < 16; ++b)
#pragma unroll
            for (int j = 0; j < 8; ++j) acc[b][j] = 0.f;
        for (int i = 0; i < 16; ++i) {
            const int k = F.lane + 64 * i;
            const float* wp = P_adaw + ((size_t)l * D + k) * (3 * D) + n0;
            const f32x4 w0 = *(const f32x4*)wp, w1 = *(const f32x4*)(wp + 4);
#pragma unroll
            for (int b = 0; b < 16; ++b) { const float cv = P_c[b * D + k], s = cv * __builtin_amdgcn_rcpf(1.0f + __expf(-cv));
#pragma unroll
                for (int j = 0; j < 4; ++j) { acc[b][j] += s * w0[j]; acc[b][4 + j] += s * w1[j]; } }
        }
        float* av = &acc[0][0];
#define TR_STEP(N, OFF) _Pragma("unroll") for (int i = 0; i < (N) / 2; ++i) { const bool up = (F.lane & (OFF)) != 0; const float keep = up ? av[i + (N) / 2] : av[i], send = up ? av[i] : av[i + (N) / 2]; av[i] = keep + shfl_x(send, (OFF), F.lane); }
        TR_STEP(128, 32) TR_STEP(64, 16) TR_STEP(32, 8) TR_STEP(16, 4) TR_STEP(8, 2) TR_STEP(4, 1)
#undef TR_STEP
        { const int b = F.lane >> 2, j = (F.lane & 3) * 2; const float* bp = P_adab + l * 3 * D + n0 + j;
          float* mp = P_mod + ((size_t)l * BATCH + b) * (3 * D) + n0 + j; mp[0] = av[0] + bp[0]; mp[1] = av[1] + bp[1]; }
    }
}

__device__ __forceinline__ void p1_fold_tile(Frame& F, const float* w_in, const float* pool_w, bf16* WIN, const int tile) {
    const int nb = tile & 1, kb = (tile >> 1) & 15, g = (tile >> 5) & 3, l = tile >> 7;
    LAS float* As = (LAS float*)(F.lds + RING_OFF);
    LAS float* Bs = As + 64 * 132;
    const int ty = F.tid >> 5, tx = F.tid & 31;
    float acc[4][4];
#pragma unroll
    for (int i = 0; i < 4; ++i)
#pragma unroll
        for (int j = 0; j < 4; ++j) acc[i][j] = 0.f;
    const float* Ag = w_in + ((size_t)l * D + kb * 64) * NZ + g * 256;
    const float* Bg = pool_w + ((size_t)(l * 4 + g) * 256) * 256 + nb * 128;
    for (int ch = 0; ch < 2; ++ch) {
        { const int r = F.tid >> 3, c4 = (F.tid & 7) * 16;
#pragma unroll
          for (int j = 0; j < 4; ++j) *(LAS f32x4*)(As + r * 132 + c4 + 4 * j) = *(const GAS f32x4*)(Ag + (size_t)r * NZ + ch * 128 + c4 + 4 * j); }
        { const int r = F.tid >> 2, c4 = (F.tid & 3) * 32;
#pragma unroll
          for (int j = 0; j < 8; ++j) *(LAS f32x4*)(Bs + r * 128 + c4 + 4 * j) = *(const GAS f32x4*)(Bg + (size_t)(ch * 128 + r) * 256 + c4 + 4 * j); }
        __syncthreads();
#pragma unroll 4
        for (int c = 0; c < 128; c += 4) {
            f32x4 a[4], bq[4];
#pragma unroll
            for (int i = 0; i < 4; ++i) a[i] = *(const LAS f32x4*)(As + (4 * ty + i) * 132 + c);
#pragma unroll
            for (int q = 0; q < 4; ++q) bq[q] = *(const LAS f32x4*)(Bs + (c + q) * 128 + 4 * tx);
#pragma unroll
            for (int i = 0; i < 4; ++i)
#pragma unroll
                for (int q = 0; q < 4; ++q)
#pragma unroll
                    for (int j = 0; j < 4; ++j) acc[i][j] += a[i][q] * bq[q][j];
        }
        __syncthreads();
    }
#pragma unroll
    for (int j = 0; j < 4; ++j) { v2u o; o.x = pk2(acc[0][j], acc[1][j]); o.y = pk2(acc[2][j], acc[3][j]);
        *(GAS v2u*)(WIN + ((size_t)l * NZ + g * 256 + nb * 128 + 4 * tx + j) * D + kb * 64 + 4 * ty) = o; }
}
__device__ __forceinline__ void p1_weights(Frame& F) {
    REFRESH_IDS(F);
    const KArgs ka = kargs(); const float* P_win = ka->in[IN_WIN]; const float* P_wout = ka->in[IN_WOUT]; const float* P_poolw = ka->in[IN_POOLW]; bf16* P_WIN = (bf16*)(ka->ws + WS_WIN); bf16* P_WOUT = (bf16*)(ka->ws + WS_WOUT);
    for (int tile = F.bid; tile < DEPTH * 4 * 16 * 2; tile += F.G) p1_fold_tile(F, P_win, P_poolw, P_WIN, tile);
    LAS float* scr = (LAS float*)(F.lds + RING_OFF + F.wave * 16384);
    const int gw = F.bid * NWAVES + F.wave, NGW = F.G * NWAVES;
    constexpr int NB_IN = (NZ - D) / 32;
    constexpr int I_IN = (D / 64) * NB_IN, I_OUT = (MIXW / 64) * (D / 32);
    constexpr int NITEMS = DEPTH * (I_IN + I_OUT);
    for (int it = gw; it < NITEMS; it += NGW) {
        int r = it;
        if (r < DEPTH * I_IN) { const int l = r / I_IN, q = r % I_IN, kb = q / NB_IN, nb = q % NB_IN + D / 32;
            p0_transpose_item(P_win + (size_t)l * D * NZ, D, NZ, P_WIN + (size_t)l * NZ * D, scr, kb * (NZ / 32) + nb, F.lane); continue; } r -= DEPTH * I_IN;
        { const int l = r / I_OUT; p0_transpose_item(P_wout + (size_t)l * MIXW * D, MIXW, D, P_WOUT + (size_t)l * D * MIXW, scr, r % I_OUT, F.lane); }
    }
}

__device__ __forceinline__ void rowpass(Frame& F, int l) {
    REFRESH_IDS(F);
    const KArgs ka = kargs(); const float* P_x = ka->in[IN_X]; float* P_out = ka->out; bf16* P_Y = (bf16*)(ka->ws + WS_Y); float* P_mod = (float*)(ka->ws + WS_MOD); const float* P_npost = ka->in[IN_NPOST]; const float* P_npre = ka->in[IN_NPRE]; bf16* P_XN = (bf16*)(ka->ws + WS_XN);
    const int gw = F.bid * NWAVES + F.wave, NGW = F.G * NWAVES;
    const int ln = l + 1;
    for (int m = gw; m < M; m += NGW) {
        const int b = m / SEQ;
        f32x4 v[4];
        const float* xin = (l <= 0 ? P_x : (const float*)P_out) + (size_t)m * D;
#pragma unroll
        for (int j = 0; j < 4; ++j) v[j] = *((const GAS f32x4*)xin + F.lane + 64 * j);
        if (l >= 0) {
            const GAS v2u* yr = (const GAS v2u*)(P_Y + (size_t)m * D) + F.lane;
            f32x4 y[4]; float ss = 0.f;
#pragma unroll
            for (int j = 0; j < 4; ++j) { const v2u w = yr[64 * j]; y[j] = (f32x4){bflo(w.x), bfhi(w.x), bflo(w.y), bfhi(w.y)}; ss += (y[j].x * y[j].x + y[j].y * y[j].y) + (y[j].z * y[j].z + y[j].w * y[j].w); }
            const float r = __builtin_amdgcn_rsqf(wave_sum(ss, F.lane) * (1.f / D) + EPS);
            const float* gate = P_mod + ((size_t)l * BATCH + b) * (3 * D) + 2 * D;
            const float* wp = P_npost + l * D;
#pragma unroll
            for (int j = 0; j < 4; ++j) { const f32x4 g = *((const f32x4*)gate + F.lane + 64 * j), w = *((const f32x4*)wp + F.lane + 64 * j); v[j] = v[j] + g * (y[j] * r * w);
                *((GAS f32x4*)(P_out + (size_t)m * D) + F.lane + 64 * j) = v[j]; }
        }
        if (ln < DEPTH) {
            float ss = 0.f;
#pragma unroll
            for (int j = 0; j < 4; ++j) ss += (v[j].x * v[j].x + v[j].y * v[j].y) + (v[j].z * v[j].z + v[j].w * v[j].w);
            const float r = __builtin_amdgcn_rsqf(wave_sum(ss, F.lane) * (1.f / D) + EPS);
            const float* shift = P_mod + ((size_t)ln * BATCH + b) * (3 * D); const float* scale = shift + D; const float* wp = P_npre + ln * D;
            GAS v2u* o = (GAS v2u*)(P_XN + (size_t)m * D) + F.lane;
#pragma unroll
            for (int j = 0; j < 4; ++j) { const f32x4 sh = *((const f32x4*)shift + F.lane + 64 * j), sc = *((const f32x4*)scale + F.lane + 64 * j), w = *((const f32x4*)wp + F.lane + 64 * j);
                const f32x4 h = v[j] * r * w * (sc + 1.0f) + sh; v2u pw; pw.x = pk2(h.x, h.y); pw.y = pk2(h.z, h.w); o[64 * j] = pw; }
        }
    }
}

__device__ __forceinline__ void pool_pass(Frame& F, const int l, const int first, const int count) {
    const KArgs ka = kargs(); const bf16* U = (const bf16*)(ka->ws + WS_U); bf16* MIXp = (bf16*)(ka->ws + WS_MIX); const float* ps = ka->in[IN_PSCALE] + l * 1024;
    constexpr int RUN = 64;
    const int c8 = (F.tid & 127) * 8, w = 2 << (c8 >> 8);
    f32x4 sc0 = *(const f32x4*)(ps + c8), sc1 = *(const f32x4*)(ps + c8 + 4);
    for (int it = first; it < M / RUN / 4; it += count) {
        const int t0 = (it * 4 + (F.tid >> 7)) * RUN, tp0 = t0 & (SEQ - 1);
        const GAS v4u* up = (const GAS v4u*)(U + (size_t)t0 * D + c8);
        GAS v4u* gp = (GAS v4u*)(MIXp + (size_t)t0 * MIXW + c8);
        float s[8];
#pragma unroll
        for (int e = 0; e < 8; ++e) s[e] = 0.f;
        for (int i = 1; i <= 16; ++i) if (i <= w && tp0 - i >= 0) { const v4u x = up[-(long)i * (D / 8)];
            s[0] += bflo(x.x); s[1] += bfhi(x.x); s[2] += bflo(x.y); s[3] += bfhi(x.y); s[4] += bflo(x.z); s[5] += bfhi(x.z); s[6] += bflo(x.w); s[7] += bfhi(x.w); }
#pragma unroll 8
        for (int r = 0; r < RUN; ++r) {
            const int tp = tp0 + r; const bool sub = tp >= w;
            const v4u x = up[(long)r * (D / 8)], gq = gp[(long)r * (MIXW / 8)];
            v4u y = (v4u){0u, 0u, 0u, 0u}; if (sub) y = up[(long)(r - w) * (D / 8)];
            const float xv[8] = {bflo(x.x), bfhi(x.x), bflo(x.y), bfhi(x.y), bflo(x.z), bfhi(x.z), bflo(x.w), bfhi(x.w)};
            const float yv[8] = {bflo(y.x), bfhi(y.x), bflo(y.y), bfhi(y.y), bflo(y.z), bfhi(y.z), bflo(y.w), bfhi(y.w)};
            const float gv[8] = {bflo(gq.x), bfhi(gq.x), bflo(gq.y), bfhi(gq.y), bflo(gq.z), bfhi(gq.z), bflo(gq.w), bfhi(gq.w)};
            const float inv = 1.0f / (float)(tp + 1 < w ? tp + 1 : w);
            float o[8];
#pragma unroll
            for (int e = 0; e < 8; ++e) { s[e] += xv[e] - yv[e]; o[e] = (s[e] * inv - xv[e]) * (e < 4 ? sc0[e] : sc1[e - 4]) * gv[e]; }
            v4u ov; ov.x = pk2(o[0], o[1]); ov.y = pk2(o[2], o[3]); ov.z = pk2(o[4], o[5]); ov.w = pk2(o[6], o[7]);
            gp[(long)r * (MIXW / 8)] = ov;
        }
    }
}

__device__ __forceinline__ void hgrn_naive(Frame& F, int l) {
    REFRESH_IDS(F);
    const KArgs ka = kargs(); const float* P_hnw = ka->in[IN_HNW]; bf16* P_Q = (bf16*)(ka->ws + WS_Q); bf16* P_LF = (bf16*)(ka->ws + WS_LF); bf16* P_V = (bf16*)(ka->ws + WS_V); bf16* P_MIX = (bf16*)(ka->ws + WS_MIX);
    LAS float* qs = (LAS float*)(F.lds + RING_OFF);
    LAS float* fs = qs + 2048; LAS float* ks = fs + 2048; LAS float* vs = ks + 2048;
    LAS float* part = vs + 2048;
    const int v = F.tid & 127, kg = F.tid >> 7;
    const float* nw = P_hnw + l * HD;
    for (int unit = F.bid; unit < BATCH * NHEAD; unit += F.G) {
        const int b = unit / NHEAD, h = unit % NHEAD;
        float S[32];
#pragma unroll
        for (int i = 0; i < 32; ++i) S[i] = 0.f;
        const size_t rb = (size_t)b * SEQ;
        for (int t0 = 0; t0 < SEQ; t0 += 16) {
            { const int tt = F.tid >> 5, ch = (F.tid & 31) * 4; const size_t off = (rb + t0 + tt) * D + h * HD + ch;
              const v2u qw = *(const GAS v2u*)(P_Q + off), lw = *(const GAS v2u*)(P_LF + off), vw = *(const GAS v2u*)(P_V + off);
              const float lf[4] = {h2f_lo(lw.x), h2f_hi(lw.x), h2f_lo(lw.y), h2f_hi(lw.y)};
              const float qq[4] = {bflo(qw.x), bfhi(qw.x), bflo(qw.y), bfhi(qw.y)}, vv[4] = {bflo(vw.x), bfhi(vw.x), bflo(vw.y), bfhi(vw.y)};
#pragma unroll
              for (int e = 0; e < 4; ++e) { const float f = __expf(lf[e]); fs[tt * 128 + ch + e] = f; ks[tt * 128 + ch + e] = 1.0f - f; qs[tt * 128 + ch + e] = qq[e]; vs[tt * 128 + ch + e] = vv[e]; } }
            __syncthreads();
            for (int tt = 0; tt < 16; ++tt) {
                const float vv = vs[tt * 128 + v]; float po = 0.f;
#pragma unroll
                for (int i = 0; i < 32; ++i) { const float f = fs[tt * 128 + kg * 32 + i], k = ks[tt * 128 + kg * 32 + i], q = qs[tt * 128 + kg * 32 + i]; S[i] = f * S[i] + k * vv; po += q * S[i]; }
                part[(tt * 4 + kg) * 128 + v] = po;
            }
            __syncthreads();
#pragma unroll
            for (int e = 0; e < 2; ++e) { const int tt = F.wave * 2 + e;
                float o0 = 0.f, o1 = 0.f;
#pragma unroll
                for (int k4 = 0; k4 < 4; ++k4) { o0 += part[(tt * 4 + k4) * 128 + F.lane]; o1 += part[(tt * 4 + k4) * 128 + 64 + F.lane]; }
                const float r = __builtin_amdgcn_rsqf(wave_sum(o0 * o0 + o1 * o1, F.lane) * (1.f / HD) + EPS);
                GAS bf16* gp = (GAS bf16*)(P_MIX + (rb + t0 + tt) * MIXW + D + h * HD);
                const float g0 = __uint_as_float((unsigned)gp[F.lane] << 16), g1 = __uint_as_float((unsigned)gp[64 + F.lane] << 16);
                gp[F.lane] = (bf16)f2bf(o0 * r * nw[F.lane] * g0); gp[64 + F.lane] = (bf16)f2bf(o1 * r * nw[64 + F.lane] * g1); }
        }
        __syncthreads();
    }
}

namespace hg {
typedef short bf16x8 __attribute__((ext_vector_type(8)));
typedef short s16x4 __attribute__((ext_vector_type(4)));
typedef float f32x4 __attribute__((ext_vector_type(4)));
typedef float f32x2 __attribute__((ext_vector_type(2)));
typedef unsigned u32x2 __attribute__((ext_vector_type(2)));
typedef unsigned u32x4 __attribute__((ext_vector_type(4)));
typedef __bf16 bf16x2_t __attribute__((ext_vector_type(2)));
constexpr int L_QT = 0, L_QB = 16384, L_K1 = 24576, L_K2 = 32768, L_KH = 49152  , L_V = 67584  , L_P = 86016  ,
              L_DEC = 92160  , L_TOT = 92672  , L_SSQ = 96768  , L_RAWQ = 99328  , L_RAWL = 115712  , L_END = 132096;
constexpr int L_PATCH = 0, PATCH_BYTES = 5120, PSTR = 80;
constexpr int VSTR = 288;
__device__ __forceinline__ unsigned cvtpk(float lo, float hi) { f32x2 v = {lo, hi}; bf16x2_t b = __builtin_convertvector(v, bf16x2_t); return __builtin_bit_cast(unsigned, b); }
__device__ __forceinline__ int perm32x(int x) { return 8 * ((x >> 2) & 3) + 4 * (x >> 4) + (x & 3); }
__device__ __forceinline__ bf16x8 ld128(const LAS unsigned char* p) { return *(const LAS bf16x8*)p; }
__device__ __forceinline__ s16x4 ldtr(const LAS unsigned char* p) { typedef short v4i16_t __attribute__((ext_vector_type(4))); return __builtin_bit_cast(s16x4, __builtin_amdgcn_ds_read_tr16_b64_v4i16((LAS v4i16_t*)p)); }
__device__ __forceinline__ bf16x8 cat(s16x4 a, s16x4 b) { return (bf16x8){a[0], a[1], a[2], a[3], b[0], b[1], b[2], b[3]}; }
#define HG_DPP(v, ctrl) __int_as_float(__builtin_amdgcn_update_dpp(0, __float_as_int(v), (ctrl), 0xf, 0xf, true))
__device__ __forceinline__ float row16_sum(float v) {
    v += HG_DPP(v, 0xB1); v += HG_DPP(v, 0x4E); v += HG_DPP(v, 0x141); v += HG_DPP(v, 0x140); return v;
}
#ifdef PROBE_SEG
#define HG_SEG(k) do { if (probe) { const unsigned long long now_ = __builtin_amdgcn_s_memrealtime(); volatile LAS unsigned long long* pa_ = (volatile LAS unsigned long long*)(lds + 141312 + 2048); pa_[k] += now_ - pa_[15]; pa_[15] = now_; } } while (0)
#else
#define HG_SEG(k) do { } while (0)
#endif
#define HG_LBAR() do { asm volatile("s_waitcnt lgkmcnt(0)" ::: "memory"); __builtin_amdgcn_s_barrier(); asm volatile("" ::: "memory"); } while (0)

__device__ __forceinline__ void hgrn_unit(LAS unsigned char* lds, const int tid, const int lane, const int wave, const int b, const int h,
                                          const bf16* Qg, const bf16* LFg, const bf16* Vg, bf16* MIXg, const float* nw) {
    const int c16 = lane & 15, g = lane >> 4, cp = lane, tg = wave;
    const int c0 = 2 * cp, pcl = perm32x(c0 & 31), pcg = c0 >> 5;
    const size_t rowbase = (size_t)b * SEQ;
    const char* Qd = (const char*)(Qg + (rowbase + 8 * wave + (lane >> 4)) * D + h * HD) + (lane & 15) * 16;
    const char* Ld = (const char*)(LFg + (rowbase + 8 * wave + (lane >> 4)) * D + h * HD) + (lane & 15) * 16;
    const GAS u32x4* Vp = (const GAS u32x4*)(Vg + (rowbase + (tid >> 3)) * D + h * HD + (tid & 7) * 16);
    GAS u32x4* Gq = (GAS u32x4*)(MIXg + (rowbase + lane) * MIXW + D + h * HD + 16 * wave);
    const float nwv = nw[16 * wave + c16];
    const int ew = ((tg >> 1) * 4 + pcg) * 1024 + (((tg & 1) * 512 + pcl * 2) ^ ((tg & 1) * 32));
    const int ewb = (((tg & 3) >> 1) * 4 + pcg) * 1024 + (((tg & 1) * 512 + pcl * 2) ^ ((tg & 1) * 32));
    const int ekh = (8 * tg) * VSTR + c0 * 2;
    const int evw = (tid >> 3) * VSTR + (tid & 7) * 32;
    const int lo = (c16 * 64 + 16 * g) ^ ((c16 >> 3) << 5);
    const int trq = (c16 >> 2) * VSTR + (c16 & 3) * 8 + (4 * g) * VSTR;
    f32x4 S[8];
#pragma unroll
    for (int i = 0; i < 8; ++i) S[i] = (f32x4){0.f, 0.f, 0.f, 0.f};
#ifdef PROBE_SEG
    const bool probe = (blockIdx.x == 0 && tid == 0);
    if (probe) ((volatile LAS unsigned long long*)(lds + 141312 + 2048))[15] = __builtin_amdgcn_s_memrealtime();
#endif
    if (wave == 0) { *(LAS u32x2*)(lds + L_P + 0 * 1024 + lane * 16 + 8) = (u32x2){0u, 0u}; *(LAS u32x2*)(lds + L_P + 3 * 1024 + lane * 16 + 8) = (u32x2){0u, 0u}; }
    u32x4 vr[2], gq[2];
#define HG_LOADS(c) do { _Pragma("unroll") for (int j = 0; j < 2; ++j) { \
        __builtin_amdgcn_global_load_lds((const unsigned*)(Qd + ((size_t)(c) * 64 + 4 * j) * (D * 2)), (LAS unsigned*)(lds + L_RAWQ + (8 * wave + 4 * j) * 256), 16, 0, 0); \
        __builtin_amdgcn_global_load_lds((const unsigned*)(Ld + ((size_t)(c) * 64 + 4 * j) * (D * 2)), (LAS unsigned*)(lds + L_RAWL + (8 * wave + 4 * j) * 256), 16, 0, 0); } \
        vr[0] = Vp[(size_t)(c) * 64 * (D / 8)]; vr[1] = Vp[(size_t)(c) * 64 * (D / 8) + 1]; } while (0)
    HG_LOADS(0);
#pragma unroll 1
    for (int c = 0; c < SEQ / 64; ++c) {
        asm volatile("s_waitcnt vmcnt(0)" ::: "memory");
        *(LAS u32x4*)(lds + L_V + evw) = vr[0]; *(LAS u32x4*)(lds + L_V + evw + 16) = vr[1];
        HG_LBAR();
        unsigned qr[8]; float f0[8], f1[8], P0[8], P1[8]; float a0 = 0.f, a1 = 0.f, r0 = 1.f, r1 = 1.f;
#pragma unroll
        for (int i = 0; i < 8; ++i) { const unsigned lw = *(const LAS unsigned*)(lds + L_RAWL + (8 * tg + i) * 256 + cp * 4); qr[i] = *(const LAS unsigned*)(lds + L_RAWQ + (8 * tg + i) * 256 + cp * 4);
            const float l0 = h2f_lo(lw), l1 = h2f_hi(lw); a0 += l0; a1 += l1; f0[i] = __expf(l0); f1[i] = __expf(l1); r0 *= f0[i]; r1 *= f1[i]; P0[i] = r0; P1[i] = r1; }
        *(LAS f32x2*)(lds + L_TOT + (tg * 128 + c0) * 4) = (f32x2){a0, a1};
        HG_LBAR();
        HG_SEG(0);
        float off0 = 0.f, off1 = 0.f, R0 = 0.f, R1 = 0.f, L0 = 0.f, L1 = 0.f;
#pragma unroll
        for (int j = 0; j < 8; ++j) { const f32x2 t = *(const LAS f32x2*)(lds + L_TOT + (j * 128 + c0) * 4);
            if (j < tg) { off0 += t.x; off1 += t.y; } if (j < 4) { R0 += t.x; R1 += t.y; } L0 += t.x; L1 += t.y; }
        const float eR0 = __expf(R0), eR1 = __expf(R1), eLR0 = __expf(L0 - R0), eLR1 = __expf(L1 - R1);
        if (tg == 0) *(LAS f32x2*)(lds + L_DEC + c0 * 4) = (f32x2){__expf(L0), __expf(L1)};
        constexpr float BIG = 5.5e34f;
        if (tg >= 4) {
            const float b0 = __expf(off0 - R0), b1 = __expf(off1 - R1);
#pragma unroll
            for (int i = 0; i < 8; ++i) {
                const float q0 = bflo(qr[i]), q1 = bfhi(qr[i]), k0 = 1.0f - f0[i], k1 = 1.0f - f1[i];
                const float e10 = b0 * P0[i], e11 = b1 * P1[i], e20 = fminf(__builtin_amdgcn_rcpf(e10), BIG), e21 = fminf(__builtin_amdgcn_rcpf(e11), BIG);
                *(LAS unsigned*)(lds + L_QT + ew + 64 * i) = cvtpk(q0 * e10 * eR0, q1 * e11 * eR1);
                *(LAS unsigned*)(lds + L_QB + ewb + 64 * i) = cvtpk(q0 * e10, q1 * e11);
                *(LAS unsigned*)(lds + L_K2 + ew + 64 * i) = cvtpk(k0 * e20, k1 * e21);
                *(LAS unsigned*)(lds + L_KH + ekh + VSTR * i) = cvtpk(k0 * e20 * eLR0, k1 * e21 * eLR1);
            }
        } else {
            const float b0 = __expf(off0), b1 = __expf(off1);
#pragma unroll
            for (int i = 0; i < 8; ++i) {
                const float q0 = bflo(qr[i]), q1 = bfhi(qr[i]), k0 = 1.0f - f0[i], k1 = 1.0f - f1[i];
                const float e00 = b0 * P0[i], e01 = b1 * P1[i], e30 = fminf(__builtin_amdgcn_rcpf(e00), BIG), e31 = fminf(__builtin_amdgcn_rcpf(e01), BIG);
                const float k20 = k0 * e30 * eR0, k21 = k1 * e31 * eR1;
                *(LAS unsigned*)(lds + L_QT + ew + 64 * i) = cvtpk(q0 * e00, q1 * e01);
                *(LAS unsigned*)(lds + L_K1 + ewb + 64 * i) = cvtpk(k0 * e30, k1 * e31);
                *(LAS unsigned*)(lds + L_K2 + ew + 64 * i) = cvtpk(k20, k21);
                *(LAS unsigned*)(lds + L_KH + ekh + VSTR * i) = cvtpk(k20 * eLR0, k21 * eLR1);
            }
        }
        HG_LBAR();
        HG_SEG(1);
        if (c + 1 < SEQ / 64) HG_LOADS(c + 1);
        gq[0] = Gq[(size_t)c * 64 * (MIXW / 8)]; gq[1] = Gq[(size_t)c * 64 * (MIXW / 8) + 1];
#pragma unroll
        for (int rep = 0; rep < 2; ++rep) {
            const int ti = wave + 8 * rep;
            if (ti < 10) {
                const int tb = ti < 1 ? 0 : ti < 3 ? 1 : ti < 6 ? 2 : 3, sb = ti - (tb == 0 ? 0 : tb == 1 ? 1 : tb == 2 ? 3 : 6);
                const LAS unsigned char* kb = lds + (tb < 2 ? L_K1 : L_K2) + sb * 4096 + lo;
                const LAS unsigned char* qb = lds + (tb < 2 ? L_QT + tb * 4096 : L_QB + (tb - 2) * 4096) + lo;
                f32x4 acc = (f32x4){0.f, 0.f, 0.f, 0.f};
#pragma unroll
                for (int ks = 0; ks < 4; ++ks) acc = __builtin_amdgcn_mfma_f32_16x16x32_bf16(ld128(kb + ks * 1024), ld128(qb + ks * 1024), acc, 0, 0, 0);
                if (sb == tb) {
#pragma unroll
                    for (int r = 0; r < 4; ++r) acc[r] = (4 * g + r <= c16) ? acc[r] : 0.f;
                }
                const int fi = tb < 2 ? tb : 2 * tb - 2 + (sb >> 1);
                *(LAS u32x2*)(lds + L_P + fi * 1024 + lane * 16 + 8 * (sb & 1)) = (u32x2){cvtpk(acc[0], acc[1]), cvtpk(acc[2], acc[3])};
            }
        }
        HG_SEG(2);
        bf16x8 vb[2];
#pragma unroll
        for (int kk = 0; kk < 2; ++kk) { const LAS unsigned char* vp = lds + L_V + trq + (32 * kk) * VSTR + (16 * wave) * 2; vb[kk] = cat(ldtr(vp), ldtr(vp + 16 * VSTR)); }
        f32x4 o[4];
#pragma unroll
        for (int tb = 0; tb < 4; ++tb) o[tb] = (f32x4){0.f, 0.f, 0.f, 0.f};
#pragma unroll
        for (int kk = 0; kk < 4; ++kk) {
            const u32x4 sw = (u32x4){cvtpk(S[2 * kk][0], S[2 * kk][1]), cvtpk(S[2 * kk][2], S[2 * kk][3]), cvtpk(S[2 * kk + 1][0], S[2 * kk + 1][1]), cvtpk(S[2 * kk + 1][2], S[2 * kk + 1][3])};
            const bf16x8 sbf = __builtin_bit_cast(bf16x8, sw);
#pragma unroll
            for (int tb = 0; tb < 4; ++tb) o[tb] = __builtin_amdgcn_mfma_f32_16x16x32_bf16(ld128(lds + L_QT + (tb * 4 + kk) * 1024 + lo), sbf, o[tb], 0, 0, 0);
        }
#pragma unroll
        for (int dkb = 0; dkb < 8; ++dkb) {
            const f32x4 dv = *(const LAS f32x4*)(lds + L_DEC + (16 * dkb + 4 * g) * 4);
            f32x4 s = S[dkb] * dv;
#pragma unroll
            for (int kk = 0; kk < 2; ++kk) { const LAS unsigned char* kp = lds + L_KH + trq + (32 * kk) * VSTR + (16 * dkb) * 2;
                s = __builtin_amdgcn_mfma_f32_16x16x32_bf16(cat(ldtr(kp), ldtr(kp + 16 * VSTR)), vb[kk], s, 0, 0, 0); }
            S[dkb] = s;
        }
        HG_LBAR();
        HG_SEG(3);
        o[0] = __builtin_amdgcn_mfma_f32_16x16x32_bf16(ld128(lds + L_P + 0 * 1024 + lane * 16), vb[0], o[0], 0, 0, 0);
        o[1] = __builtin_amdgcn_mfma_f32_16x16x32_bf16(ld128(lds + L_P + 1 * 1024 + lane * 16), vb[0], o[1], 0, 0, 0);
        o[2] = __builtin_amdgcn_mfma_f32_16x16x32_bf16(ld128(lds + L_P + 2 * 1024 + lane * 16), vb[0], o[2], 0, 0, 0);
        o[2] = __builtin_amdgcn_mfma_f32_16x16x32_bf16(ld128(lds + L_P + 3 * 1024 + lane * 16), vb[1], o[2], 0, 0, 0);
        o[3] = __builtin_amdgcn_mfma_f32_16x16x32_bf16(ld128(lds + L_P + 4 * 1024 + lane * 16), vb[0], o[3], 0, 0, 0);
        o[3] = __builtin_amdgcn_mfma_f32_16x16x32_bf16(ld128(lds + L_P + 5 * 1024 + lane * 16), vb[1], o[3], 0, 0, 0);
#pragma unroll
        for (int tb = 0; tb < 4; ++tb) { f32x4 q2 = o[tb] * o[tb];
#pragma unroll
            for (int r = 0; r < 4; ++r) q2[r] = row16_sum(q2[r]);
            if (c16 == 0) *(LAS f32x4*)(lds + L_SSQ + (wave * 64 + 16 * tb + 4 * g) * 4) = q2; }
        HG_LBAR();
        HG_SEG(4);
        { float ss = 0.f;
#pragma unroll
          for (int w2 = 0; w2 < 8; ++w2) ss += *(const LAS float*)(lds + L_SSQ + (w2 * 64 + lane) * 4);
          const float rsv = __builtin_amdgcn_rsqf(ss * (1.0f / HD) + EPS);
          LAS unsigned char* patch = lds + L_PATCH + wave * PATCH_BYTES;
#pragma unroll
          for (int tb = 0; tb < 4; ++tb)
#pragma unroll
              for (int r = 0; r < 4; ++r) *(LAS float*)(patch + (16 * tb + 4 * g + r) * PSTR + c16 * 4) = o[tb][r] * nwv;
          asm volatile("s_waitcnt lgkmcnt(0)" ::: "memory");
          f32x4 pv[4];
#pragma unroll
          for (int j = 0; j < 4; ++j) pv[j] = *(const LAS f32x4*)(patch + lane * PSTR + 16 * j) * rsv;
          u32x4 o0, o1;
          o0.x = pk2(pv[0][0] * bflo(gq[0].x), pv[0][1] * bfhi(gq[0].x)); o0.y = pk2(pv[0][2] * bflo(gq[0].y), pv[0][3] * bfhi(gq[0].y));
          o0.z = pk2(pv[1][0] * bflo(gq[0].z), pv[1][1] * bfhi(gq[0].z)); o0.w = pk2(pv[1][2] * bflo(gq[0].w), pv[1][3] * bfhi(gq[0].w));
          o1.x = pk2(pv[2][0] * bflo(gq[1].x), pv[2][1] * bfhi(gq[1].x)); o1.y = pk2(pv[2][2] * bflo(gq[1].y), pv[2][3] * bfhi(gq[1].y));
          o1.z = pk2(pv[3][0] * bflo(gq[1].z), pv[3][1] * bfhi(gq[1].z)); o1.w = pk2(pv[3][2] * bflo(gq[1].w), pv[3][3] * bfhi(gq[1].w));
          Gq[(size_t)c * 64 * (MIXW / 8)] = o0; Gq[(size_t)c * 64 * (MIXW / 8) + 1] = o1; }
        HG_SEG(5);
    }
#undef HG_LOADS
    HG_LBAR();
}
}


namespace hg2 {
typedef short bf16x8 __attribute__((ext_vector_type(8)));
typedef short s16x4 __attribute__((ext_vector_type(4)));
typedef float f32x4 __attribute__((ext_vector_type(4)));
typedef float f32x2 __attribute__((ext_vector_type(2)));
typedef unsigned u32x2 __attribute__((ext_vector_type(2)));
typedef unsigned u32x4 __attribute__((ext_vector_type(4)));
typedef __bf16 bf16x2_t __attribute__((ext_vector_type(2)));
constexpr int VSTR = 288;
constexpr int SET_BYTES = 16384 + 16384 + 64 * VSTR + 3 * 512;
constexpr int S_QB = 0, S_K2 = 16384, S_V = 32768, S_ER = 32768 + 64 * VSTR, S_ELR = S_ER + 512, S_DEC = S_ER + 1024;
constexpr int L_SET0 = 0, L_SET1 = SET_BYTES;
constexpr int OSTR = 528;
constexpr int L_O = 2 * SET_BYTES, L_SSQ = L_O + 64 * OSTR  , L_NW = L_SSQ + 1024  , L_END = L_NW + 512;
static_assert(L_END <= 141312, "HGRN LDS map must stay below the LDS control words");
__device__ __forceinline__ unsigned cvtpk(float lo, float hi) { f32x2 v = {lo, hi}; bf16x2_t b = __builtin_convertvector(v, bf16x2_t); return __builtin_bit_cast(unsigned, b); }
__device__ __forceinline__ bf16x8 ld128(const LAS unsigned char* p) { return *(const LAS bf16x8*)p; }
__device__ __forceinline__ s16x4 ld64(const LAS unsigned char* p) { return *(const LAS s16x4*)p; }
__device__ __forceinline__ s16x4 ldtr(const LAS unsigned char* p) { typedef short v4i16_t __attribute__((ext_vector_type(4))); return __builtin_bit_cast(s16x4, __builtin_amdgcn_ds_read_tr16_b64_v4i16((LAS v4i16_t*)p)); }
__device__ __forceinline__ bf16x8 cat(s16x4 a, s16x4 b) { return (bf16x8){a[0], a[1], a[2], a[3], b[0], b[1], b[2], b[3]}; }
#define HG_DPP(v, ctrl) __int_as_float(__builtin_amdgcn_update_dpp(0, __float_as_int(v), (ctrl), 0xf, 0xf, true))
__device__ __forceinline__ float row16_sum(float v) { v += HG_DPP(v, 0xB1); v += HG_DPP(v, 0x4E); v += HG_DPP(v, 0x141); v += HG_DPP(v, 0x140); return v; }
#define HG_BAR() do { asm volatile("s_waitcnt lgkmcnt(0)" ::: "memory"); __builtin_amdgcn_s_barrier(); asm volatile("" ::: "memory"); } while (0)
#define MFMA16(a, b, c) __builtin_amdgcn_mfma_f32_16x16x32_bf16((a), (b), (c), 0, 0, 0)

__device__ __forceinline__ void hgrn_unit(LAS unsigned char* lds, const int wave, const int b, const int h,
                                          const bf16* Qg, const bf16* LFg, const bf16* Vg, bf16* MIXg, const float* nw) {
    const size_t rowbase = (size_t)b * SEQ;
    constexpr int NCH = SEQ / 64;
    const int lane = lane_now();
    if (wave < 2) *(LAS float*)(lds + L_NW + (wave * 64 + lane) * 4) = nw[wave * 64 + lane];
    if (wave < 4) {
        int ln_ = lane; asm volatile("" : "+v"(ln_));
        const int c16 = ln_ & 15, g = ln_ >> 4, j = wave;
        const int lo = (c16 * 64 + 16 * g) ^ ((c16 >> 3) << 5);
        const int lo8a = (c16 * 64 + 8 * g) ^ ((c16 >> 3) << 5), lo8b = (c16 * 64 + 32 + 8 * g) ^ ((c16 >> 3) << 5);
        const int q_ = c16 >> 2, p_ = c16 & 3;
        const int trv = (4 * g + q_) * VSTR + (32 * j + 4 * p_) * 2;
        const int trk = (4 * g + q_) * 64 + ((8 * p_) ^ ((g >> 1) << 5));
        f32x4 S[8][2];
#pragma unroll
        for (int m = 0; m < 8; ++m) { S[m][0] = (f32x4){0.f, 0.f, 0.f, 0.f}; S[m][1] = (f32x4){0.f, 0.f, 0.f, 0.f}; }
        HG_BAR();
#pragma unroll 1
        for (int k = 0; k < NCH; ++k) {
            const LAS unsigned char* set = lds + ((k & 1) ? L_SET1 : L_SET0);
            u32x2 pf[6][2];
            pf[0][1] = (u32x2){0u, 0u}; pf[3][1] = (u32x2){0u, 0u};
#pragma unroll
            for (int tb = 0; tb < 4; ++tb) {
                bf16x8 qf[4];
#pragma unroll
                for (int ks = 0; ks < 4; ++ks) qf[ks] = ld128(set + S_QB + (tb * 4 + ks) * 1024 + lo);
#pragma unroll
                for (int sb = 0; sb <= tb; ++sb) {
                    f32x4 acc = (f32x4){0.f, 0.f, 0.f, 0.f};
#pragma unroll
                    for (int ks = 0; ks < 4; ++ks) acc = MFMA16(ld128(set + S_K2 + (sb * 4 + ks) * 1024 + lo), qf[ks], acc);
                    if (sb == tb) {
#pragma unroll
                        for (int r = 0; r < 4; ++r) acc[r] = (4 * g + r <= c16) ? acc[r] : 0.f;
                    }
                    pf[tb < 2 ? tb : 2 * tb - 2 + (sb >> 1)][sb & 1] = (u32x2){cvtpk(acc[0], acc[1]), cvtpk(acc[2], acc[3])};
                }
            }
            bf16x8 vf[2][2];
#pragma unroll
            for (int kk = 0; kk < 2; ++kk)
#pragma unroll
                for (int dvb = 0; dvb < 2; ++dvb) { const LAS unsigned char* vp = set + S_V + trv + (32 * kk) * VSTR + (16 * dvb) * 2; vf[kk][dvb] = cat(ldtr(vp), ldtr(vp + 16 * VSTR)); }
            f32x4 o[4][2];
#pragma unroll
            for (int tb = 0; tb < 4; ++tb)
#pragma unroll
                for (int dvb = 0; dvb < 2; ++dvb) {
                    const int f0 = tb < 2 ? tb : 2 * tb - 2;
                    const u32x4 w0 = (u32x4){pf[f0][0].x, pf[f0][0].y, pf[f0][1].x, pf[f0][1].y};
                    f32x4 a = MFMA16(__builtin_bit_cast(bf16x8, w0), vf[0][dvb], ((f32x4){0.f, 0.f, 0.f, 0.f}));
                    if (tb >= 2) { const u32x4 w1 = (u32x4){pf[f0 + 1][0].x, pf[f0 + 1][0].y, pf[f0 + 1][1].x, pf[f0 + 1][1].y}; a = MFMA16(__builtin_bit_cast(bf16x8, w1), vf[1][dvb], a); }
                    o[tb][dvb] = a;
                }
#pragma unroll
            for (int kk = 0; kk < 4; ++kk) {
                const f32x4 e0 = *(const LAS f32x4*)(set + S_ER + (32 * kk + 4 * g) * 4), e1 = *(const LAS f32x4*)(set + S_ER + (32 * kk + 16 + 4 * g) * 4);
                bf16x8 sf[2];
#pragma unroll
                for (int dvb = 0; dvb < 2; ++dvb) { const f32x4 s0 = S[2 * kk][dvb] * e0, s1 = S[2 * kk + 1][dvb] * e1;
                    const u32x4 sw = (u32x4){cvtpk(s0[0], s0[1]), cvtpk(s0[2], s0[3]), cvtpk(s1[0], s1[1]), cvtpk(s1[2], s1[3])}; sf[dvb] = __builtin_bit_cast(bf16x8, sw); }
#pragma unroll
                for (int tb = 0; tb < 4; ++tb) { const bf16x8 af = cat(ld64(set + S_QB + (tb * 4 + kk) * 1024 + lo8a), ld64(set + S_QB + (tb * 4 + kk) * 1024 + lo8b));
                    o[tb][0] = MFMA16(af, sf[0], o[tb][0]); o[tb][1] = MFMA16(af, sf[1], o[tb][1]); }
            }
#pragma unroll
            for (int m = 0; m < 8; ++m) {
                f32x4 t0 = (f32x4){0.f, 0.f, 0.f, 0.f}, t1 = (f32x4){0.f, 0.f, 0.f, 0.f};
#pragma unroll
                for (int kk = 0; kk < 2; ++kk) {
                    const LAS unsigned char* k0 = set + S_K2 + ((2 * kk) * 4 + (m >> 1)) * 1024 + trk + 32 * (m & 1) * (1 - 2 * (g >> 1));
                    const bf16x8 af = cat(ldtr(k0), ldtr(k0 + 4096));
                    t0 = MFMA16(af, vf[kk][0], t0); t1 = MFMA16(af, vf[kk][1], t1); }
                const f32x4 dc = *(const LAS f32x4*)(set + S_DEC + (16 * m + 4 * g) * 4), el = *(const LAS f32x4*)(set + S_ELR + (16 * m + 4 * g) * 4);
                S[m][0] = S[m][0] * dc + t0 * el; S[m][1] = S[m][1] * dc + t1 * el;
            }
            HG_BAR();
#pragma unroll
            for (int tb = 0; tb < 4; ++tb) {
                f32x4 q2 = o[tb][0] * o[tb][0] + o[tb][1] * o[tb][1];
#pragma unroll
                for (int r = 0; r < 4; ++r) { q2[r] = row16_sum(q2[r]);
                    *(LAS float*)(lds + L_O + (16 * tb + 4 * g + r) * OSTR + (32 * j + c16) * 4) = o[tb][0][r];
                    *(LAS float*)(lds + L_O + (16 * tb + 4 * g + r) * OSTR + (32 * j + 16 + c16) * 4) = o[tb][1][r]; }
                if (c16 == 0) *(LAS f32x4*)(lds + L_SSQ + (j * 64 + 16 * tb + 4 * g) * 4) = q2;
            }
            HG_BAR();
        }
        HG_BAR();
    } else {
        int ln_ = lane; asm volatile("" : "+v"(ln_));
        const int pw = wave - 4, ptid = (wave - 4) * 64 + ln_, tgq = ln_ >> 4, cpq = ln_ & 15;
        const int ch0 = 32 * pw + 2 * cpq;
        const GAS unsigned* Qp = (const GAS unsigned*)(Qg + (rowbase + 16 * tgq) * D + h * HD + ch0);
        const GAS unsigned* Lp = (const GAS unsigned*)(LFg + (rowbase + 16 * tgq) * D + h * HD + ch0);
        const GAS u32x4* Vp = (const GAS u32x4*)(Vg + (rowbase + (ptid >> 2)) * D + h * HD + (ptid & 3) * 32);
        GAS u32x4* Gq = (GAS u32x4*)(MIXg + (rowbase + (ptid >> 2)) * MIXW + D + h * HD + (ptid & 3) * 32);
        const int ew = (tgq * 4 + pw) * 1024;
        const int evw = (ptid >> 2) * VSTR + (ptid & 3) * 64;
        unsigned qr[16], lr[16]; u32x4 vr[4], gq[4];
#define HG_LD(c) do { _Pragma("unroll") for (int i = 0; i < 16; ++i) { qr[i] = Qp[((size_t)(c) * 64 + i) * (D / 2)]; lr[i] = Lp[((size_t)(c) * 64 + i) * (D / 2)]; } \
        _Pragma("unroll") for (int i = 0; i < 4; ++i) vr[i] = Vp[(size_t)(c) * 64 * (D / 8) + i]; } while (0)
#define HG_LDG(c) do { _Pragma("unroll") for (int i = 0; i < 4; ++i) gq[i] = Gq[(size_t)(c) * 64 * (MIXW / 8) + i]; } while (0)
#define HG_ELEM(set) do { \
        float a0 = 0.f, a1 = 0.f, r0 = 1.f, r1 = 1.f; float f0[16], f1[16], P0[16], P1[16]; \
        _Pragma("unroll") for (int i = 0; i < 16; ++i) { const float l0 = h2f_lo(lr[i]), l1 = h2f_hi(lr[i]); a0 += l0; a1 += l1; f0[i] = __expf(l0); f1[i] = __expf(l1); r0 *= f0[i]; r1 *= f1[i]; P0[i] = r0; P1[i] = r1; } \
          \
        const float x10 = shfl_x(a0, 16, ln_), x11 = shfl_x(a1, 16, ln_), x20 = shfl_x(a0, 32, ln_), x21 = shfl_x(a1, 32, ln_), x30 = shfl_x(a0, 48, ln_), x31 = shfl_x(a1, 48, ln_); \
          \
        const float t00 = tgq == 0 ? a0 : tgq == 1 ? x10 : tgq == 2 ? x20 : x30, t01 = tgq == 0 ? a1 : tgq == 1 ? x11 : tgq == 2 ? x21 : x31; \
        const float t10 = tgq == 1 ? a0 : tgq == 0 ? x10 : tgq == 3 ? x20 : x30, t11 = tgq == 1 ? a1 : tgq == 0 ? x11 : tgq == 3 ? x21 : x31; \
        const float t20 = tgq == 2 ? a0 : tgq == 3 ? x10 : tgq == 0 ? x20 : x30, t21 = tgq == 2 ? a1 : tgq == 3 ? x11 : tgq == 0 ? x21 : x31; \
        const float t30 = tgq == 3 ? a0 : tgq == 2 ? x10 : tgq == 1 ? x20 : x30, t31 = tgq == 3 ? a1 : tgq == 2 ? x11 : tgq == 1 ? x21 : x31; \
        const float R0 = t00 + t10, R1 = t01 + t11, L0 = R0 + t20 + t30, L1 = R1 + t21 + t31; \
          \
        const float d0 = tgq == 0 ? -R0 : tgq == 1 ? -t10 : tgq == 2 ? 0.f : t20, d1 = tgq == 0 ? -R1 : tgq == 1 ? -t11 : tgq == 2 ? 0.f : t21; \
        const float b0 = __expf(fminf(d0, 80.f)), b1 = __expf(fminf(d1, 80.f)); \
        if (tgq == 0) { *(LAS f32x2*)((set) + S_ER + ch0 * 4) = (f32x2){__expf(R0), __expf(R1)}; *(LAS f32x2*)((set) + S_ELR + ch0 * 4) = (f32x2){__expf(L0 - R0), __expf(L1 - R1)}; \
                        *(LAS f32x2*)((set) + S_DEC + ch0 * 4) = (f32x2){__expf(L0), __expf(L1)}; } \
        _Pragma("unroll") for (int i = 0; i < 16; ++i) { \
            const float q0 = bflo(qr[i]), q1 = bfhi(qr[i]), k0 = 1.0f - f0[i], k1 = 1.0f - f1[i]; \
            const float e10 = b0 * P0[i], e11 = b1 * P1[i], e20 = fminf(__builtin_amdgcn_rcpf(e10), 5.5e34f), e21 = fminf(__builtin_amdgcn_rcpf(e11), 5.5e34f); \
            const int ob = (64 * i + 4 * cpq) ^ ((i >> 3) << 5); \
            *(LAS unsigned*)((set) + S_QB + ew + ob) = cvtpk(q0 * e10, q1 * e11); \
            *(LAS unsigned*)((set) + S_K2 + ew + ob) = cvtpk(k0 * e20, k1 * e21); } \
        _Pragma("unroll") for (int i = 0; i < 4; ++i) *(LAS u32x4*)((set) + S_V + evw + 16 * i) = vr[i]; } while (0)
        HG_LD(0);
        HG_ELEM(lds + L_SET0);
        HG_LD(1);
        HG_BAR();
        f32x4 ov[8]; float rsv = 0.f;
#pragma unroll 1
        for (int k = 0; k < NCH; ++k) {
            if (k >= 1) {
                const int tok = ptid >> 2;
                float ss = 0.f;
#pragma unroll
                for (int w2 = 0; w2 < 4; ++w2) ss += *(const LAS float*)(lds + L_SSQ + (w2 * 64 + tok) * 4);
                rsv = __builtin_amdgcn_rsqf(ss * (1.0f / HD) + EPS);
#pragma unroll
                for (int i = 0; i < 8; ++i) ov[i] = *(const LAS f32x4*)(lds + L_O + tok * OSTR + (ptid & 3) * 128 + 16 * i);
            }
            if (k + 1 < NCH) { HG_ELEM(lds + (((k + 1) & 1) ? L_SET1 : L_SET0)); if (k + 2 < NCH) HG_LD(k + 2); }
            HG_BAR();
            if (k >= 1) {
#pragma unroll
                for (int i = 0; i < 4; ++i) {
                    const f32x4 n0 = *(const LAS f32x4*)(lds + L_NW + (ptid & 3) * 128 + 32 * i), n1 = *(const LAS f32x4*)(lds + L_NW + (ptid & 3) * 128 + 32 * i + 16);
                    const f32x4 a = ov[2 * i] * n0 * rsv, c = ov[2 * i + 1] * n1 * rsv; const u32x4 gw = gq[i]; u32x4 w;
                    w.x = pk2(a[0] * bflo(gw.x), a[1] * bfhi(gw.x)); w.y = pk2(a[2] * bflo(gw.y), a[3] * bfhi(gw.y)); w.z = pk2(c[0] * bflo(gw.z), c[1] * bfhi(gw.z)); w.w = pk2(c[2] * bflo(gw.w), c[3] * bfhi(gw.w));
                    Gq[(size_t)(k - 1) * 64 * (MIXW / 8) + i] = w; }
            }
            HG_LDG(k);
            HG_BAR();
        }
        { const int tok = ptid >> 2; float ss = 0.f;
#pragma unroll
          for (int w2 = 0; w2 < 4; ++w2) ss += *(const LAS float*)(lds + L_SSQ + (w2 * 64 + tok) * 4);
          rsv = __builtin_amdgcn_rsqf(ss * (1.0f / HD) + EPS);
#pragma unroll
          for (int i = 0; i < 4; ++i) {
              const f32x4 n0 = *(const LAS f32x4*)(lds + L_NW + (ptid & 3) * 128 + 32 * i), n1 = *(const LAS f32x4*)(lds + L_NW + (ptid & 3) * 128 + 32 * i + 16);
              const f32x4 a = *(const LAS f32x4*)(lds + L_O + tok * OSTR + (ptid & 3) * 128 + 32 * i) * n0 * rsv, c = *(const LAS f32x4*)(lds + L_O + tok * OSTR + (ptid & 3) * 128 + 32 * i + 16) * n1 * rsv;
              const u32x4 gw = gq[i]; u32x4 w;
              w.x = pk2(a[0] * bflo(gw.x), a[1] * bfhi(gw.x)); w.y = pk2(a[2] * bflo(gw.y), a[3] * bfhi(gw.y)); w.z = pk2(c[0] * bflo(gw.z), c[1] * bfhi(gw.z)); w.w = pk2(c[2] * bflo(gw.w), c[3] * bfhi(gw.w));
              Gq[(size_t)(NCH - 1) * 64 * (MIXW / 8) + i] = w; } }
        HG_BAR();
#undef HG_LD
#undef HG_LDG
#undef HG_ELEM
    }
}
#undef HG_DPP
#undef HG_BAR
#undef MFMA16
}

__device__ __forceinline__ void mixer_phase(Frame& F, const int l) {
    REFRESH_IDS(F);
    const int nh = F.G < BATCH * NHEAD ? F.G : BATCH * NHEAD;
    if (F.bid < nh) {
        const KArgs ka = kargs(); const float* nw = ka->in[IN_HNW] + l * HD;
        const bf16* Qg = (const bf16*)(ka->ws + WS_Q); const bf16* LFg = (const bf16*)(ka->ws + WS_LF); const bf16* Vg = (const bf16*)(ka->ws + WS_V); bf16* MIXg = (bf16*)(ka->ws + WS_MIX);
        for (int unit = F.bid; unit < BATCH * NHEAD; unit += nh) hg2::hgrn_unit(F.lds + RING_OFF, F.wave, unit / NHEAD, unit % NHEAD, Qg, LFg, Vg, MIXg, nw);
#ifdef PROBE_HG
        if (l == 0 && F.bid == 0 && F.wave0 == 0 && lane_now() == 0) *(volatile LAS unsigned long long*)(F.lds + LDSCTL_OFF + 1024 + 8 * 14) = __builtin_amdgcn_s_memrealtime();
#endif
    }
    if (F.G > nh) { if (F.bid >= nh) pool_pass(F, l, F.bid - nh, F.G - nh); }
    else pool_pass(F, l, F.bid, F.G);
}

#ifndef DBG_KINDS
#define DBG_KINDS 0x7f
#endif
#define KIND(j) ((DBG_KINDS >> (j)) & 1)
#define IN(k) (lo <= (k) && (k) < hi)
#define BOTH(k) (IN(k) && IN((k) + 1))
#define GRID_BAR() do { if (N_LAUNCHES == 1) xcd_barrier(bar); } while (0)
#if defined(PROBE_PHASE) && !defined(PROBE_PHASE_END)
#define PROBE_PHASE_END (PROBE_PHASE + 1)
#endif
#ifdef PROBE_PHASE
constexpr int STAMP_OFF = LDSCTL_OFF + 1024;
#define STAMP(k) do { if (F.bid == 0 && F.wave0 == 0 && lane_now() == 0) *(volatile LAS unsigned long long*)(F.lds + STAMP_OFF + 8 * (k)) = __builtin_amdgcn_s_memrealtime(); } while (0)
#else
#define STAMP(k) do { } while (0)
#endif
template <int l> __device__ __forceinline__ void layer_phases(Frame& F, const XcdBarrier& bar, const int lo, const int hi) {
        const int p = 2 + 4 * l;
    if (KIND(2) && IN(p)) {
        const KArgs ka = kargs(); bf16* P_XN = (bf16*)(ka->ws + WS_XN); bf16* P_WIN = (bf16*)(ka->ws + WS_WIN);
        pg8::Gemm g{P_XN, P_WIN + (size_t)l * NZ * D, M, NZ, D, D, 0}; pg8::StaticOrder S; REFRESH_IDS(F); S.init(M, NZ, F.G, F.bid);
        pg8::EpiZ E{l};
        pg8::gemm_phase<pg8::EpiZ, pg8::StaticOrder, PG8_ALIGN, PG8_SP2>(F.lds + RING_OFF, g, S, E, F.tid);
        if (BOTH(p)) GRID_BAR();
    }
    STAMP(p + 1);
    if (KIND(3) && IN(p + 1)) {
#if defined(HGRN_NAIVE)
        REFRESH_IDS(F); pool_pass(F, l, F.bid, F.G);
        hgrn_naive(F, l);
#else
        mixer_phase(F, l);
#endif
        if (BOTH(p + 1)) GRID_BAR();
    }
    STAMP(p + 2);
    if (KIND(5) && IN(p + 2)) {
        const KArgs ka = kargs(); bf16* P_MIX = (bf16*)(ka->ws + WS_MIX); bf16* P_WOUT = (bf16*)(ka->ws + WS_WOUT);
        pg8::Gemm g{P_MIX, P_WOUT + (size_t)l * D * MIXW, M, D, MIXW, MIXW, 0}; pg8::StaticOrder S; REFRESH_IDS(F); S.init(M, D, F.G, F.bid);
        pg8::EpiBf16Plain E{WS_Y, D};
        pg8::gemm_phase<pg8::EpiBf16Plain, pg8::StaticOrder, PG8_ALIGN, PG8_SP2>(F.lds + RING_OFF, g, S, E, F.tid);
        if (BOTH(p + 2)) GRID_BAR();
    }
    STAMP(p + 3);
    if (KIND(6) && IN(p + 3)) {
        rowpass(F, l);
        if (BOTH(p + 3)) GRID_BAR();
    }
    STAMP(p + 4);
}

__global__ void __launch_bounds__(NWAVES * 64, 2) skel_fwd(Args args) {
    extern __shared__ __attribute__((aligned(16))) unsigned char lds[];
    Frame F;
    F.lds = (LAS unsigned char*)lds;
    F.MISC = (volatile LAS unsigned*)(F.lds + MISC_OFF);
    F.tid = threadIdx.x; F.lane = F.tid & 63; F.wave = __builtin_amdgcn_readfirstlane(F.tid >> 6); F.wave0 = F.wave;
    F.G = gridDim.x; F.bid = blockIdx.x;
    F.ctl = (gu32*)(args.ws + WS_CTL);
    for (int u = F.tid; u < (LDS_BYTES - LDSCTL_OFF) / 4; u += NWAVES * 64) ((LAS unsigned*)(F.lds + LDSCTL_OFF))[u] = 0u;
    __syncthreads();
    XcdBarrier bar; bar.bar = (unsigned*)(F.ctl + CW_BAR); bar.x = 0; bar.st = nullptr; bar.wave0 = F.wave0;
    if (N_LAUNCHES == 1) bar = xcd_barrier_post((unsigned*)(F.ctl + CW_BAR), F.MISC + 8);
    const int lo = (N_LAUNCHES == 1) ? 0 : args.ph_lo, hi = (N_LAUNCHES == 1) ? N_PHASES : args.ph_hi;

    STAMP(0);
    if (KIND(0) && IN(0)) { p0_prologue(F); if (N_LAUNCHES == 1) xcd_barrier_census(bar); if (BOTH(0)) GRID_BAR(); }
    STAMP(1);
    if (KIND(1) && IN(1)) { p1_weights(F); rowpass(F, -1); if (BOTH(1)) GRID_BAR(); }
    STAMP(2);
    layer_phases<0>(F, bar, lo, hi);
    layer_phases<1>(F, bar, lo, hi);
    static_assert(DEPTH == 2, "two explicit layer_phases calls");
#ifdef PROBE_SEG
    if (F.bid == 0 && F.wave0 == 0 && lane_now() == 0) {
        volatile LAS unsigned long long* pa_ = (volatile LAS unsigned long long*)(F.lds + 141312 + 2048);
        const unsigned long long span = (PROBE_SEG == 99) ? pa_[0] + pa_[1] + pa_[2] + pa_[3] + pa_[4] + pa_[5] : pa_[PROBE_SEG & 15];
        const unsigned long long t0 = __builtin_amdgcn_s_memrealtime();
        while (__builtin_amdgcn_s_memrealtime() - t0 < span) __builtin_amdgcn_s_sleep(8);
    }
#endif
#ifdef PROBE_PHASE
    if (F.bid == 0 && F.wave0 == 0 && lane_now() == 0) {
#ifdef PROBE_HG
        const unsigned long long span = *(volatile LAS unsigned long long*)(F.lds + STAMP_OFF + 8 * 14) - *(volatile LAS unsigned long long*)(F.lds + STAMP_OFF + 8 * 3);
#else
        const unsigned long long span = *(volatile LAS unsigned long long*)(F.lds + STAMP_OFF + 8 * (PROBE_PHASE_END)) - *(volatile LAS unsigned long long*)(F.lds + STAMP_OFF + 8 * (PROBE_PHASE));
#endif
        const unsigned long long t0 = __builtin_amdgcn_s_memrealtime();
        while (__builtin_amdgcn_s_memrealtime() - t0 < span) __builtin_amdgcn_s_sleep(8);
    }
#endif
#undef IN
#undef BOTH
}

extern "C" void kernel_launch(void* const* d_in, const int* in_sizes, int n_in, void* d_out, int out_size, void* d_ws, size_t ws_size, hipStream_t stream) {
    static int grid = 0;
    if (grid == 0) {
        if (n_in != 12 || in_sizes[0] != M * D || out_size != M * D || ws_size < WS_END) { fprintf(stderr, "kernel_launch: unexpected shapes: n_in %d in0 %d out %d ws %zu\n", n_in, n_in > 0 ? in_sizes[0] : -1, out_size, ws_size); grid = -1; return; }
        int dev = 0, cus = 0, per_cu = 0;
        if (hipGetDevice(&dev) != hipSuccess || hipDeviceGetAttribute(&cus, hipDeviceAttributeMultiprocessorCount, dev) != hipSuccess) { grid = -1; return; }
        if (hipFuncSetAttribute((const void*)skel_fwd, hipFuncAttributeMaxDynamicSharedMemorySize, LDS_BYTES) != hipSuccess) { fprintf(stderr, "kernel_launch: hipFuncSetAttribute failed\n"); grid = -1; return; }
        if (hipOccupancyMaxActiveBlocksPerMultiprocessor(&per_cu, (const void*)skel_fwd, NWAVES * 64, LDS_BYTES) != hipSuccess || per_cu < 1) { fprintf(stderr, "kernel_launch: occupancy query says %d blocks per CU\n", per_cu); per_cu = 1; }
        (void)hipGetLastError();
        grid = cus;
    }
    if (grid < 0) return;
    if (hipMemsetAsync((char*)d_ws + WS_CTL, 0, CTL_ZERO_BYTES, stream) != hipSuccess) { fprintf(stderr, "kernel_launch: memset failed\n"); return; }
    Args a{};
    for (int i = 0; i < 12; ++i) a.in[i] = (const float*)d_in[i];
    a.out = (float*)d_out; a.ws = (unsigned char*)d_ws;
    for (int li = 0; li < N_LAUNCHES; ++li) {
        a.ph_lo = (N_LAUNCHES == 1) ? 0 : li; a.ph_hi = (N_LAUNCHES == 1) ? N_PHASES : li + 1; a.li = li;
        hipLaunchKernelGGL(skel_fwd, dim3(grid), dim3(NWAVES * 64), LDS_BYTES, stream, a);
        const hipError_t le = hipPeekAtLastError();
        if (le != hipSuccess) { fprintf(stderr, "kernel_launch: launch %d failed: %s\n", li, hipGetErrorName(le)); break; }
    }
}
```

```cpp
#include <hip/hip_runtime.h>
#include <cstdio>
#include <cstdint>

#ifndef MK_N_LAUNCHES
#define MK_N_LAUNCHES 1
#endif

constexpr int NWAVES = 8;
constexpr int N_LAUNCHES = MK_N_LAUNCHES;
constexpr int BATCH = 16, SEQ = 2048, D = 1024, DEPTH = 2, NZ = 6144, MIXW = 2048, NHEAD = 8, HD = 128;
constexpr int M = BATCH * SEQ;
constexpr float EPS = 1e-6f;
constexpr int N_PHASES = 2 + 4 * DEPTH;

constexpr size_t MiB = 1u << 20;
constexpr size_t WS_CTL = 0, CTL_ZERO_BYTES = 1 * MiB;
constexpr size_t WS_MOD = 1 * MiB;
constexpr size_t WS_LB = 1 * MiB + 512 * 1024;
constexpr size_t WS_WIN = 2 * MiB;
constexpr size_t WS_WOUT = 26 * MiB;
constexpr size_t WS_WPOOL = 34 * MiB;
constexpr size_t WS_XN = 36 * MiB;
constexpr size_t WS_U = 100 * MiB, WS_Q = 164 * MiB, WS_LF = 228 * MiB, WS_V = 292 * MiB;
constexpr size_t WS_MIX = 356 * MiB;
constexpr size_t WS_Y = WS_U;
constexpr size_t WS_END = 484 * MiB;
constexpr int CW_TMO = 0, CW_CODE = 1;
constexpr int CW_BAR = 4096;


struct Args { const float* in[12]; float* out; unsigned char* ws; int ph_lo, ph_hi, li, pad; };
typedef const __attribute__((address_space(4))) Args* KArgs;
__device__ __forceinline__ KArgs kargs() { KArgs p = (KArgs)__builtin_amdgcn_kernarg_segment_ptr(); asm volatile("" : "+s"(p)); return p; }
enum { IN_X = 0, IN_C, IN_NPRE, IN_ADAW, IN_ADAB, IN_WIN, IN_POOLW, IN_PSCALE, IN_HLB, IN_HNW, IN_WOUT, IN_NPOST };

namespace pg8 {
#define PG8_LAS __attribute__((address_space(3)))
typedef unsigned short bf16_t;
typedef short bf16x8 __attribute__((ext_vector_type(8)));
typedef float f32x4 __attribute__((ext_vector_type(4)));
typedef unsigned u32x4 __attribute__((ext_vector_type(4)));
constexpr int BM = 256, BK = 64, HALF = 128, HTB = HALF * BK * 2  , STAGE_BYTES = 8 * HTB, NXCD = 8, WGM = 8;

__host__ __device__ __forceinline__ int lds_byte(int r, int c) { const int st = (r >> 4) * 2 + (c >> 5), rr = r & 15, cc = c & 31, ob = rr * 64 + cc * 2; return st * 1024 + (ob ^ (((ob >> 9) & 1) << 5)); }
__host__ __device__ __forceinline__ void stage_rc(int b, int& R, int& C) { const int st = b / 1024, sb = b % 1024, swz = sb ^ (((sb >> 9) & 1) << 5); R = (st >> 1) * 16 + swz / 64; C = (st & 1) * 32 + (swz % 64) / 2; }
__host__ __device__ __forceinline__ int perm32(int rho) { const int n = rho >> 4, i = rho & 15; return 8 * (i >> 2) + 4 * n + (i & 3); }

struct Unit { int pm, pn; };
struct Gemm { const bf16_t* A; const bf16_t* Bt; int M, N, K, lda, acol; };

struct StaticOrder {
    int nM, nN, nwg, G, c;
    __host__ __device__ void init(int M, int N, int G_, int c_) { nM = M / BM; nN = N / BM; nwg = nM * nN; G = G_; c = c_; }
    __host__ __device__ bool next(int i, Unit& u) const {
        const long L = (long)i * G + c; if (L >= nwg) return false;
        int wgid = (int)L; { const int q = nwg / NXCD, r = nwg % NXCD, xcd = wgid % NXCD, off = wgid / NXCD; wgid = (xcd < r ? xcd * (q + 1) : r * (q + 1) + (xcd - r) * q) + off; }
        const int nig = WGM * nN, gid = wgid / nig, fm = gid * WGM, gsz = (nM - fm) < WGM ? (nM - fm) : WGM;
        u.pm = fm + ((wgid % nig) % gsz); u.pn = (wgid % nig) / gsz; return true;
    }
    __device__ __forceinline__ void a_ready(const Unit&) const {}
    __device__ __forceinline__ void done(const Unit&) const {}
};

__device__ __forceinline__ unsigned cvt_pk_bf16(float lo, float hi) { unsigned r; asm volatile("v_cvt_pk_bf16_f32 %0, %1, %2" : "=v"(r) : "v"(lo), "v"(hi)); return r; }
__device__ __forceinline__ unsigned cvt_pk_f16(float lo, float hi) { typedef _Float16 h2 __attribute__((ext_vector_type(2))); h2 v; v.x = (_Float16)lo; v.y = (_Float16)hi; return __builtin_bit_cast(unsigned, v); }
__device__ __forceinline__ float bf_lo(unsigned w) { return __uint_as_float(w << 16); }
__device__ __forceinline__ float bf_hi(unsigned w) { return __uint_as_float(w & 0xffff0000u); }
__device__ __forceinline__ float sigmoid_f(float x) { return __builtin_amdgcn_rcpf(1.0f + __expf(-x)); }

struct EpiBf16Plain {
    static constexpr bool PERM = true, AFTER_DRAIN = false;
    size_t ws_off; int ldc;
    __device__ __forceinline__ void operator()(const f32x4 (&acc)[2][2][4][2], const Unit& u, int wr, int wc, int fr, int fq) const {
        const int row0 = u.pm * BM + wr * 64 + fr, col0 = u.pn * BM + wc * 32 + 8 * fq;
        bf16_t* O = (bf16_t*)(kargs()->ws + ws_off);
#pragma unroll
        for (int ai = 0; ai < 2; ++ai)
#pragma unroll
            for (int m = 0; m < 4; ++m) { bf16_t* rowp = O + (size_t)(row0 + ai * HALF + m * 16) * ldc + col0;
#pragma unroll
                for (int bj = 0; bj < 2; ++bj) { const f32x4 v0 = acc[ai][bj][m][0], v1 = acc[ai][bj][m][1];
                    u32x4 w; w.x = cvt_pk_bf16(v0[0], v0[1]); w.y = cvt_pk_bf16(v0[2], v0[3]); w.z = cvt_pk_bf16(v1[0], v1[1]); w.w = cvt_pk_bf16(v1[2], v1[3]);
                    *(u32x4*)(rowp + bj * HALF) = w; } }
    }
};

struct EpiZ {
    static constexpr bool PERM = true, AFTER_DRAIN = false;
    int l;
    template <int ACT> __device__ __forceinline__ void tile(const f32x4 (&acc)[2][2][4][2], bf16_t* base, int ldc, int row0, int col0, const float* lb) const {
        f32x4 lbv[2][2];
        if (ACT == 2) {
#pragma unroll
            for (int bj = 0; bj < 2; ++bj)
#pragma unroll
                for (int n = 0; n < 2; ++n) lbv[bj][n] = *(const f32x4*)(lb + col0 + bj * HALF + 4 * n);
        }
#pragma unroll
        for (int ai = 0; ai < 2; ++ai)
#pragma unroll
            for (int m = 0; m < 4; ++m) { bf16_t* rowp = base + (size_t)(row0 + ai * HALF + m * 16) * ldc + col0;
#pragma unroll
                for (int bj = 0; bj < 2; ++bj) { f32x4 v[2] = {acc[ai][bj][m][0], acc[ai][bj][m][1]};
                    u32x4 w;
                    if (ACT == 1) {
#pragma unroll
                        for (int n = 0; n < 2; ++n)
#pragma unroll
                            for (int e = 0; e < 4; ++e) v[n][e] = v[n][e] * sigmoid_f(v[n][e]);
                    }
                    if (ACT == 2) {
#pragma unroll
                        for (int n = 0; n < 2; ++n)
#pragma unroll
                            for (int e = 0; e < 4; ++e) { const float x = fminf(fmaxf(v[n][e], -30.f), 30.f), l = lbv[bj][n][e]; v[n][e] = __logf(l + (1.0f - l) * sigmoid_f(x)); }
                        w.x = cvt_pk_f16(v[0][0], v[0][1]); w.y = cvt_pk_f16(v[0][2], v[0][3]); w.z = cvt_pk_f16(v[1][0], v[1][1]); w.w = cvt_pk_f16(v[1][2], v[1][3]);
                    } else {
                        w.x = cvt_pk_bf16(v[0][0], v[0][1]); w.y = cvt_pk_bf16(v[0][2], v[0][3]); w.z = cvt_pk_bf16(v[1][0], v[1][1]); w.w = cvt_pk_bf16(v[1][2], v[1][3]);
                    }
                    *(u32x4*)(rowp + bj * HALF) = w; }
                if (ACT != 0) __builtin_amdgcn_sched_barrier(0); }
    }
    __device__ __forceinline__ void operator()(const f32x4 (&acc)[2][2][4][2], const Unit& u, int wr, int wc, int fr, int fq) const {
        const int seg = u.pn >> 2, row0 = u.pm * BM + wr * 64 + fr, col0 = (u.pn & 3) * BM + wc * 32 + 8 * fq;
        unsigned char* ws = kargs()->ws; const float* lb = (const float*)(ws + WS_LB) + l * 1024;
        const size_t off = seg == 0 ? WS_U : seg == 2 ? WS_Q : seg == 3 ? WS_LF : seg == 4 ? WS_V : seg == 1 ? WS_MIX : WS_MIX + 2048;
        const int ldc = (seg == 1 || seg == 5) ? 2048 : 1024;
        bf16_t* base = (bf16_t*)(ws + off);
        if (seg == 3) tile<2>(acc, base, ldc, row0, col0, lb);
        else if (seg == 1 || seg == 5) tile<1>(acc, base, ldc, row0, col0, lb);
        else tile<0>(acc, base, ldc, row0, col0, lb);
    }
};

struct EpiPool {
    static constexpr bool PERM = true, AFTER_DRAIN = false;
    int l;
    __device__ __forceinline__ void operator()(const f32x4 (&acc)[2][2][4][2], const Unit& u, int wr, int wc, int fr, int fq) const {
        const int row0 = u.pm * BM + wr * 64 + fr, col0 = u.pn * BM + wc * 32 + 8 * fq;
        const KArgs ka = kargs(); bf16_t* MIX = (bf16_t*)(ka->ws + WS_MIX); const float* pscale = ka->in[IN_PSCALE] + l * 1024;
        f32x4 sv[2][2];
#pragma unroll
        for (int bj = 0; bj < 2; ++bj)
#pragma unroll
            for (int n = 0; n < 2; ++n) sv[bj][n] = *(const f32x4*)(pscale + col0 + bj * HALF + 4 * n);
#pragma unroll
        for (int ai = 0; ai < 2; ++ai)
#pragma unroll
            for (int m = 0; m < 4; ++m) { bf16_t* rowp = MIX + (size_t)(row0 + ai * HALF + m * 16) * 2048 + col0;
#pragma unroll
                for (int bj = 0; bj < 2; ++bj) { const u32x4 gw = *(const u32x4*)(rowp + bj * HALF);
                    const f32x4 v0 = acc[ai][bj][m][0] * sv[bj][0], v1 = acc[ai][bj][m][1] * sv[bj][1];
                    u32x4 w; w.x = cvt_pk_bf16(v0[0] * bf_lo(gw.x), v0[1] * bf_hi(gw.x)); w.y = cvt_pk_bf16(v0[2] * bf_lo(gw.y), v0[3] * bf_hi(gw.y));
                    w.z = cvt_pk_bf16(v1[0] * bf_lo(gw.z), v1[1] * bf_hi(gw.z)); w.w = cvt_pk_bf16(v1[2] * bf_lo(gw.w), v1[3] * bf_hi(gw.w));
                    *(u32x4*)(rowp + bj * HALF) = w; }
                if (m & 1) asm volatile("" ::: "memory"); }
    }
};

template <class Epi, class Sched, bool ALIGN_EPI = false, bool SP2 = false>
__device__ __forceinline__ void gemm_phase(PG8_LAS unsigned char* lds, const Gemm g, const Sched& S, const Epi& E, const int tid_in) {
    int tid_ = tid_in; asm volatile("" : "+v"(tid_));
    const int tid = tid_, wid = __builtin_amdgcn_readfirstlane(tid >> 6), lane = tid & 63, wr = wid >> 2, wc = wid & 3, fr = lane & 15, fq = lane >> 4;
    const int K = g.K, nt = K / BK;
    unsigned voffA[2], voffB[2];
#pragma unroll
    for (int i = 0; i < 2; ++i) { int R, C; stage_rc(tid * 16 + i * 8192, R, C); const int Rb = Epi::PERM ? ((R & ~31) + perm32(R & 31)) : R;
        voffA[i] = (unsigned)(R * g.lda + C) * 2u; voffB[i] = (unsigned)(Rb * K + C) * 2u; }
    const size_t kstep = (size_t)(BK * 2);
    const size_t hstepA = (size_t)HALF * g.lda * 2, hstepB = (size_t)HALF * K * 2;
    const size_t tstepA = 2 * hstepA, tstepB = 2 * hstepB;
    const size_t acolB = (size_t)g.acol * 2;
    const unsigned ldsw = (unsigned)wid * 1024u;
    const int aoff = lds_byte(wr * 64 + fr, fq * 8), boff = lds_byte(wc * 32 + fr, fq * 8);
#define PG8_SA(b, h) (((b) * 2 + (h)) * HTB)
#define PG8_SB(b, h) ((4 + (b) * 2 + (h)) * HTB)
#define PG8_STAGE(bufoff, gbase, voff) do { _Pragma("unroll") for (int _i = 0; _i < 2; ++_i) \
        __builtin_amdgcn_global_load_lds((const unsigned*)((const char*)(gbase) + (voff)[_i]), (PG8_LAS unsigned*)(lds + (bufoff) + ldsw + _i * 8192), 16, 0, 0); } while (0)
#define PG8_LDA(dst, b, h) do { _Pragma("unroll") for (int m = 0; m < 4; ++m) _Pragma("unroll") for (int k = 0; k < 2; ++k) dst[m][k] = *(const PG8_LAS bf16x8*)(lds + PG8_SA(b, h) + aoff + m * 2048 + k * 1024); } while (0)
#define PG8_LDB(dst, b, h) do { _Pragma("unroll") for (int n = 0; n < 2; ++n) _Pragma("unroll") for (int k = 0; k < 2; ++k) dst[n][k] = *(const PG8_LAS bf16x8*)(lds + PG8_SB(b, h) + boff + n * 2048 + k * 1024); } while (0)
#define PG8_MMA(ai, bj, At, Bt) do { __builtin_amdgcn_s_setprio(1); _Pragma("unroll") for (int m = 0; m < 4; ++m) _Pragma("unroll") for (int n = 0; n < 2; ++n) _Pragma("unroll") for (int k = 0; k < 2; ++k) \
        acc[ai][bj][m][n] = __builtin_amdgcn_mfma_f32_16x16x32_bf16(Bt[n][k], At[m][k], acc[ai][bj][m][n], 0, 0, 0); __builtin_amdgcn_s_setprio(0); } while (0)
#define PG8_WAIT_V(n) asm volatile("s_waitcnt vmcnt(" #n ")" ::: "memory")
#define PG8_WAIT_L(n) asm volatile("s_waitcnt lgkmcnt(" #n ")" ::: "memory")
#define PG8_BAR __builtin_amdgcn_s_barrier()
#define PG8_SCHED __builtin_amdgcn_sched_barrier(0)
    Unit cur, nxt; int ui = 0;
    if (!S.next(0, cur)) return;
    f32x4 acc[2][2][4][2];
#pragma unroll
    for (int a = 0; a < 2; ++a)
#pragma unroll
        for (int b = 0; b < 2; ++b)
#pragma unroll
            for (int m = 0; m < 4; ++m)
#pragma unroll
                for (int n = 0; n < 2; ++n) acc[a][b][m][n] = (f32x4){0.f, 0.f, 0.f, 0.f};
    bf16x8 At[4][2], B0[2][2], B1[2][2];
    const char* cA = (const char*)g.A + (size_t)cur.pm * tstepA + (size_t)cur.pn * acolB; const char* cB = (const char*)g.Bt + (size_t)cur.pn * tstepB;
    S.a_ready(cur);
    if constexpr (SP2) {
        PG8_STAGE(PG8_SB(0, 0), cB, voffB); PG8_STAGE(PG8_SB(0, 1), cB + hstepB, voffB); PG8_STAGE(PG8_SA(0, 0), cA, voffA); PG8_STAGE(PG8_SA(0, 1), cA + hstepA, voffA);
        if (wr == 1) PG8_BAR;
        PG8_WAIT_V(2); PG8_BAR;
        PG8_STAGE(PG8_SB(1, 0), cB + kstep, voffB); PG8_STAGE(PG8_SA(1, 0), cA + kstep, voffA); PG8_STAGE(PG8_SB(1, 1), cB + hstepB + kstep, voffB);
        PG8_WAIT_V(6); PG8_BAR;
    } else {
        PG8_STAGE(PG8_SB(0, 0), cB, voffB); PG8_STAGE(PG8_SA(0, 0), cA, voffA); PG8_STAGE(PG8_SB(0, 1), cB + hstepB, voffB); PG8_STAGE(PG8_SA(0, 1), cA + hstepA, voffA);
        if (wr == 1) PG8_BAR;
        PG8_WAIT_V(4); PG8_BAR;
        PG8_STAGE(PG8_SB(1, 0), cB + kstep, voffB); PG8_STAGE(PG8_SA(1, 0), cA + kstep, voffA); PG8_STAGE(PG8_SB(1, 1), cB + hstepB + kstep, voffB);
        PG8_WAIT_V(6); PG8_BAR;
    }
    for (;;) {
        const bool has_next = S.next(ui + 1, nxt);
        const char* nA = has_next ? (const char*)g.A + (size_t)nxt.pm * tstepA + (size_t)nxt.pn * acolB : cA; const char* nB = has_next ? (const char*)g.Bt + (size_t)nxt.pn * tstepB : cB;
        for (int t = 0; t < nt; t += 2) {
            const bool last = (t == nt - 2);
            const char* a1 = cA + (size_t)(t + 1) * kstep;
            const char* a2 = last ? nA : cA + (size_t)(t + 2) * kstep; const char* b2 = last ? nB : cB + (size_t)(t + 2) * kstep;
            const char* a3 = a2 + kstep; const char* b3 = b2 + kstep;
            if (last && has_next) S.a_ready(nxt);
            if constexpr (SP2) {
            PG8_LDB(B0, 0, 0); PG8_LDB(B1, 0, 1); PG8_SCHED; PG8_LDA(At, 0, 0); PG8_STAGE(PG8_SA(1, 1), a1 + hstepA, voffA);
            PG8_WAIT_V(8); PG8_WAIT_L(0); PG8_BAR; PG8_MMA(0, 0, At, B0); PG8_MMA(0, 1, At, B1); PG8_BAR; PG8_SCHED;
            PG8_LDA(At, 0, 1); PG8_STAGE(PG8_SB(0, 0), b2, voffB); PG8_STAGE(PG8_SB(0, 1), b2 + hstepB, voffB); PG8_STAGE(PG8_SA(0, 0), a2, voffA);
            PG8_WAIT_V(8); PG8_WAIT_L(0); PG8_BAR; PG8_MMA(1, 0, At, B0); PG8_MMA(1, 1, At, B1); PG8_BAR; PG8_SCHED;
            PG8_LDB(B0, 1, 0); PG8_LDB(B1, 1, 1); PG8_SCHED; PG8_LDA(At, 1, 0); PG8_STAGE(PG8_SA(0, 1), a2 + hstepA, voffA);
            PG8_WAIT_V(8); PG8_WAIT_L(0); PG8_BAR; PG8_MMA(0, 0, At, B0); PG8_MMA(0, 1, At, B1); PG8_BAR; PG8_SCHED;
            PG8_LDA(At, 1, 1); PG8_STAGE(PG8_SB(1, 0), b3, voffB); PG8_STAGE(PG8_SB(1, 1), b3 + hstepB, voffB); PG8_STAGE(PG8_SA(1, 0), a3, voffA);
            PG8_WAIT_V(8); PG8_WAIT_L(0); PG8_BAR; PG8_MMA(1, 0, At, B0); PG8_MMA(1, 1, At, B1); PG8_BAR; PG8_SCHED;
            } else {
            PG8_LDB(B0, 0, 0); PG8_SCHED; PG8_LDA(At, 0, 0); PG8_STAGE(PG8_SA(1, 1), a1 + hstepA, voffA);
            PG8_WAIT_L(8); PG8_BAR; PG8_WAIT_L(0); PG8_MMA(0, 0, At, B0); PG8_BAR; PG8_SCHED;
            PG8_LDB(B1, 0, 1); PG8_STAGE(PG8_SB(0, 0), b2, voffB);
            PG8_BAR; PG8_WAIT_L(0); PG8_MMA(0, 1, At, B1); PG8_BAR;
            PG8_LDA(At, 0, 1); PG8_STAGE(PG8_SA(0, 0), a2, voffA);
            PG8_BAR; PG8_WAIT_L(0); PG8_MMA(1, 0, At, B0); PG8_BAR; PG8_SCHED;
            PG8_STAGE(PG8_SB(0, 1), b2 + hstepB, voffB);
            PG8_WAIT_V(6); PG8_BAR; PG8_MMA(1, 1, At, B1); PG8_BAR;
            PG8_LDB(B0, 1, 0); PG8_SCHED; PG8_LDA(At, 1, 0); PG8_STAGE(PG8_SA(0, 1), a2 + hstepA, voffA);
            PG8_WAIT_L(8); PG8_BAR; PG8_WAIT_L(0); PG8_MMA(0, 0, At, B0); PG8_BAR; PG8_SCHED;
            PG8_LDB(B1, 1, 1); PG8_STAGE(PG8_SB(1, 0), b3, voffB);
            PG8_BAR; PG8_WAIT_L(0); PG8_MMA(0, 1, At, B1); PG8_BAR;
            PG8_LDA(At, 1, 1); PG8_STAGE(PG8_SA(1, 0), a3, voffA);
            PG8_BAR; PG8_WAIT_L(0); PG8_MMA(1, 0, At, B0); PG8_BAR; PG8_SCHED;
            PG8_STAGE(PG8_SB(1, 1), b3 + hstepB, voffB);
            PG8_WAIT_V(6); PG8_BAR; PG8_MMA(1, 1, At, B1); PG8_BAR;
            }
        }
        if constexpr (ALIGN_EPI) { if (wr == 0) PG8_BAR; }
        if constexpr (!Epi::AFTER_DRAIN) { E(acc, cur, wr, wc, fr, fq); S.done(cur); }
        if (!has_next) break;
#pragma unroll
        for (int a = 0; a < 2; ++a)
#pragma unroll
            for (int b = 0; b < 2; ++b)
#pragma unroll
                for (int m = 0; m < 4; ++m)
#pragma unroll
                    for (int n = 0; n < 2; ++n) acc[a][b][m][n] = (f32x4){0.f, 0.f, 0.f, 0.f};
        cur = nxt; cA = nA; cB = nB; ++ui;
        if constexpr (ALIGN_EPI) { if (wr == 1) PG8_BAR; }
    }
    PG8_WAIT_V(0);
    if constexpr (!ALIGN_EPI) { if (wr == 0) PG8_BAR; }
    PG8_BAR;
    if constexpr (Epi::AFTER_DRAIN) { E.fused(acc, cur, wr, wc, fr, fq, lds, wid, lane); S.done(cur); }
#undef PG8_SA
#undef PG8_SB
#undef PG8_STAGE
#undef PG8_LDA
#undef PG8_LDB
#undef PG8_MMA
#undef PG8_WAIT_V
#undef PG8_WAIT_L
#undef PG8_BAR
#undef PG8_SCHED
}
}

#define PG8_SP2 true
#define PG8_ALIGN true

constexpr int RING_OFF = 0, RING_BYTES = 131072;
constexpr int LDSCTL_OFF = 141312  , MISC_OFF = LDSCTL_OFF + 320;
constexpr int LDS_BYTES = 147456;

#define GAS __attribute__((address_space(1)))
#define LAS __attribute__((address_space(3)))
typedef unsigned short bf16;
typedef unsigned v4u __attribute__((ext_vector_type(4)));
typedef unsigned v2u __attribute__((ext_vector_type(2)));
typedef float f32x4 __attribute__((ext_vector_type(4)));
typedef short bf16x8 __attribute__((ext_vector_type(8)));
typedef GAS unsigned gu32;
typedef GAS unsigned long long gu64;
#define RLX_AGENT __ATOMIC_RELAXED, __HIP_MEMORY_SCOPE_AGENT
#define LDS_WAIT() asm volatile("s_waitcnt lgkmcnt(0)" ::: "memory")
#define VM_WAIT() asm volatile("s_waitcnt vmcnt(0)" ::: "memory")
__device__ __forceinline__ unsigned f2bf(float f) { unsigned u = __builtin_bit_cast(unsigned, f); return (u + 0x7fffu + ((u >> 16) & 1u)) >> 16; }
__device__ __forceinline__ unsigned pk2(float lo, float hi) { return f2bf(lo) | (f2bf(hi) << 16); }
__device__ __forceinline__ float bflo(unsigned w) { return __uint_as_float(w << 16); }
__device__ __forceinline__ float bfhi(unsigned w) { return __uint_as_float(w & 0xffff0000u); }
__device__ __forceinline__ float h2f_lo(unsigned w) { typedef _Float16 h2 __attribute__((ext_vector_type(2))); return (float)__builtin_bit_cast(h2, w).x; }
__device__ __forceinline__ float h2f_hi(unsigned w) { typedef _Float16 h2 __attribute__((ext_vector_type(2))); return (float)__builtin_bit_cast(h2, w).y; }

#define XB_TMO      128
#define XB_XCNT(j)  (256  + 64 * (j))
#define XB_XSUB(j)  (1280 + 64 * (j))
#define XB_XGEN(j)  (2304 + 64 * (j))
#define XB_TOP      3328
#define XB_TOPGEN   3392
#define XCD_BAR_WORDS 3456
#define XB_SPIN_CAP (1u << 18)

__device__ __forceinline__ unsigned xb_ld(unsigned* p)              { return __hip_atomic_load(p, __ATOMIC_RELAXED, __HIP_MEMORY_SCOPE_AGENT); }
__device__ __forceinline__ unsigned xb_add(unsigned* p, unsigned v) { return __hip_atomic_fetch_add(p, v, __ATOMIC_RELAXED, __HIP_MEMORY_SCOPE_AGENT); }
__device__ __forceinline__ unsigned xb_xcc_id() { return (unsigned)__builtin_amdgcn_s_getreg((3 << 11) | 20) & 0xFu; }
#define XB_SPIN(cond, bar) do { unsigned _sp = 0; while (cond) { __builtin_amdgcn_s_sleep(1); \
    if ((++_sp & 255u) == 0u) { if (xb_ld(&(bar)[XB_TMO])) break; if (_sp > XB_SPIN_CAP) { atomicAdd(&(bar)[XB_TMO], 1u); break; } } } } while (0)

__device__ __forceinline__ int lane_now() { int l; asm volatile("v_mbcnt_lo_u32_b32 %0, -1, 0\n\tv_mbcnt_hi_u32_b32 %0, -1, %0" : "=v"(l)); return l; }
struct XcdBarrier { unsigned* bar; unsigned x; volatile LAS unsigned* st; int wave0; };

__device__ __forceinline__ XcdBarrier xcd_barrier_post(unsigned* bar, volatile LAS unsigned* st) {
    XcdBarrier b; b.bar = bar; b.x = xb_xcc_id(); b.st = st; b.wave0 = __builtin_amdgcn_readfirstlane(threadIdx.x >> 6);
    if (threadIdx.x == 0) (void)xb_add(&bar[XB_XCNT(b.x)], 1u);
    return b;
}
__device__ __forceinline__ void xcd_barrier_complete(unsigned* bar, unsigned x, unsigned& nloc, unsigned& nx) {
    const unsigned G = gridDim.x * gridDim.y * gridDim.z;
    unsigned sum, cnt, mine, sp = 0u;
    for (;;) {
        sum = 0u; cnt = 0u; mine = 0u;
#pragma unroll
        for (unsigned j = 0; j < 16; ++j) { const unsigned c = xb_ld(&bar[XB_XCNT(j)]); sum += c; cnt += (c > 0u) ? 1u : 0u; mine = (j == x) ? c : mine; }
        if (sum == G) break;
        __builtin_amdgcn_s_sleep(1);
        if ((++sp & 255u) == 0u) { if (xb_ld(&bar[XB_TMO])) break; if (sp > XB_SPIN_CAP) { atomicAdd(&bar[XB_TMO], 1u); break; } }
    }
    nloc = mine > 0u ? mine : 1u; nx = cnt > 0u ? cnt : 1u;
}
__device__ __forceinline__ void xcd_barrier_census(const XcdBarrier& b) {
    if (b.wave0 == 0 && lane_now() == 0) { unsigned nloc, nx; xcd_barrier_complete(b.bar, b.x, nloc, nx); b.st[0] = nloc; b.st[1] = nx; }
}
__device__ __forceinline__ void xcd_barrier(const XcdBarrier& b) {
    asm volatile("s_waitcnt vmcnt(0)" ::: "memory");
    __syncthreads();
    if (b.wave0 == 0 && lane_now() == 0) {
        unsigned* bar = b.bar;
        __builtin_amdgcn_s_waitcnt(0);
        const unsigned nloc = b.st[0], nx = b.st[1];
        const unsigned old = xb_add(&bar[XB_XSUB(b.x)], 1u);
        const unsigned gen = old / nloc;
        if (old + 1u == (gen + 1u) * nloc) {
            __builtin_amdgcn_fence(__ATOMIC_RELEASE, "agent");
            asm volatile("s_waitcnt vmcnt(0)" ::: "memory");
            const unsigned og = xb_add(&bar[XB_TOP], 1u);
            const unsigned tg = og / nx;
            if (og + 1u == (tg + 1u) * nx) xb_add(&bar[XB_TOPGEN], 1u);
            else XB_SPIN(xb_ld(&bar[XB_TOPGEN]) == tg, bar);
            __builtin_amdgcn_fence(__ATOMIC_ACQUIRE, "agent");
            xb_add(&bar[XB_XGEN(b.x)], 1u);
            asm volatile("s_waitcnt vmcnt(0)" ::: "memory");
        } else {
            XB_SPIN(xb_ld(&bar[XB_XGEN(b.x)]) == gen, bar);
            __builtin_amdgcn_fence(__ATOMIC_ACQUIRE, "agent");
            asm volatile("s_waitcnt vmcnt(0)" ::: "memory");
        }
    }
    __syncthreads();
}

struct Frame {
    LAS unsigned char* lds;
    volatile LAS unsigned* MISC;
    gu32* ctl;
    int tid, lane, wave, wave0;
    int G, bid;
};
#define REFRESH_IDS(F) do { int w_ = (F).wave0; asm volatile("" : "+s"(w_)); int l_ = lane_now(); asm volatile("" : "+v"(l_)); (F).wave = w_; (F).lane = l_; (F).tid = w_ * 64 + l_; \
    int b_ = blockIdx.x, g_ = gridDim.x; asm volatile("" : "+s"(b_), "+s"(g_)); (F).bid = b_; (F).G = g_; } while (0)

__device__ __forceinline__ float shfl_x(float v, int o, int lane) { return __int_as_float(__builtin_amdgcn_ds_bpermute((lane ^ o) << 2, __float_as_int(v))); }
__device__ __forceinline__ float wave_sum(float v, int lane) {
#pragma unroll
    for (int o = 1; o < 64; o <<= 1) v += shfl_x(v, o, lane);
    return v;
}
__device__ __forceinline__ void p0_transpose_item(const float* W, int K, int N, bf16* WT, LAS float* scr, int item, int lane) {
    const int nblk = N / 32, kb = item / nblk, nb = item % nblk, k0 = 64 * kb, n0 = 32 * nb;
#pragma unroll 8
    for (int i = 0; i < 32; ++i) { const int kk = 2 * i + (lane >> 5); scr[kk * 33 + (lane & 31)] = W[(size_t)(k0 + kk) * N + n0 + (lane & 31)]; }
    LDS_WAIT(); asm volatile("" ::: "memory");
    const int c = lane & 7;
#pragma unroll
    for (int j = 0; j < 4; ++j) { const int n = (lane >> 3) + 8 * j; const LAS float* s = scr + (8 * c) * 33 + n;
        v4u o; o.x = pk2(s[0 * 33], s[1 * 33]); o.y = pk2(s[2 * 33], s[3 * 33]); o.z = pk2(s[4 * 33], s[5 * 33]); o.w = pk2(s[6 * 33], s[7 * 33]);
        *(GAS v4u*)(WT + (size_t)(n0 + n) * K + k0 + 8 * c) = o; }
    LDS_WAIT(); asm volatile("" ::: "memory");
}

__device__ __forceinline__ void p0_prologue(Frame& F) {
    REFRESH_IDS(F);
    const KArgs ka = kargs(); const float* P_hlb = ka->in[IN_HLB]; float* P_lb = (float*)(ka->ws + WS_LB); const float* P_adaw = ka->in[IN_ADAW]; const float* P_adab = ka->in[IN_ADAB]; const float* P_c = ka->in[IN_C]; float* P_mod = (float*)(ka->ws + WS_MOD);
    const int gw = F.bid * NWAVES + F.wave, NGW = F.G * NWAVES;
    if (F.bid == 0) for (int j = F.tid; j < 1024; j += NWAVES * 64) { const float a0 = P_hlb[j], a1 = P_hlb[1024 + j]; P_lb[j] = 0.f; P_lb[1024 + j] = 1.0f / (1.0f + __expf(a0 - a1)); }
    constexpr int AITEMS = DEPTH * (3 * D / 8);
    for (int it = NGW - 1 - gw; it < AITEMS; it += NGW) {
        const int l = it / (3 * D / 8), n0 = (it % (3 * D / 8)) * 8;
        float acc[16][8];
#pragma unroll
        for (int b = 0; b < 16; ++b)
#pragma unroll
            for (int j = 0; j < 8; ++j) acc[b][j] = 0.f;
        for (int i = 0; i < 16; ++i) {
            const int k = F.lane + 64 * i;
            const float* wp = P_adaw + ((size_t)l * D + k) * (3 * D) + n0;
            const f32x4 w0 = *(const f32x4*)wp, w1 = *(const f32x4*)(wp + 4);
#pragma unroll
            for (int b = 0; b < 16; ++b) { const float cv = P_c[b * D + k], s = cv * __builtin_amdgcn_rcpf(1.0f + __expf(-cv));
#pragma unroll
                for (int j = 0; j < 4; ++j) { acc[b][j] += s * w0[j]; acc[b][4 + j] += s * w1[j]; } }
        }
        float* av = &acc[0][0];
#define TR_STEP(N, OFF) _Pragma("unroll") for (int i = 0; i < (N) / 2; ++i) { const bool up = (F.lane & (OFF)) != 0; const float keep = up ? av[i + (N) / 2] : av[i], send = up ? av[i] : av[i + (N) / 2]; av[i] = keep + shfl_x(send, (OFF), F.lane); }
        TR_STEP(128, 32) TR_STEP(64, 16) TR_STEP(32, 8) TR_STEP(16, 4) TR_STEP(8, 2) TR_STEP(4, 1)
#undef TR_STEP
        { const int b = F.lane >> 2, j = (F.lane & 3) * 2; const float* bp = P_adab + l * 3 * D + n0 + j;
          float* mp = P_mod + ((size_t)l * BATCH + b) * (3 * D) + n0 + j; mp[0] = av[0] + bp[0]; mp[1] = av[1] + bp[1]; }
    }
}

__device__ __forceinline__ void p1_fold_tile(Frame& F, const float* w_in, const float* pool_w, bf16* WIN, const int tile) {
    const int nb = tile & 1, kb = (tile >> 1) & 15, g = (tile >> 5) & 3, l = tile >> 7;
    LAS float* As = (LAS float*)(F.lds + RING_OFF);
    LAS float* Bs = As + 64 * 132;
    const int ty = F.tid >> 5, tx = F.tid & 31;
    float acc[4][4];
#pragma unroll
    for (int i = 0; i < 4; ++i)
#pragma unroll
        for (int j = 0; j < 4; ++j) acc[i][j] = 0.f;
    const float* Ag = w_in + ((size_t)l * D + kb * 64) * NZ + g * 256;
    const float* Bg = pool_w + ((size_t)(l * 4 + g) * 256) * 256 + nb * 128;
    for (int ch = 0; ch < 2; ++ch) {
        { const int r = F.tid >> 3, c4 = (F.tid & 7) * 16;
#pragma unroll
          for (int j = 0; j < 4; ++j) *(LAS f32x4*)(As + r * 132 + c4 + 4 * j) = *(const GAS f32x4*)(Ag + (size_t)r * NZ + ch * 128 + c4 + 4 * j); }
        { const int r = F.tid >> 2, c4 = (F.tid & 3) * 32;
#pragma unroll
          for (int j = 0; j < 8; ++j) *(LAS f32x4*)(Bs + r * 128 + c4 + 4 * j) = *(const GAS f32x4*)(Bg + (size_t)(ch * 128 + r) * 256 + c4 + 4 * j); }
        __syncthreads();
#pragma unroll 4
        for (int c = 0; c < 128; c += 4) {
            f32x4 a[4], bq[4];
#pragma unroll
            for (int i = 0; i < 4; ++i) a[i] = *(const LAS f32x4*)(As + (4 * ty + i) * 132 + c);
#pragma unroll
            for (int q = 0; q < 4; ++q) bq[q] = *(const LAS f32x4*)(Bs + (c + q) * 128 + 4 * tx);
#pragma unroll
            for (int i = 0; i < 4; ++i)
#pragma unroll
                for (int q = 0; q < 4; ++q)
#pragma unroll
                    for (int j = 0; j < 4; ++j) acc[i][j] += a[i][q] * bq[q][j];
        }
        __syncthreads();
    }
#pragma unroll
    for (int j = 0; j < 4; ++j) { v2u o; o.x = pk2(acc[0][j], acc[1][j]); o.y = pk2(acc[2][j], acc[3][j]);
        *(GAS v2u*)(WIN + ((size_t)l * NZ + g * 256 + nb * 128 + 4 * tx + j) * D + kb * 64 + 4 * ty) = o; }
}
__device__ __forceinline__ void weights_prep(Frame& F, const int l, const int lo_out, const int hi_out, const int first, const int count) {
    const KArgs ka = kargs(); const float* P_win = ka->in[IN_WIN]; const float* P_wout = ka->in[IN_WOUT]; const float* P_poolw = ka->in[IN_POOLW]; bf16* P_WIN = (bf16*)(ka->ws + WS_WIN); bf16* P_WOUT = (bf16*)(ka->ws + WS_WOUT);
    const int rb = F.bid - first;
    if (rb < 0 || rb >= count) return;
    constexpr int NTILE = 4 * 16 * 2;
    const int nf = count >= 2 * NTILE ? NTILE : count;
    if (rb < nf) for (int tile = rb; tile < NTILE; tile += nf) p1_fold_tile(F, P_win, P_poolw, P_WIN, l * NTILE + tile);
    LAS float* scr = (LAS float*)(F.lds + RING_OFF + F.wave * 16384);
    constexpr int NB_IN = (NZ - D) / 32;
    constexpr int I_IN = (D / 64) * NB_IN, I_OUT = (MIXW / 64) * (D / 32);
    const int nw_ = count * NWAVES, rw = ((rb + count - nf) % count) * NWAVES + F.wave;
    for (int q = rw; q < I_IN; q += nw_) { const int kb = q / NB_IN, nb = q % NB_IN + D / 32;
        p0_transpose_item(P_win + (size_t)l * D * NZ, D, NZ, P_WIN + (size_t)l * NZ * D, scr, kb * (NZ / 32) + nb, F.lane); }
    const int gw = rb * NWAVES + F.wave;
    for (int r = gw; r < (hi_out - lo_out) * I_OUT; r += nw_) { const int lo_ = lo_out + r / I_OUT;
        p0_transpose_item(P_wout + (size_t)lo_ * MIXW * D, MIXW, D, P_WOUT + (size_t)lo_ * D * MIXW, scr, r % I_OUT, F.lane); }
}

__device__ __forceinline__ void rowpass(Frame& F, int l) {
    REFRESH_IDS(F);
    const KArgs ka = kargs(); const float* P_x = ka->in[IN_X]; float* P_out = ka->out; bf16* P_Y = (bf16*)(ka->ws + WS_Y); float* P_mod = (float*)(ka->ws + WS_MOD); const float* P_npost = ka->in[IN_NPOST]; const float* P_npre = ka->in[IN_NPRE]; bf16* P_XN = (bf16*)(ka->ws + WS_XN);
    const int gw = F.bid * NWAVES + F.wave, NGW = F.G * NWAVES;
    const int ln = l + 1;
    for (int m = gw; m < M; m += NGW) {
        const int b = m / SEQ;
        f32x4 v[4];
        const float* xin = (l <= 0 ? P_x : (const float*)P_out) + (size_t)m * D;
#pragma unroll
        for (int j = 0; j < 4; ++j) v[j] = *((const GAS f32x4*)xin + F.lane + 64 * j);
        if (l >= 0) {
            const GAS v2u* yr = (const GAS v2u*)(P_Y + (size_t)m * D) + F.lane;
            f32x4 y[4]; float ss = 0.f;
#pragma unroll
            for (int j = 0; j < 4; ++j) { const v2u w = yr[64 * j]; y[j] = (f32x4){bflo(w.x), bfhi(w.x), bflo(w.y), bfhi(w.y)}; ss += (y[j].x * y[j].x + y[j].y * y[j].y) + (y[j].z * y[j].z + y[j].w * y[j].w); }
            const float r = __builtin_amdgcn_rsqf(wave_sum(ss, F.lane) * (1.f / D) + EPS);
            const float* gate = P_mod + ((size_t)l * BATCH + b) * (3 * D) + 2 * D;
            const float* wp = P_npost + l * D;
#pragma unroll
            for (int j = 0; j < 4; ++j) { const f32x4 g = *((const f32x4*)gate + F.lane + 64 * j), w = *((const f32x4*)wp + F.lane + 64 * j); v[j] = v[j] + g * (y[j] * r * w);
                *((GAS f32x4*)(P_out + (size_t)m * D) + F.lane + 64 * j) = v[j]; }
        }
        if (ln < DEPTH) {
            float ss = 0.f;
#pragma unroll
            for (int j = 0; j < 4; ++j) ss += (v[j].x * v[j].x + v[j].y * v[j].y) + (v[j].z * v[j].z + v[j].w * v[j].w);
            const float r = __builtin_amdgcn_rsqf(wave_sum(ss, F.lane) * (1.f / D) + EPS);
            const float* shift = P_mod + ((size_t)ln * BATCH + b) * (3 * D); const float* scale = shift + D; const float* wp = P_npre + ln * D;
            GAS v2u* o = (GAS v2u*)(P_XN + (size_t)m * D) + F.lane;
#pragma unroll
            for (int j = 0; j < 4; ++j) { const f32x4 sh = *((const f32x4*)shift + F.lane + 64 * j), sc = *((const f32x4*)scale + F.lane + 64 * j), w = *((const f32x4*)wp + F.lane + 64 * j);
                const f32x4 h = v[j] * r * w * (sc + 1.0f) + sh; v2u pw; pw.x = pk2(h.x, h.y); pw.y = pk2(h.z, h.w); o[64 * j] = pw; }
        }
    }
}

__device__ __forceinline__ void pool_pass(Frame& F, const int l, const int first, const int count) {
    const KArgs ka = kargs(); const bf16* U = (const bf16*)(ka->ws + WS_U); bf16* MIXp = (bf16*)(ka->ws + WS_MIX); const float* ps = ka->in[IN_PSCALE] + l * 1024;
    constexpr int RUN = 64;
    const int c8 = (F.tid & 127) * 8, w = 2 << (c8 >> 8);
    f32x4 sc0 = *(const f32x4*)(ps + c8), sc1 = *(const f32x4*)(ps + c8 + 4);
    for (int it = first; it < M / RUN / 4; it += count) {
        const int t0 = (it * 4 + (F.tid >> 7)) * RUN, tp0 = t0 & (SEQ - 1);
        const GAS v4u* up = (const GAS v4u*)(U + (size_t)t0 * D + c8);
        GAS v4u* gp = (GAS v4u*)(MIXp + (size_t)t0 * MIXW + c8);
        float s[8];
#pragma unroll
        for (int e = 0; e < 8; ++e) s[e] = 0.f;
        for (int i = 1; i <= 16; ++i) if (i <= w && tp0 - i >= 0) { const v4u x = up[-(long)i * (D / 8)];
            s[0] += bflo(x.x); s[1] += bfhi(x.x); s[2] += bflo(x.y); s[3] += bfhi(x.y); s[4] += bflo(x.z); s[5] += bfhi(x.z); s[6] += bflo(x.w); s[7] += bfhi(x.w); }
#pragma unroll 8
        for (int r = 0; r < RUN; ++r) {
            const int tp = tp0 + r; const bool sub = tp >= w;
            const v4u x = up[(long)r * (D / 8)], gq = gp[(long)r * (MIXW / 8)];
            v4u y = (v4u){0u, 0u, 0u, 0u}; if (sub) y = up[(long)(r - w) * (D / 8)];
            const float xv[8] = {bflo(x.x), bfhi(x.x), bflo(x.y), bfhi(x.y), bflo(x.z), bfhi(x.z), bflo(x.w), bfhi(x.w)};
            const float yv[8] = {bflo(y.x), bfhi(y.x), bflo(y.y), bfhi(y.y), bflo(y.z), bfhi(y.z), bflo(y.w), bfhi(y.w)};
            const float gv[8] = {bflo(gq.x), bfhi(gq.x), bflo(gq.y), bfhi(gq.y), bflo(gq.z), bfhi(gq.z), bflo(gq.w), bfhi(gq.w)};
            const float inv = 1.0f / (float)(tp + 1 < w ? tp + 1 : w);
            float o[8];
#pragma unroll
            for (int e = 0; e < 8; ++e) { s[e] += xv[e] - yv[e]; o[e] = (s[e] * inv - xv[e]) * (e < 4 ? sc0[e] : sc1[e - 4]) * gv[e]; }
            v4u ov; ov.x = pk2(o[0], o[1]); ov.y = pk2(o[2], o[3]); ov.z = pk2(o[4], o[5]); ov.w = pk2(o[6], o[7]);
            gp[(long)r * (MIXW / 8)] = ov;
        }
    }
}

__device__ __forceinline__ void hgrn_naive(Frame& F, int l) {
    REFRESH_IDS(F);
    const KArgs ka = kargs(); const float* P_hnw = ka->in[IN_HNW]; bf16* P_Q = (bf16*)(ka->ws + WS_Q); bf16* P_LF = (bf16*)(ka->ws + WS_LF); bf16* P_V = (bf16*)(ka->ws + WS_V); bf16* P_MIX = (bf16*)(ka->ws + WS_MIX);
    LAS float* qs = (LAS float*)(F.lds + RING_OFF);
    LAS float* fs = qs + 2048; LAS float* ks = fs + 2048; LAS float* vs = ks + 2048;
    LAS float* part = vs + 2048;
    const int v = F.tid & 127, kg = F.tid >> 7;
    const float* nw = P_hnw + l * HD;
    for (int unit = F.bid; unit < BATCH * NHEAD; unit += F.G) {
        const int b = unit / NHEAD, h = unit % NHEAD;
        float S[32];
#pragma unroll
        for (int i = 0; i < 32; ++i) S[i] = 0.f;
        const size_t rb = (size_t)b * SEQ;
        for (int t0 = 0; t0 < SEQ; t0 += 16) {
            { const int tt = F.tid >> 5, ch = (F.tid & 31) * 4; const size_t off = (rb + t0 + tt) * D + h * HD + ch;
              const v2u qw = *(const GAS v2u*)(P_Q + off), lw = *(const GAS v2u*)(P_LF + off), vw = *(const GAS v2u*)(P_V + off);
              const float lf[4] = {h2f_lo(lw.x), h2f_hi(lw.x), h2f_lo(lw.y), h2f_hi(lw.y)};
              const float qq[4] = {bflo(qw.x), bfhi(qw.x), bflo(qw.y), bfhi(qw.y)}, vv[4] = {bflo(vw.x), bfhi(vw.x), bflo(vw.y), bfhi(vw.y)};
#pragma unroll
              for (int e = 0; e < 4; ++e) { const float f = __expf(lf[e]); fs[tt * 128 + ch + e] = f; ks[tt * 128 + ch + e] = 1.0f - f; qs[tt * 128 + ch + e] = qq[e]; vs[tt * 128 + ch + e] = vv[e]; } }
            __syncthreads();
            for (int tt = 0; tt < 16; ++tt) {
                const float vv = vs[tt * 128 + v]; float po = 0.f;
#pragma unroll
                for (int i = 0; i < 32; ++i) { const float f = fs[tt * 128 + kg * 32 + i], k = ks[tt * 128 + kg * 32 + i], q = qs[tt * 128 + kg * 32 + i]; S[i] = f * S[i] + k * vv; po += q * S[i]; }
                part[(tt * 4 + kg) * 128 + v] = po;
            }
            __syncthreads();
#pragma unroll
            for (int e = 0; e < 2; ++e) { const int tt = F.wave * 2 + e;
                float o0 = 0.f, o1 = 0.f;
#pragma unroll
                for (int k4 = 0; k4 < 4; ++k4) { o0 += part[(tt * 4 + k4) * 128 + F.lane]; o1 += part[(tt * 4 + k4) * 128 + 64 + F.lane]; }
                const float r = __builtin_amdgcn_rsqf(wave_sum(o0 * o0 + o1 * o1, F.lane) * (1.f / HD) + EPS);
                GAS bf16* gp = (GAS bf16*)(P_MIX + (rb + t0 + tt) * MIXW + D + h * HD);
                const float g0 = __uint_as_float((unsigned)gp[F.lane] << 16), g1 = __uint_as_float((unsigned)gp[64 + F.lane] << 16);
                gp[F.lane] = (bf16)f2bf(o0 * r * nw[F.lane] * g0); gp[64 + F.lane] = (bf16)f2bf(o1 * r * nw[64 + F.lane] * g1); }
        }
        __syncthreads();
    }
}

namespace hg {
typedef short bf16x8 __attribute__((ext_vector_type(8)));
typedef short s16x4 __attribute__((ext_vector_type(4)));
typedef float f32x4 __attribute__((ext_vector_type(4)));
typedef float f32x2 __attribute__((ext_vector_type(2)));
typedef unsigned u32x2 __attribute__((ext_vector_type(2)));
typedef unsigned u32x4 __attribute__((ext_vector_type(4)));
typedef __bf16 bf16x2_t __attribute__((ext_vector_type(2)));
constexpr int L_QT = 0, L_QB = 16384, L_K1 = 24576, L_K2 = 32768, L_KH = 49152  , L_V = 67584  , L_P = 86016  ,
              L_DEC = 92160  , L_TOT = 92672  , L_SSQ = 96768  , L_RAWQ = 99328  , L_RAWL = 115712  , L_END = 132096;
constexpr int L_PATCH = 0, PATCH_BYTES = 5120, PSTR = 80;
constexpr int VSTR = 288;
__device__ __forceinline__ unsigned cvtpk(float lo, float hi) { f32x2 v = {lo, hi}; bf16x2_t b = __builtin_convertvector(v, bf16x2_t); return __builtin_bit_cast(unsigned, b); }
__device__ __forceinline__ int perm32x(int x) { return 8 * ((x >> 2) & 3) + 4 * (x >> 4) + (x & 3); }
__device__ __forceinline__ bf16x8 ld128(const LAS unsigned char* p) { return *(const LAS bf16x8*)p; }
__device__ __forceinline__ s16x4 ldtr(const LAS unsigned char* p) { typedef short v4i16_t __attribute__((ext_vector_type(4))); return __builtin_bit_cast(s16x4, __builtin_amdgcn_ds_read_tr16_b64_v4i16((LAS v4i16_t*)p)); }
__device__ __forceinline__ bf16x8 cat(s16x4 a, s16x4 b) { return (bf16x8){a[0], a[1], a[2], a[3], b[0], b[1], b[2], b[3]}; }
#define HG_DPP(v, ctrl) __int_as_float(__builtin_amdgcn_update_dpp(0, __float_as_int(v), (ctrl), 0xf, 0xf, true))
__device__ __forceinline__ float row16_sum(float v) {
    v += HG_DPP(v, 0xB1); v += HG_DPP(v, 0x4E); v += HG_DPP(v, 0x141); v += HG_DPP(v, 0x140); return v;
}
#ifdef PROBE_SEG
#define HG_SEG(k) do { if (probe) { const unsigned long long now_ = __builtin_amdgcn_s_memrealtime(); volatile LAS unsigned long long* pa_ = (volatile LAS unsigned long long*)(lds + 141312 + 2048); pa_[k] += now_ - pa_[15]; pa_[15] = now_; } } while (0)
#else
#define HG_SEG(k) do { } while (0)
#endif
#define HG_LBAR() do { asm volatile("s_waitcnt lgkmcnt(0)" ::: "memory"); __builtin_amdgcn_s_barrier(); asm volatile("" ::: "memory"); } while (0)

__device__ __forceinline__ void hgrn_unit(LAS unsigned char* lds, const int tid, const int lane, const int wave, const int b, const int h,
                                          const bf16* Qg, const bf16* LFg, const bf16* Vg, bf16* MIXg, const float* nw) {
    const int c16 = lane & 15, g = lane >> 4, cp = lane, tg = wave;
    const int c0 = 2 * cp, pcl = perm32x(c0 & 31), pcg = c0 >> 5;
    const size_t rowbase = (size_t)b * SEQ;
    const char* Qd = (const char*)(Qg + (rowbase + 8 * wave + (lane >> 4)) * D + h * HD) + (lane & 15) * 16;
    const char* Ld = (const char*)(LFg + (rowbase + 8 * wave + (lane >> 4)) * D + h * HD) + (lane & 15) * 16;
    const GAS u32x4* Vp = (const GAS u32x4*)(Vg + (rowbase + (tid >> 3)) * D + h * HD + (tid & 7) * 16);
    GAS u32x4* Gq = (GAS u32x4*)(MIXg + (rowbase + lane) * MIXW + D + h * HD + 16 * wave);
    const float nwv = nw[16 * wave + c16];
    const int ew = ((tg >> 1) * 4 + pcg) * 1024 + (((tg & 1) * 512 + pcl * 2) ^ ((tg & 1) * 32));
    const int ewb = (((tg & 3) >> 1) * 4 + pcg) * 1024 + (((tg & 1) * 512 + pcl * 2) ^ ((tg & 1) * 32));
    const int ekh = (8 * tg) * VSTR + c0 * 2;
    const int evw = (tid >> 3) * VSTR + (tid & 7) * 32;
    const int lo = (c16 * 64 + 16 * g) ^ ((c16 >> 3) << 5);
    const int trq = (c16 >> 2) * VSTR + (c16 & 3) * 8 + (4 * g) * VSTR;
    f32x4 S[8];
#pragma unroll
    for (int i = 0; i < 8; ++i) S[i] = (f32x4){0.f, 0.f, 0.f, 0.f};
#ifdef PROBE_SEG
    const bool probe = (blockIdx.x == 0 && tid == 0);
    if (probe) ((volatile LAS unsigned long long*)(lds + 141312 + 2048))[15] = __builtin_amdgcn_s_memrealtime();
#endif
    if (wave == 0) { *(LAS u32x2*)(lds + L_P + 0 * 1024 + lane * 16 + 8) = (u32x2){0u, 0u}; *(LAS u32x2*)(lds + L_P + 3 * 1024 + lane * 16 + 8) = (u32x2){0u, 0u}; }
    u32x4 vr[2], gq[2];
#define HG_LOADS(c) do { _Pragma("unroll") for (int j = 0; j < 2; ++j) { \
        __builtin_amdgcn_global_load_lds((const unsigned*)(Qd + ((size_t)(c) * 64 + 4 * j) * (D * 2)), (LAS unsigned*)(lds + L_RAWQ + (8 * wave + 4 * j) * 256), 16, 0, 0); \
        __builtin_amdgcn_global_load_lds((const unsigned*)(Ld + ((size_t)(c) * 64 + 4 * j) * (D * 2)), (LAS unsigned*)(lds + L_RAWL + (8 * wave + 4 * j) * 256), 16, 0, 0); } \
        vr[0] = Vp[(size_t)(c) * 64 * (D / 8)]; vr[1] = Vp[(size_t)(c) * 64 * (D / 8) + 1]; } while (0)
    HG_LOADS(0);
#pragma unroll 1
    for (int c = 0; c < SEQ / 64; ++c) {
        asm volatile("s_waitcnt vmcnt(0)" ::: "memory");
        *(LAS u32x4*)(lds + L_V + evw) = vr[0]; *(LAS u32x4*)(lds + L_V + evw + 16) = vr[1];
        HG_LBAR();
        unsigned qr[8]; float f0[8], f1[8], P0[8], P1[8]; float a0 = 0.f, a1 = 0.f, r0 = 1.f, r1 = 1.f;
#pragma unroll
        for (int i = 0; i < 8; ++i) { const unsigned lw = *(const LAS unsigned*)(lds + L_RAWL + (8 * tg + i) * 256 + cp * 4); qr[i] = *(const LAS unsigned*)(lds + L_RAWQ + (8 * tg + i) * 256 + cp * 4);
            const float l0 = h2f_lo(lw), l1 = h2f_hi(lw); a0 += l0; a1 += l1; f0[i] = __expf(l0); f1[i] = __expf(l1); r0 *= f0[i]; r1 *= f1[i]; P0[i] = r0; P1[i] = r1; }
        *(LAS f32x2*)(lds + L_TOT + (tg * 128 + c0) * 4) = (f32x2){a0, a1};
        HG_LBAR();
        HG_SEG(0);
        float off0 = 0.f, off1 = 0.f, R0 = 0.f, R1 = 0.f, L0 = 0.f, L1 = 0.f;
#pragma unroll
        for (int j = 0; j < 8; ++j) { const f32x2 t = *(const LAS f32x2*)(lds + L_TOT + (j * 128 + c0) * 4);
            if (j < tg) { off0 += t.x; off1 += t.y; } if (j < 4) { R0 += t.x; R1 += t.y; } L0 += t.x; L1 += t.y; }
        const float eR0 = __expf(R0), eR1 = __expf(R1), eLR0 = __expf(L0 - R0), eLR1 = __expf(L1 - R1);
        if (tg == 0) *(LAS f32x2*)(lds + L_DEC + c0 * 4) = (f32x2){__expf(L0), __expf(L1)};
        constexpr float BIG = 5.5e34f;
        if (tg >= 4) {
            const float b0 = __expf(off0 - R0), b1 = __expf(off1 - R1);
#pragma unroll
            for (int i = 0; i < 8; ++i) {
                const float q0 = bflo(qr[i]), q1 = bfhi(qr[i]), k0 = 1.0f - f0[i], k1 = 1.0f - f1[i];
                const float e10 = b0 * P0[i], e11 = b1 * P1[i], e20 = fminf(__builtin_amdgcn_rcpf(e10), BIG), e21 = fminf(__builtin_amdgcn_rcpf(e11), BIG);
                *(LAS unsigned*)(lds + L_QT + ew + 64 * i) = cvtpk(q0 * e10 * eR0, q1 * e11 * eR1);
                *(LAS unsigned*)(lds + L_QB + ewb + 64 * i) = cvtpk(q0 * e10, q1 * e11);
                *(LAS unsigned*)(lds + L_K2 + ew + 64 * i) = cvtpk(k0 * e20, k1 * e21);
                *(LAS unsigned*)(lds + L_KH + ekh + VSTR * i) = cvtpk(k0 * e20 * eLR0, k1 * e21 * eLR1);
            }
        } else {
            const float b0 = __expf(off0), b1 = __expf(off1);
#pragma unroll
            for (int i = 0; i < 8; ++i) {
                const float q0 = bflo(qr[i]), q1 = bfhi(qr[i]), k0 = 1.0f - f0[i], k1 = 1.0f - f1[i];
                const float e00 = b0 * P0[i], e01 = b1 * P1[i], e30 = fminf(__builtin_amdgcn_rcpf(e00), BIG), e31 = fminf(__builtin_amdgcn_rcpf(e01), BIG);
                const float k20 = k0 * e30 * eR0, k21 = k1 * e31 * eR1;
                *(LAS unsigned*)(lds + L_QT + ew + 64 * i) = cvtpk(q0 * e00, q1 * e01);
                *(LAS unsigned*)(lds + L_K1 + ewb + 64 * i) = cvtpk(k0 * e30, k1 * e31);
                *(LAS unsigned*)(lds + L_K2 + ew + 64 * i) = cvtpk(k20, k21);
                *(LAS unsigned*)(lds + L_KH + ekh + VSTR * i) = cvtpk(k20 * eLR0, k21 * eLR1);
            }
        }
        HG_LBAR();
        HG_SEG(1);
        if (c + 1 < SEQ / 64) HG_LOADS(c + 1);
        gq[0] = Gq[(size_t)c * 64 * (MIXW / 8)]; gq[1] = Gq[(size_t)c * 64 * (MIXW / 8) + 1];
#pragma unroll
        for (int rep = 0; rep < 2; ++rep) {
            const int ti = wave + 8 * rep;
            if (ti < 10) {
                const int tb = ti < 1 ? 0 : ti < 3 ? 1 : ti < 6 ? 2 : 3, sb = ti - (tb == 0 ? 0 : tb == 1 ? 1 : tb == 2 ? 3 : 6);
                const LAS unsigned char* kb = lds + (tb < 2 ? L_K1 : L_K2) + sb * 4096 + lo;
                const LAS unsigned char* qb = lds + (tb < 2 ? L_QT + tb * 4096 : L_QB + (tb - 2) * 4096) + lo;
                f32x4 acc = (f32x4){0.f, 0.f, 0.f, 0.f};
#pragma unroll
                for (int ks = 0; ks < 4; ++ks) acc = __builtin_amdgcn_mfma_f32_16x16x32_bf16(ld128(kb + ks * 1024), ld128(qb + ks * 1024), acc, 0, 0, 0);
                if (sb == tb) {
#pragma unroll
                    for (int r = 0; r < 4; ++r) acc[r] = (4 * g + r <= c16) ? acc[r] : 0.f;
                }
                const int fi = tb < 2 ? tb : 2 * tb - 2 + (sb >> 1);
                *(LAS u32x2*)(lds + L_P + fi * 1024 + lane * 16 + 8 * (sb & 1)) = (u32x2){cvtpk(acc[0], acc[1]), cvtpk(acc[2], acc[3])};
            }
        }
        HG_SEG(2);
        bf16x8 vb[2];
#pragma unroll
        for (int kk = 0; kk < 2; ++kk) { const LAS unsigned char* vp = lds + L_V + trq + (32 * kk) * VSTR + (16 * wave) * 2; vb[kk] = cat(ldtr(vp), ldtr(vp + 16 * VSTR)); }
        f32x4 o[4];
#pragma unroll
        for (int tb = 0; tb < 4; ++tb) o[tb] = (f32x4){0.f, 0.f, 0.f, 0.f};
#pragma unroll
        for (int kk = 0; kk < 4; ++kk) {
            const u32x4 sw = (u32x4){cvtpk(S[2 * kk][0], S[2 * kk][1]), cvtpk(S[2 * kk][2], S[2 * kk][3]), cvtpk(S[2 * kk + 1][0], S[2 * kk + 1][1]), cvtpk(S[2 * kk + 1][2], S[2 * kk + 1][3])};
            const bf16x8 sbf = __builtin_bit_cast(bf16x8, sw);
#pragma unroll
            for (int tb = 0; tb < 4; ++tb) o[tb] = __builtin_amdgcn_mfma_f32_16x16x32_bf16(ld128(lds + L_QT + (tb * 4 + kk) * 1024 + lo), sbf, o[tb], 0, 0, 0);
        }
#pragma unroll
        for (int dkb = 0; dkb < 8; ++dkb) {
            const f32x4 dv = *(const LAS f32x4*)(lds + L_DEC + (16 * dkb + 4 * g) * 4);
            f32x4 s = S[dkb] * dv;
#pragma unroll
            for (int kk = 0; kk < 2; ++kk) { const LAS unsigned char* kp = lds + L_KH + trq + (32 * kk) * VSTR + (16 * dkb) * 2;
                s = __builtin_amdgcn_mfma_f32_16x16x32_bf16(cat(ldtr(kp), ldtr(kp + 16 * VSTR)), vb[kk], s, 0, 0, 0); }
            S[dkb] = s;
        }
        HG_LBAR();
        HG_SEG(3);
        o[0] = __builtin_amdgcn_mfma_f32_16x16x32_bf16(ld128(lds + L_P + 0 * 1024 + lane * 16), vb[0], o[0], 0, 0, 0);
        o[1] = __builtin_amdgcn_mfma_f32_16x16x32_bf16(ld128(lds + L_P + 1 * 1024 + lane * 16), vb[0], o[1], 0, 0, 0);
        o[2] = __builtin_amdgcn_mfma_f32_16x16x32_bf16(ld128(lds + L_P + 2 * 1024 + lane * 16), vb[0], o[2], 0, 0, 0);
        o[2] = __builtin_amdgcn_mfma_f32_16x16x32_bf16(ld128(lds + L_P + 3 * 1024 + lane * 16), vb[1], o[2], 0, 0, 0);
        o[3] = __builtin_amdgcn_mfma_f32_16x16x32_bf16(ld128(lds + L_P + 4 * 1024 + lane * 16), vb[0], o[3], 0, 0, 0);
        o[3] = __builtin_amdgcn_mfma_f32_16x16x32_bf16(ld128(lds + L_P + 5 * 1024 + lane * 16), vb[1], o[3], 0, 0, 0);
#pragma unroll
        for (int tb = 0; tb < 4; ++tb) { f32x4 q2 = o[tb] * o[tb];
#pragma unroll
            for (int r = 0; r < 4; ++r) q2[r] = row16_sum(q2[r]);
            if (c16 == 0) *(LAS f32x4*)(lds + L_SSQ + (wave * 64 + 16 * tb + 4 * g) * 4) = q2; }
        HG_LBAR();
        HG_SEG(4);
        { float ss = 0.f;
#pragma unroll
          for (int w2 = 0; w2 < 8; ++w2) ss += *(const LAS float*)(lds + L_SSQ + (w2 * 64 + lane) * 4);
          const float rsv = __builtin_amdgcn_rsqf(ss * (1.0f / HD) + EPS);
          LAS unsigned char* patch = lds + L_PATCH + wave * PATCH_BYTES;
#pragma unroll
          for (int tb = 0; tb < 4; ++tb)
#pragma unroll
              for (int r = 0; r < 4; ++r) *(LAS float*)(patch + (16 * tb + 4 * g + r) * PSTR + c16 * 4) = o[tb][r] * nwv;
          asm volatile("s_waitcnt lgkmcnt(0)" ::: "memory");
          f32x4 pv[4];
#pragma unroll
          for (int j = 0; j < 4; ++j) pv[j] = *(const LAS f32x4*)(patch + lane * PSTR + 16 * j) * rsv;
          u32x4 o0, o1;
          o0.x = pk2(pv[0][0] * bflo(gq[0].x), pv[0][1] * bfhi(gq[0].x)); o0.y = pk2(pv[0][2] * bflo(gq[0].y), pv[0][3] * bfhi(gq[0].y));
          o0.z = pk2(pv[1][0] * bflo(gq[0].z), pv[1][1] * bfhi(gq[0].z)); o0.w = pk2(pv[1][2] * bflo(gq[0].w), pv[1][3] * bfhi(gq[0].w));
          o1.x = pk2(pv[2][0] * bflo(gq[1].x), pv[2][1] * bfhi(gq[1].x)); o1.y = pk2(pv[2][2] * bflo(gq[1].y), pv[2][3] * bfhi(gq[1].y));
          o1.z = pk2(pv[3][0] * bflo(gq[1].z), pv[3][1] * bfhi(gq[1].z)); o1.w = pk2(pv[3][2] * bflo(gq[1].w), pv[3][3] * bfhi(gq[1].w));
          Gq[(size_t)c * 64 * (MIXW / 8)] = o0; Gq[(size_t)c * 64 * (MIXW / 8) + 1] = o1; }
        HG_SEG(5);
    }
#undef HG_LOADS
    HG_LBAR();
}
}


namespace hg2 {
typedef short bf16x8 __attribute__((ext_vector_type(8)));
typedef short s16x4 __attribute__((ext_vector_type(4)));
typedef float f32x4 __attribute__((ext_vector_type(4)));
typedef float f32x2 __attribute__((ext_vector_type(2)));
typedef unsigned u32x2 __attribute__((ext_vector_type(2)));
typedef unsigned u32x4 __attribute__((ext_vector_type(4)));
typedef __bf16 bf16x2_t __attribute__((ext_vector_type(2)));
constexpr int VSTR = 288;
constexpr int SET_BYTES = 16384 + 16384 + 64 * VSTR + 3 * 512;
constexpr int S_QB = 0, S_K2 = 16384, S_V = 32768, S_ER = 32768 + 64 * VSTR, S_ELR = S_ER + 512, S_DEC = S_ER + 1024;
constexpr int L_SET0 = 0, L_SET1 = SET_BYTES;
constexpr int OSTR = 528;
constexpr int L_O = 2 * SET_BYTES, L_SSQ = L_O + 64 * OSTR  , L_NW = L_SSQ + 1024  , L_END = L_NW + 512;
static_assert(L_END <= 141312, "HGRN LDS map must stay below the LDS control words");
__device__ __forceinline__ unsigned cvtpk(float lo, float hi) { f32x2 v = {lo, hi}; bf16x2_t b = __builtin_convertvector(v, bf16x2_t); return __builtin_bit_cast(unsigned, b); }
__device__ __forceinline__ bf16x8 ld128(const LAS unsigned char* p) { return *(const LAS bf16x8*)p; }
__device__ __forceinline__ s16x4 ld64(const LAS unsigned char* p) { return *(const LAS s16x4*)p; }
__device__ __forceinline__ s16x4 ldtr(const LAS unsigned char* p) { typedef short v4i16_t __attribute__((ext_vector_type(4))); return __builtin_bit_cast(s16x4, __builtin_amdgcn_ds_read_tr16_b64_v4i16((LAS v4i16_t*)p)); }
__device__ __forceinline__ bf16x8 cat(s16x4 a, s16x4 b) { return (bf16x8){a[0], a[1], a[2], a[3], b[0], b[1], b[2], b[3]}; }
#define HG_DPP(v, ctrl) __int_as_float(__builtin_amdgcn_update_dpp(0, __float_as_int(v), (ctrl), 0xf, 0xf, true))
__device__ __forceinline__ float row16_sum(float v) { v += HG_DPP(v, 0xB1); v += HG_DPP(v, 0x4E); v += HG_DPP(v, 0x141); v += HG_DPP(v, 0x140); return v; }
#define HG_BAR() do { asm volatile("s_waitcnt lgkmcnt(0)" ::: "memory"); __builtin_amdgcn_s_barrier(); asm volatile("" ::: "memory"); } while (0)
#define MFMA16(a, b, c) __builtin_amdgcn_mfma_f32_16x16x32_bf16((a), (b), (c), 0, 0, 0)

__device__ __forceinline__ void hgrn_unit(LAS unsigned char* lds, const int wave, const int b, const int h,
                                          const bf16* Qg, const bf16* LFg, const bf16* Vg, bf16* MIXg, const float* nw) {
    const size_t rowbase = (size_t)b * SEQ;
    constexpr int NCH = SEQ / 64;
    const int lane = lane_now();
    if (wave < 2) *(LAS float*)(lds + L_NW + (wave * 64 + lane) * 4) = nw[wave * 64 + lane];
    if (wave < 4) {
        int ln_ = lane; asm volatile("" : "+v"(ln_));
        const int c16 = ln_ & 15, g = ln_ >> 4, j = wave;
        const int lo = (c16 * 64 + 16 * g) ^ ((c16 >> 3) << 5);
        const int lo8a = (c16 * 64 + 8 * g) ^ ((c16 >> 3) << 5), lo8b = (c16 * 64 + 32 + 8 * g) ^ ((c16 >> 3) << 5);
        const int q_ = c16 >> 2, p_ = c16 & 3;
        const int trv = (4 * g + q_) * VSTR + (32 * j + 4 * p_) * 2;
        const int trk = (4 * g + q_) * 64 + ((8 * p_) ^ ((g >> 1) << 5));
        f32x4 S[8][2];
#pragma unroll
        for (int m = 0; m < 8; ++m) { S[m][0] = (f32x4){0.f, 0.f, 0.f, 0.f}; S[m][1] = (f32x4){0.f, 0.f, 0.f, 0.f}; }
        HG_BAR();
#pragma unroll 1
        for (int k = 0; k < NCH; ++k) {
            const LAS unsigned char* set = lds + ((k & 1) ? L_SET1 : L_SET0);
            u32x2 pf[6][2];
            pf[0][1] = (u32x2){0u, 0u}; pf[3][1] = (u32x2){0u, 0u};
#pragma unroll
            for (int tb = 0; tb < 4; ++tb) {
                bf16x8 qf[4];
#pragma unroll
                for (int ks = 0; ks < 4; ++ks) qf[ks] = ld128(set + S_QB + (tb * 4 + ks) * 1024 + lo);
#pragma unroll
                for (int sb = 0; sb <= tb; ++sb) {
                    f32x4 acc = (f32x4){0.f, 0.f, 0.f, 0.f};
#pragma unroll
                    for (int ks = 0; ks < 4; ++ks) acc = MFMA16(ld128(set + S_K2 + (sb * 4 + ks) * 1024 + lo), qf[ks], acc);
                    if (sb == tb) {
#pragma unroll
                        for (int r = 0; r < 4; ++r) acc[r] = (4 * g + r <= c16) ? acc[r] : 0.f;
                    }
                    pf[tb < 2 ? tb : 2 * tb - 2 + (sb >> 1)][sb & 1] = (u32x2){cvtpk(acc[0], acc[1]), cvtpk(acc[2], acc[3])};
                }
            }
            bf16x8 vf[2][2];
#pragma unroll
            for (int kk = 0; kk < 2; ++kk)
#pragma unroll
                for (int dvb = 0; dvb < 2; ++dvb) { const LAS unsigned char* vp = set + S_V + trv + (32 * kk) * VSTR + (16 * dvb) * 2; vf[kk][dvb] = cat(ldtr(vp), ldtr(vp + 16 * VSTR)); }
            f32x4 o[4][2];
#pragma unroll
            for (int tb = 0; tb < 4; ++tb)
#pragma unroll
                for (int dvb = 0; dvb < 2; ++dvb) {
                    const int f0 = tb < 2 ? tb : 2 * tb - 2;
                    const u32x4 w0 = (u32x4){pf[f0][0].x, pf[f0][0].y, pf[f0][1].x, pf[f0][1].y};
                    f32x4 a = MFMA16(__builtin_bit_cast(bf16x8, w0), vf[0][dvb], ((f32x4){0.f, 0.f, 0.f, 0.f}));
                    if (tb >= 2) { const u32x4 w1 = (u32x4){pf[f0 + 1][0].x, pf[f0 + 1][0].y, pf[f0 + 1][1].x, pf[f0 + 1][1].y}; a = MFMA16(__builtin_bit_cast(bf16x8, w1), vf[1][dvb], a); }
                    o[tb][dvb] = a;
                }
#pragma unroll
            for (int kk = 0; kk < 4; ++kk) {
                const f32x4 e0 = *(const LAS f32x4*)(set + S_ER + (32 * kk + 4 * g) * 4), e1 = *(const LAS f32x4*)(set + S_ER + (32 * kk + 16 + 4 * g) * 4);
                bf16x8 sf[2];
#pragma unroll
                for (int dvb = 0; dvb < 2; ++dvb) { const f32x4 s0 = S[2 * kk][dvb] * e0, s1 = S[2 * kk + 1][dvb] * e1;
                    const u32x4 sw = (u32x4){cvtpk(s0[0], s0[1]), cvtpk(s0[2], s0[3]), cvtpk(s1[0], s1[1]), cvtpk(s1[2], s1[3])}; sf[dvb] = __builtin_bit_cast(bf16x8, sw); }
#pragma unroll
                for (int tb = 0; tb < 4; ++tb) { const bf16x8 af = cat(ld64(set + S_QB + (tb * 4 + kk) * 1024 + lo8a), ld64(set + S_QB + (tb * 4 + kk) * 1024 + lo8b));
                    o[tb][0] = MFMA16(af, sf[0], o[tb][0]); o[tb][1] = MFMA16(af, sf[1], o[tb][1]); }
            }
#pragma unroll
            for (int m = 0; m < 8; ++m) {
                f32x4 t0 = (f32x4){0.f, 0.f, 0.f, 0.f}, t1 = (f32x4){0.f, 0.f, 0.f, 0.f};
#pragma unroll
                for (int kk = 0; kk < 2; ++kk) {
                    const LAS unsigned char* k0 = set + S_K2 + ((2 * kk) * 4 + (m >> 1)) * 1024 + trk + 32 * (m & 1) * (1 - 2 * (g >> 1));
                    const bf16x8 af = cat(ldtr(k0), ldtr(k0 + 4096));
                    t0 = MFMA16(af, vf[kk][0], t0); t1 = MFMA16(af, vf[kk][1], t1); }
                const f32x4 dc = *(const LAS f32x4*)(set + S_DEC + (16 * m + 4 * g) * 4), el = *(const LAS f32x4*)(set + S_ELR + (16 * m + 4 * g) * 4);
                S[m][0] = S[m][0] * dc + t0 * el; S[m][1] = S[m][1] * dc + t1 * el;
            }
            HG_BAR();
#pragma unroll
            for (int tb = 0; tb < 4; ++tb) {
                f32x4 q2 = o[tb][0] * o[tb][0] + o[tb][1] * o[tb][1];
#pragma unroll
                for (int r = 0; r < 4; ++r) { q2[r] = row16_sum(q2[r]);
                    *(LAS float*)(lds + L_O + (16 * tb + 4 * g + r) * OSTR + (32 * j + c16) * 4) = o[tb][0][r];
                    *(LAS float*)(lds + L_O + (16 * tb + 4 * g + r) * OSTR + (32 * j + 16 + c16) * 4) = o[tb][1][r]; }
                if (c16 == 0) *(LAS f32x4*)(lds + L_SSQ + (j * 64 + 16 * tb + 4 * g) * 4) = q2;
            }
            HG_BAR();
        }
        HG_BAR();
    } else {
        int ln_ = lane; asm volatile("" : "+v"(ln_));
        const int pw = wave - 4, ptid = (wave - 4) * 64 + ln_, tgq = ln_ >> 4, cpq = ln_ & 15;
        const int ch0 = 32 * pw + 2 * cpq;
        const GAS unsigned* Qp = (const GAS unsigned*)(Qg + (rowbase + 16 * tgq) * D + h * HD + ch0);
        const GAS unsigned* Lp = (const GAS unsigned*)(LFg + (rowbase + 16 * tgq) * D + h * HD + ch0);
        const GAS u32x4* Vp = (const GAS u32x4*)(Vg + (rowbase + (ptid >> 2)) * D + h * HD + (ptid & 3) * 32);
        GAS u32x4* Gq = (GAS u32x4*)(MIXg + (rowbase + (ptid >> 2)) * MIXW + D + h * HD + (ptid & 3) * 32);
        const int ew = (tgq * 4 + pw) * 1024;
        const int evw = (ptid >> 2) * VSTR + (ptid & 3) * 64;
        unsigned qr[16], lr[16]; u32x4 vr[4], gq[4];
#define HG_LD(c) do { _Pragma("unroll") for (int i = 0; i < 16; ++i) { qr[i] = Qp[((size_t)(c) * 64 + i) * (D / 2)]; lr[i] = Lp[((size_t)(c) * 64 + i) * (D / 2)]; } \
        _Pragma("unroll") for (int i = 0; i < 4; ++i) vr[i] = Vp[(size_t)(c) * 64 * (D / 8) + i]; } while (0)
#define HG_LDG(c) do { _Pragma("unroll") for (int i = 0; i < 4; ++i) gq[i] = Gq[(size_t)(c) * 64 * (MIXW / 8) + i]; } while (0)
#define HG_ELEM(set) do { \
        float a0 = 0.f, a1 = 0.f, r0 = 1.f, r1 = 1.f; float f0[16], f1[16], P0[16], P1[16]; \
        _Pragma("unroll") for (int i = 0; i < 16; ++i) { const float l0 = h2f_lo(lr[i]), l1 = h2f_hi(lr[i]); a0 += l0; a1 += l1; f0[i] = __expf(l0); f1[i] = __expf(l1); r0 *= f0[i]; r1 *= f1[i]; P0[i] = r0; P1[i] = r1; } \
          \
        const float x10 = shfl_x(a0, 16, ln_), x11 = shfl_x(a1, 16, ln_), x20 = shfl_x(a0, 32, ln_), x21 = shfl_x(a1, 32, ln_), x30 = shfl_x(a0, 48, ln_), x31 = shfl_x(a1, 48, ln_); \
          \
        const float t00 = tgq == 0 ? a0 : tgq == 1 ? x10 : tgq == 2 ? x20 : x30, t01 = tgq == 0 ? a1 : tgq == 1 ? x11 : tgq == 2 ? x21 : x31; \
        const float t10 = tgq == 1 ? a0 : tgq == 0 ? x10 : tgq == 3 ? x20 : x30, t11 = tgq == 1 ? a1 : tgq == 0 ? x11 : tgq == 3 ? x21 : x31; \
        const float t20 = tgq == 2 ? a0 : tgq == 3 ? x10 : tgq == 0 ? x20 : x30, t21 = tgq == 2 ? a1 : tgq == 3 ? x11 : tgq == 0 ? x21 : x31; \
        const float t30 = tgq == 3 ? a0 : tgq == 2 ? x10 : tgq == 1 ? x20 : x30, t31 = tgq == 3 ? a1 : tgq == 2 ? x11 : tgq == 1 ? x21 : x31; \
        const float R0 = t00 + t10, R1 = t01 + t11, L0 = R0 + t20 + t30, L1 = R1 + t21 + t31; \
          \
        const float d0 = tgq == 0 ? -R0 : tgq == 1 ? -t10 : tgq == 2 ? 0.f : t20, d1 = tgq == 0 ? -R1 : tgq == 1 ? -t11 : tgq == 2 ? 0.f : t21; \
        const float b0 = __expf(fminf(d0, 80.f)), b1 = __expf(fminf(d1, 80.f)); \
        if (tgq == 0) { *(LAS f32x2*)((set) + S_ER + ch0 * 4) = (f32x2){__expf(R0), __expf(R1)}; *(LAS f32x2*)((set) + S_ELR + ch0 * 4) = (f32x2){__expf(L0 - R0), __expf(L1 - R1)}; \
                        *(LAS f32x2*)((set) + S_DEC + ch0 * 4) = (f32x2){__expf(L0), __expf(L1)}; } \
        _Pragma("unroll") for (int i = 0; i < 16; ++i) { \
            const float q0 = bflo(qr[i]), q1 = bfhi(qr[i]), k0 = 1.0f - f0[i], k1 = 1.0f - f1[i]; \
            const float e10 = b0 * P0[i], e11 = b1 * P1[i], e20 = fminf(__builtin_amdgcn_rcpf(e10), 5.5e34f), e21 = fminf(__builtin_amdgcn_rcpf(e11), 5.5e34f); \
            const int ob = (64 * i + 4 * cpq) ^ ((i >> 3) << 5); \
            *(LAS unsigned*)((set) + S_QB + ew + ob) = cvtpk(q0 * e10, q1 * e11); \
            *(LAS unsigned*)((set) + S_K2 + ew + ob) = cvtpk(k0 * e20, k1 * e21); } \
        _Pragma("unroll") for (int i = 0; i < 4; ++i) *(LAS u32x4*)((set) + S_V + evw + 16 * i) = vr[i]; } while (0)
        HG_LD(0);
        HG_ELEM(lds + L_SET0);
        HG_LD(1);
        HG_BAR();
        f32x4 ov[8]; float rsv = 0.f;
#pragma unroll 1
        for (int k = 0; k < NCH; ++k) {
            if (k >= 1) {
                const int tok = ptid >> 2;
                float ss = 0.f;
#pragma unroll
                for (int w2 = 0; w2 < 4; ++w2) ss += *(const LAS float*)(lds + L_SSQ + (w2 * 64 + tok) * 4);
                rsv = __builtin_amdgcn_rsqf(ss * (1.0f / HD) + EPS);
#pragma unroll
                for (int i = 0; i < 8; ++i) ov[i] = *(const LAS f32x4*)(lds + L_O + tok * OSTR + (ptid & 3) * 128 + 16 * i);
            }
            if (k >= 1) {
#pragma unroll
                for (int i = 0; i < 4; ++i) {
                    const f32x4 n0 = *(const LAS f32x4*)(lds + L_NW + (ptid & 3) * 128 + 32 * i), n1 = *(const LAS f32x4*)(lds + L_NW + (ptid & 3) * 128 + 32 * i + 16);
                    const f32x4 a = ov[2 * i] * n0 * rsv, c = ov[2 * i + 1] * n1 * rsv; const u32x4 gw = gq[i]; u32x4 w;
                    w.x = pk2(a[0] * bflo(gw.x), a[1] * bfhi(gw.x)); w.y = pk2(a[2] * bflo(gw.y), a[3] * bfhi(gw.y)); w.z = pk2(c[0] * bflo(gw.z), c[1] * bfhi(gw.z)); w.w = pk2(c[2] * bflo(gw.w), c[3] * bfhi(gw.w));
                    Gq[(size_t)(k - 1) * 64 * (MIXW / 8) + i] = w; }
            }
            HG_LDG(k);
            if (k + 1 < NCH) { HG_ELEM(lds + (((k + 1) & 1) ? L_SET1 : L_SET0)); if (k + 2 < NCH) HG_LD(k + 2); }
            HG_BAR();
            HG_BAR();
        }
        { const int tok = ptid >> 2; float ss = 0.f;
#pragma unroll
          for (int w2 = 0; w2 < 4; ++w2) ss += *(const LAS float*)(lds + L_SSQ + (w2 * 64 + tok) * 4);
          rsv = __builtin_amdgcn_rsqf(ss * (1.0f / HD) + EPS);
#pragma unroll
          for (int i = 0; i < 4; ++i) {
              const f32x4 n0 = *(const LAS f32x4*)(lds + L_NW + (ptid & 3) * 128 + 32 * i), n1 = *(const LAS f32x4*)(lds + L_NW + (ptid & 3) * 128 + 32 * i + 16);
              const f32x4 a = *(const LAS f32x4*)(lds + L_O + tok * OSTR + (ptid & 3) * 128 + 32 * i) * n0 * rsv, c = *(const LAS f32x4*)(lds + L_O + tok * OSTR + (ptid & 3) * 128 + 32 * i + 16) * n1 * rsv;
              const u32x4 gw = gq[i]; u32x4 w;
              w.x = pk2(a[0] * bflo(gw.x), a[1] * bfhi(gw.x)); w.y = pk2(a[2] * bflo(gw.y), a[3] * bfhi(gw.y)); w.z = pk2(c[0] * bflo(gw.z), c[1] * bfhi(gw.z)); w.w = pk2(c[2] * bflo(gw.w), c[3] * bfhi(gw.w));
              Gq[(size_t)(NCH - 1) * 64 * (MIXW / 8) + i] = w; } }
        HG_BAR();
#undef HG_LD
#undef HG_LDG
#undef HG_ELEM
    }
}
#undef HG_DPP
#undef HG_BAR
#undef MFMA16
}

__device__ __forceinline__ void mixer_phase(Frame& F, const int l) {
    REFRESH_IDS(F);
    const int nh = F.G < BATCH * NHEAD ? F.G : BATCH * NHEAD;
    if (F.bid < nh) {
        const KArgs ka = kargs(); const float* nw = ka->in[IN_HNW] + l * HD;
        const bf16* Qg = (const bf16*)(ka->ws + WS_Q); const bf16* LFg = (const bf16*)(ka->ws + WS_LF); const bf16* Vg = (const bf16*)(ka->ws + WS_V); bf16* MIXg = (bf16*)(ka->ws + WS_MIX);
        for (int unit = F.bid; unit < BATCH * NHEAD; unit += nh) hg2::hgrn_unit(F.lds + RING_OFF, F.wave, unit / NHEAD, unit % NHEAD, Qg, LFg, Vg, MIXg, nw);
#ifdef PROBE_HG
        if (l == 0 && F.bid == 0 && F.wave0 == 0 && lane_now() == 0) *(volatile LAS unsigned long long*)(F.lds + LDSCTL_OFF + 1024 + 8 * 14) = __builtin_amdgcn_s_memrealtime();
#endif
    }
    if (F.G > nh) { if (F.bid >= nh) { pool_pass(F, l, F.bid - nh, F.G - nh); if (l == 0) { __syncthreads(); weights_prep(F, 1, 0, 0, nh, F.G - nh); } } }
    else { pool_pass(F, l, F.bid, F.G); if (l == 0) { __syncthreads(); weights_prep(F, 1, 0, 0, 0, F.G); } }
}

#ifndef DBG_KINDS
#define DBG_KINDS 0x7f
#endif
#define KIND(j) ((DBG_KINDS >> (j)) & 1)
#define IN(k) (lo <= (k) && (k) < hi)
#define BOTH(k) (IN(k) && IN((k) + 1))
#define GRID_BAR() do { if (N_LAUNCHES == 1) xcd_barrier(bar); } while (0)
#if defined(PROBE_PHASE) && !defined(PROBE_PHASE_END)
#define PROBE_PHASE_END (PROBE_PHASE + 1)
#endif
#ifdef PROBE_PHASE
constexpr int STAMP_OFF = LDSCTL_OFF + 1024;
#define STAMP(k) do { if (F.bid == 0 && F.wave0 == 0 && lane_now() == 0) *(volatile LAS unsigned long long*)(F.lds + STAMP_OFF + 8 * (k)) = __builtin_amdgcn_s_memrealtime(); } while (0)
#else
#define STAMP(k) do { } while (0)
#endif
template <int l> __device__ __forceinline__ void layer_phases(Frame& F, const XcdBarrier& bar, const int lo, const int hi) {
        const int p = 2 + 4 * l;
    if (KIND(2) && IN(p)) {
        const KArgs ka = kargs(); bf16* P_XN = (bf16*)(ka->ws + WS_XN); bf16* P_WIN = (bf16*)(ka->ws + WS_WIN);
        pg8::Gemm g{P_XN, P_WIN + (size_t)l * NZ * D, M, NZ, D, D, 0}; pg8::StaticOrder S; REFRESH_IDS(F); S.init(M, NZ, F.G, F.bid);
        pg8::EpiZ E{l};
        pg8::gemm_phase<pg8::EpiZ, pg8::StaticOrder, PG8_ALIGN, PG8_SP2>(F.lds + RING_OFF, g, S, E, F.tid);
        if (BOTH(p)) GRID_BAR();
    }
    STAMP(p + 1);
    if (KIND(3) && IN(p + 1)) {
#if defined(HGRN_NAIVE)
        REFRESH_IDS(F); pool_pass(F, l, F.bid, F.G);
        hgrn_naive(F, l);
#else
        mixer_phase(F, l);
#endif
        if (BOTH(p + 1)) GRID_BAR();
    }
    STAMP(p + 2);
    if (KIND(5) && IN(p + 2)) {
        const KArgs ka = kargs(); bf16* P_MIX = (bf16*)(ka->ws + WS_MIX); bf16* P_WOUT = (bf16*)(ka->ws + WS_WOUT);
        pg8::Gemm g{P_MIX, P_WOUT + (size_t)l * D * MIXW, M, D, MIXW, MIXW, 0}; pg8::StaticOrder S; REFRESH_IDS(F); S.init(M, D, F.G, F.bid);
        pg8::EpiBf16Plain E{WS_Y, D};
        pg8::gemm_phase<pg8::EpiBf16Plain, pg8::StaticOrder, PG8_ALIGN, PG8_SP2>(F.lds + RING_OFF, g, S, E, F.tid);
        if (BOTH(p + 2)) GRID_BAR();
    }
    STAMP(p + 3);
    if (KIND(6) && IN(p + 3)) {
        rowpass(F, l);
        if (BOTH(p + 3)) GRID_BAR();
    }
    STAMP(p + 4);
}

__global__ void __launch_bounds__(NWAVES * 64, 2) skel_fwd(Args args) {
    extern __shared__ __attribute__((aligned(16))) unsigned char lds[];
    Frame F;
    F.lds = (LAS unsigned char*)lds;
    F.MISC = (volatile LAS unsigned*)(F.lds + MISC_OFF);
    F.tid = threadIdx.x; F.lane = F.tid & 63; F.wave = __builtin_amdgcn_readfirstlane(F.tid >> 6); F.wave0 = F.wave;
    F.G = gridDim.x; F.bid = blockIdx.x;
    F.ctl = (gu32*)(args.ws + WS_CTL);
    for (int u = F.tid; u < (LDS_BYTES - LDSCTL_OFF) / 4; u += NWAVES * 64) ((LAS unsigned*)(F.lds + LDSCTL_OFF))[u] = 0u;
    __syncthreads();
    XcdBarrier bar; bar.bar = (unsigned*)(F.ctl + CW_BAR); bar.x = 0; bar.st = nullptr; bar.wave0 = F.wave0;
    if (N_LAUNCHES == 1) bar = xcd_barrier_post((unsigned*)(F.ctl + CW_BAR), F.MISC + 8);
    const int lo = (N_LAUNCHES == 1) ? 0 : args.ph_lo, hi = (N_LAUNCHES == 1) ? N_PHASES : args.ph_hi;

    STAMP(0);
    if (KIND(0) && IN(0)) { p0_prologue(F); weights_prep(F, 0, 0, DEPTH, 0, F.G); if (N_LAUNCHES == 1) xcd_barrier_census(bar); if (BOTH(0)) GRID_BAR(); }
    STAMP(1);
    if (KIND(1) && IN(1)) { rowpass(F, -1); if (BOTH(1)) GRID_BAR(); }
    STAMP(2);
    layer_phases<0>(F, bar, lo, hi);
    layer_phases<1>(F, bar, lo, hi);
    static_assert(DEPTH == 2, "two explicit layer_phases calls");
#ifdef PROBE_SEG
    if (F.bid == 0 && F.wave0 == 0 && lane_now() == 0) {
        volatile LAS unsigned long long* pa_ = (volatile LAS unsigned long long*)(F.lds + 141312 + 2048);
        const unsigned long long span = (PROBE_SEG == 99) ? pa_[0] + pa_[1] + pa_[2] + pa_[3] + pa_[4] + pa_[5] : pa_[PROBE_SEG & 15];
        const unsigned long long t0 = __builtin_amdgcn_s_memrealtime();
        while (__builtin_amdgcn_s_memrealtime() - t0 < span) __builtin_amdgcn_s_sleep(8);
    }
#endif
#ifdef PROBE_PHASE
    if (F.bid == 0 && F.wave0 == 0 && lane_now() == 0) {
#ifdef PROBE_HG
        const unsigned long long span = *(volatile LAS unsigned long long*)(F.lds + STAMP_OFF + 8 * 14) - *(volatile LAS unsigned long long*)(F.lds + STAMP_OFF + 8 * 3);
#else
        const unsigned long long span = *(volatile LAS unsigned long long*)(F.lds + STAMP_OFF + 8 * (PROBE_PHASE_END)) - *(volatile LAS unsigned long long*)(F.lds + STAMP_OFF + 8 * (PROBE_PHASE));
#endif
        const unsigned long long t0 = __builtin_amdgcn_s_memrealtime();
        while (__builtin_amdgcn_s_memrealtime() - t0 < span) __builtin_amdgcn_s_sleep(8);
    }
#endif
#undef IN
#undef BOTH
}

extern "C" void kernel_launch(void* const* d_in, const int* in_sizes, int n_in, void* d_out, int out_size, void* d_ws, size_t ws_size, hipStream_t stream) {
    static int grid = 0;
    if (grid == 0) {
        if (n_in != 12 || in_sizes[0] != M * D || out_size != M * D || ws_size < WS_END) { fprintf(stderr, "kernel_launch: unexpected shapes: n_in %d in0 %d out %d ws %zu\n", n_in, n_in > 0 ? in_sizes[0] : -1, out_size, ws_size); grid = -1; return; }
        int dev = 0, cus = 0, per_cu = 0;
        if (hipGetDevice(&dev) != hipSuccess || hipDeviceGetAttribute(&cus, hipDeviceAttributeMultiprocessorCount, dev) != hipSuccess) { grid = -1; return; }
        if (hipFuncSetAttribute((const void*)skel_fwd, hipFuncAttributeMaxDynamicSharedMemorySize, LDS_BYTES) != hipSuccess) { fprintf(stderr, "kernel_launch: hipFuncSetAttribute failed\n"); grid = -1; return; }
        if (hipOccupancyMaxActiveBlocksPerMultiprocessor(&per_cu, (const void*)skel_fwd, NWAVES * 64, LDS_BYTES) != hipSuccess || per_cu < 1) { fprintf(stderr, "kernel_launch: occupancy query says %d blocks per CU\n", per_cu); per_cu = 1; }
        (void)hipGetLastError();
        grid = cus;
    }
    if (grid < 0) return;
    if (hipMemsetAsync((char*)d_ws + WS_CTL, 0, CTL_ZERO_BYTES, stream) != hipSuccess) { fprintf(stderr, "kernel_launch: memset failed\n"); return; }
    Args a{};
    for (int i = 0; i < 12; ++i) a.in[i] = (const float*)d_in[i];
    a.out = (float*)d_out; a.ws = (unsigned char*)d_ws;
    for (int li = 0; li < N_LAUNCHES; ++li) {
        a.ph_lo = (N_LAUNCHES == 1) ? 0 : li; a.ph_hi = (N_LAUNCHES == 1) ? N_PHASES : li + 1; a.li = li;
        hipLaunchKernelGGL(skel_fwd, dim3(grid), dim3(NWAVES * 64), LDS_BYTES, stream, a);
        const hipError_t le = hipPeekAtLastError();
        if (le != hipSuccess) { fprintf(stderr, "kernel_launch: launch %d failed: %s\n", li, hipGetErrorName(le)); break; }
    }
}
```
